# Optimizing an MI355X kernel written in HIP

```python
import math
import jax
import jax.numpy as jnp
from jax import lax
import numpy as np


D_MODEL = 1024
BATCH = 16
SEQ = 2048
DEPTH = 1

GRID_W = 64
CTX_LEN = 256
DA_HEAD_DIM = 64
DA_V_DIM = 2 * DA_HEAD_DIM
DA_WIDTH = D_MODEL // 2
DA_HEADS = DA_WIDTH // DA_V_DIM
QK_COLS = DA_HEADS * DA_HEAD_DIM
SG_CHUNK = 128
SG_GROUP_DIM = 128
SG_WIDTH = D_MODEL - DA_WIDTH
SG_GROUPS = SG_WIDTH // SG_GROUP_DIM
MIX_WIDTH = DA_WIDTH + SG_WIDTH
KV_LO = 2 * QK_COLS
KV_HI = 4 * QK_COLS + DA_WIDTH
IN_COLS = KV_HI + 2 * SG_WIDTH
Q_BLOCK = 128
ROPE_THETA = 10000.0
MOE_GROUPS = 4
MOE_EXPERTS_PER_GROUP = 8
N_EXPERTS = MOE_GROUPS * MOE_EXPERTS_PER_GROUP
MOE_TOP_K = 2
D_EXPERT = D_MODEL
MOE_BLOCK = 128
EPS = 1e-5
DEEPNORM_ALPHA = (2.0 * DEPTH) ** 0.25
DEEPNORM_BETA = (8.0 * DEPTH) ** -0.25

kernel_name = 'hybrid_diffattn_sgmlp_hmoe_dit_block'


def _layer_norm(x, g, b):
    xf = x.astype(jnp.float32)
    mu = jnp.mean(xf, -1, keepdims=True)
    var = jnp.mean(jnp.square(xf - mu), -1, keepdims=True)
    y = (xf - mu) * lax.rsqrt(var + EPS) * g.astype(jnp.float32) + b.astype(jnp.float32)
    return y.astype(x.dtype)


def _modulate(h, shift, scale):
    return h * (1 + scale[..., None, :]) + shift[..., None, :]


def _heads(t, dh):
    return t.reshape(t.shape[:-1] + (DA_HEADS, dh))


def _rope_1d(x, pos):
    half = x.shape[-1] // 2
    inv = ROPE_THETA ** (-jnp.arange(half, dtype=jnp.float32) / half)
    ang = pos[:, None] * inv[None, :]
    cos = jnp.cos(ang)[None, :, None, :].astype(x.dtype)
    sin = jnp.sin(ang)[None, :, None, :].astype(x.dtype)
    x1, x2 = x[..., :half], x[..., half:]
    return jnp.concatenate([x1 * cos - x2 * sin, x2 * cos + x1 * sin], -1)


def _axial_rope(x, rows, cols):
    a = x.shape[-1] // 2
    return jnp.concatenate([_rope_1d(x[..., :a], rows), _rope_1d(x[..., a:], cols)], -1)


def _diff_attend(q1, q2, k1, k2, v, lam):
    s1 = jnp.einsum('bqhd,bkhd->bhqk', q1, k1).astype(jnp.float32)
    s2 = jnp.einsum('bqhd,bkhd->bhqk', q2, k2).astype(jnp.float32)
    a = jax.nn.softmax(s1, axis=-1) - lam * jax.nn.softmax(s2, axis=-1)
    return jnp.einsum('bhqk,bkhe->bqhe', a.astype(v.dtype), v)


def _diff_attend_blocked(q1, q2, k1, k2, v, lam):
    B, L, H, d = q1.shape
    nb = L // Q_BLOCK

    def to_blocks(q):
        return q.reshape(B, nb, Q_BLOCK, H, d).swapaxes(0, 1)

    o = lax.map(lambda qs: _diff_attend(qs[0], qs[1], k1, k2, v, lam),
                (to_blocks(q1), to_blocks(q2)))
    return o.swapaxes(0, 1).reshape(B, L, H, v.shape[-1])


def _diff_head_out(o, g, lam_init):
    of = o.astype(jnp.float32)
    of = of * lax.rsqrt(jnp.mean(of * of, -1, keepdims=True) + EPS) * g.astype(jnp.float32)
    of = of * (1.0 - lam_init)
    return of.astype(o.dtype).reshape(o.shape[:-2] + (DA_WIDTH,))


def _spatial_gate(z, ln_g, ln_b, w_s, b_s):
    z = jax.nn.gelu(z, approximate=False)
    u, v = z[..., :SG_WIDTH], z[..., SG_WIDTH:]
    v = _layer_norm(v, ln_g, ln_b)
    B, L, _ = v.shape
    v = v.reshape(B, L // SG_CHUNK, SG_CHUNK, SG_GROUPS, SG_GROUP_DIM)
    s = jnp.einsum('gpq,bnqgc->bnpgc', w_s, v) + b_s.T[None, None, :, :, None]
    return u * s.reshape(B, L, SG_WIDTH)


def _expert_dispatch(t, eid, w, w_gate, w_up, w_down):
    N, D = t.shape
    S = N * MOE_TOP_K
    flat_e = eid.reshape(S)
    flat_w = w.reshape(S)
    order = jnp.argsort(flat_e)
    sorted_e = flat_e[order]
    counts = jnp.zeros((N_EXPERTS,), jnp.int32).at[flat_e].add(1)
    padded = (counts + MOE_BLOCK - 1) // MOE_BLOCK * MOE_BLOCK
    start = jnp.cumsum(counts) - counts
    pad_end = jnp.cumsum(padded)
    pad_start = pad_end - padded
    dest = pad_start[sorted_e] + (jnp.arange(S, dtype=jnp.int32) - start[sorted_e])
    n_blocks = -(-S // MOE_BLOCK) + N_EXPERTS
    P = n_blocks * MOE_BLOCK
    buf_tok = jnp.zeros((P,), jnp.int32).at[dest].set((order // MOE_TOP_K).astype(jnp.int32))
    buf_w = jnp.zeros((P,), t.dtype).at[dest].set(flat_w[order])
    blk_start = jnp.arange(n_blocks, dtype=jnp.int32) * MOE_BLOCK
    blk_e = jnp.minimum(jnp.searchsorted(pad_end, blk_start, side='right'), N_EXPERTS - 1)
    xb = t[buf_tok].reshape(n_blocks, MOE_BLOCK, D)

    def run(args):
        xe, e = args
        hid = jax.nn.silu(xe @ w_gate[e]) * (xe @ w_up[e])
        return hid @ w_down[e]

    yb = lax.map(run, (xb, blk_e)).reshape(P, D)
    return jnp.zeros_like(t).at[buf_tok].add(yb * buf_w[:, None])


def _hier_moe(h, wg, bg, we, be, w_gate, w_up, w_down):
    B, L, D = h.shape
    t = h.reshape(B * L, D)
    N = t.shape[0]
    g_logits = (t @ wg).astype(jnp.float32) + bg.astype(jnp.float32)
    g_prob = jax.nn.softmax(g_logits, axis=-1)
    g_sel = jnp.argmax(g_logits, axis=-1).astype(jnp.int32)
    g_w = jnp.take_along_axis(g_prob, g_sel[:, None], axis=-1)
    e_logits = ((t @ we).astype(jnp.float32) + be.astype(jnp.float32)).reshape(
        N, MOE_GROUPS, MOE_EXPERTS_PER_GROUP)
    e_logits = jnp.take_along_axis(e_logits, g_sel[:, None, None], axis=1)[:, 0]
    top_v, top_i = lax.top_k(e_logits, MOE_TOP_K)
    w = jax.nn.softmax(top_v, axis=-1) * g_w
    eid = g_sel[:, None] * MOE_EXPERTS_PER_GROUP + top_i.astype(jnp.int32)
    out = _expert_dispatch(t, eid, w.astype(t.dtype), w_gate, w_up, w_down)
    return out.reshape(B, L, D)


def setup_inputs(seed: int = 0) -> dict:
    key = jax.random.key(seed)
    ks = jax.random.split(key, 28)

    def nrm(k, shape, scale):
        return jax.random.normal(k, shape, jnp.float32) * scale

    return {
        'x': nrm(ks[0], (BATCH, SEQ, D_MODEL), 1.0),
        'c': nrm(ks[1], (BATCH, D_MODEL), 1.0),
        'ctx': nrm(ks[2], (BATCH, CTX_LEN, D_MODEL), 1.0),
        'c_ctx': nrm(ks[3], (D_MODEL,), 1.0),
        'w_mod': nrm(ks[4], (DEPTH, D_MODEL, 6 * D_MODEL), 0.5 * D_MODEL ** -0.5),
        'b_mod': nrm(ks[5], (DEPTH, 6 * D_MODEL), 0.01),
        'w_in': nrm(ks[6], (DEPTH, D_MODEL, IN_COLS), D_MODEL ** -0.5),
        'lam_q1': nrm(ks[7], (DEPTH, DA_HEAD_DIM), 0.1),
        'lam_k1': nrm(ks[8], (DEPTH, DA_HEAD_DIM), 0.1),
        'lam_q2': nrm(ks[9], (DEPTH, DA_HEAD_DIM), 0.1),
        'lam_k2': nrm(ks[10], (DEPTH, DA_HEAD_DIM), 0.1),
        'subln_g': 1.0 + nrm(ks[11], (DEPTH, DA_V_DIM), 0.01),
        'sg_ln_g': 1.0 + nrm(ks[12], (DEPTH, SG_WIDTH), 0.01),
        'sg_ln_b': nrm(ks[13], (DEPTH, SG_WIDTH), 0.01),
        'sg_w': nrm(ks[14], (DEPTH, SG_GROUPS, SG_CHUNK, SG_CHUNK), SG_CHUNK ** -0.5),
        'sg_b': 1.0 + nrm(ks[15], (DEPTH, SG_GROUPS, SG_CHUNK), 0.01),
        'w_out': nrm(ks[16], (DEPTH, MIX_WIDTH, D_MODEL), DEEPNORM_BETA * MIX_WIDTH ** -0.5),
        'ln1_g': 1.0 + nrm(ks[17], (DEPTH, D_MODEL), 0.01),
        'ln1_b': nrm(ks[18], (DEPTH, D_MODEL), 0.01),
        'router_group_w': nrm(ks[19], (DEPTH, D_MODEL, MOE_GROUPS), D_MODEL ** -0.5),
        'router_group_b': nrm(ks[20], (DEPTH, MOE_GROUPS), 0.01),
        'router_expert_w': nrm(ks[21], (DEPTH, D_MODEL, N_EXPERTS), D_MODEL ** -0.5),
        'router_expert_b': nrm(ks[22], (DEPTH, N_EXPERTS), 0.01),
        'exp_w_gate': nrm(ks[23], (DEPTH, N_EXPERTS, D_MODEL, D_EXPERT), D_MODEL ** -0.5),
        'exp_w_up': nrm(ks[24], (DEPTH, N_EXPERTS, D_MODEL, D_EXPERT), D_MODEL ** -0.5),
        'exp_w_down': nrm(ks[25], (DEPTH, N_EXPERTS, D_EXPERT, D_MODEL), DEEPNORM_BETA * D_EXPERT ** -0.5),
        'ln2_g': 1.0 + nrm(ks[26], (DEPTH, D_MODEL), 0.01),
        'ln2_b': nrm(ks[27], (DEPTH, D_MODEL), 0.01),
    }


def reference(x, c, ctx, c_ctx, w_mod, b_mod, w_in, lam_q1, lam_k1, lam_q2, lam_k2,
              subln_g, sg_ln_g, sg_ln_b, sg_w, sg_b, w_out, ln1_g, ln1_b,
              router_group_w, router_group_b, router_expert_w, router_expert_b,
              exp_w_gate, exp_w_up, exp_w_down, ln2_g, ln2_b):
    B, L, D = x.shape
    rows_n = L // GRID_W
    rows = jnp.repeat(jnp.arange(rows_n, dtype=jnp.float32), GRID_W)
    cols = jnp.tile(jnp.arange(GRID_W, dtype=jnp.float32), rows_n)
    q_scale = DA_HEAD_DIM ** -0.5
    for l in range(DEPTH):
        last = l == DEPTH - 1
        wi = w_in[l]
        mod = jnp.einsum('bd,de->be', jax.nn.silu(c), w_mod[l]) + b_mod[l]
        mod_c = jax.nn.silu(c_ctx) @ w_mod[l] + b_mod[l]
        sh1, sc1, g1, sh2, sc2, g2 = jnp.split(mod, 6, axis=-1)
        csh1, csc1, cg1, csh2, csc2, cg2 = jnp.split(mod_c, 6, axis=-1)
        lam_init = 0.8 - 0.6 * math.exp(-0.3 * l)
        lam = (jnp.exp(jnp.sum(lam_q1[l].astype(jnp.float32) * lam_k1[l].astype(jnp.float32)))
               - jnp.exp(jnp.sum(lam_q2[l].astype(jnp.float32) * lam_k2[l].astype(jnp.float32)))
               + lam_init)

        h_c = _modulate(ctx, csh1, csc1)
        kv_c = jnp.einsum('bld,dc->blc', h_c, wi[:, KV_LO:KV_HI])
        k1_c = _heads(kv_c[..., :QK_COLS], DA_HEAD_DIM)
        k2_c = _heads(kv_c[..., QK_COLS:2 * QK_COLS], DA_HEAD_DIM)
        v_c = _heads(kv_c[..., 2 * QK_COLS:], DA_V_DIM)

        h = _modulate(x, sh1, sc1)
        p = jnp.einsum('bld,dc->blc', h, wi)
        q1 = _axial_rope(_heads(p[..., :QK_COLS], DA_HEAD_DIM) * q_scale, rows, cols)
        q2 = _axial_rope(_heads(p[..., QK_COLS:KV_LO], DA_HEAD_DIM) * q_scale, rows, cols)
        k1 = _axial_rope(_heads(p[..., KV_LO:KV_LO + QK_COLS], DA_HEAD_DIM), rows, cols)
        k2 = _axial_rope(_heads(p[..., KV_LO + QK_COLS:2 * KV_LO], DA_HEAD_DIM), rows, cols)
        v = _heads(p[..., 2 * KV_LO:KV_HI], DA_V_DIM)
        k1_all = jnp.concatenate([k1, k1_c], axis=1)
        k2_all = jnp.concatenate([k2, k2_c], axis=1)
        v_all = jnp.concatenate([v, v_c], axis=1)
        da = _diff_head_out(_diff_attend_blocked(q1, q2, k1_all, k2_all, v_all, lam),
                            subln_g[l], lam_init)
        sg = _spatial_gate(p[..., KV_HI:], sg_ln_g[l], sg_ln_b[l], sg_w[l], sg_b[l])
        y = jnp.einsum('blc,cd->bld', jnp.concatenate([da, sg], axis=-1), w_out[l])
        x = _layer_norm(DEEPNORM_ALPHA * x + g1[:, None, :] * y, ln1_g[l], ln1_b[l])

        f = _hier_moe(_modulate(x, sh2, sc2), router_group_w[l], router_group_b[l],
                      router_expert_w[l], router_expert_b[l],
                      exp_w_gate[l], exp_w_up[l], exp_w_down[l])
        x = _layer_norm(DEEPNORM_ALPHA * x + g2[:, None, :] * f, ln2_g[l], ln2_b[l])

        if not last:
            qc = jnp.einsum('bld,dc->blc', h_c, wi[:, :KV_LO])
            q1_c = _heads(qc[..., :QK_COLS], DA_HEAD_DIM) * q_scale
            q2_c = _heads(qc[..., QK_COLS:], DA_HEAD_DIM) * q_scale
            da_c = _diff_head_out(_diff_attend(q1_c, q2_c, k1_c, k2_c, v_c, lam), subln_g[l], lam_init)
            sg_c = _spatial_gate(jnp.einsum('bld,dc->blc', h_c, wi[:, KV_HI:]),
                                 sg_ln_g[l], sg_ln_b[l], sg_w[l], sg_b[l])
            y_c = jnp.einsum('blc,cd->bld', jnp.concatenate([da_c, sg_c], axis=-1), w_out[l])
            ctx = _layer_norm(DEEPNORM_ALPHA * ctx + cg1 * y_c, ln1_g[l], ln1_b[l])
            f_c = _hier_moe(_modulate(ctx, csh2, csc2), router_group_w[l], router_group_b[l],
                            router_expert_w[l], router_expert_b[l],
                            exp_w_gate[l], exp_w_up[l], exp_w_down[l])
            ctx = _layer_norm(DEEPNORM_ALPHA * ctx + cg2 * f_c, ln2_g[l], ln2_b[l])
    return x
```

```cpp
#include <hip/hip_runtime.h>
#include <cstdint>
#include <cstdio>

typedef unsigned short bf16_t;
#define DEV __device__ __forceinline__

namespace cfg {
constexpr int B = 16, L = 2048, D = 1024, NTOK = B * L, CTX = 256, NCTX = B * CTX, KEYS = L + CTX;
constexpr int INC = 2560, NE = 32, PMAX = 73728, MAXT = 288;
constexpr float EPS = 1e-5f, ALPHA = 1.189207115002721f, LAM_INIT = 0.2f;
constexpr size_t MiB = 1048576;
constexpr size_t OFF_CTL = 0;
constexpr size_t OFF_MOD = 65536;
constexpr size_t OFF_ROPE = OFF_MOD + 17 * 6144 * 4;
constexpr size_t OFF_LAM = OFF_ROPE + 8192;
constexpr size_t OFF_TOKE = OFF_LAM + 256;
constexpr size_t OFF_TOKP = OFF_TOKE + 262144;
constexpr size_t OFF_TOKW = OFF_TOKP + 262144;
constexpr size_t OFF_TOKS = OFF_TOKW + 262144;
constexpr size_t OFF_SLOTTOK = OFF_TOKS + 262144;
constexpr size_t OFF_TILEE = OFF_SLOTTOK + PMAX * 4;
constexpr size_t OFF_WIN = 2 * MiB;
constexpr size_t OFF_WOUT = 7 * MiB;
constexpr size_t OFF_SGW = 9 * MiB;
constexpr size_t OFF_WGU = 10 * MiB;
constexpr size_t OFF_WD = 138 * MiB;
constexpr size_t OFF_A = 202 * MiB;
constexpr size_t OFF_B = 346 * MiB;
constexpr size_t OFF_C = 490 * MiB;
constexpr size_t WS_END = 554 * MiB;
constexpr int CW_CNT = 4096;
}
using namespace cfg;

DEV bf16_t f2bf(float f) { unsigned u = __float_as_uint(f); u += 0x7fffu + ((u >> 16) & 1u); return (bf16_t)(u >> 16); }
DEV float bf2f(bf16_t h) { return __uint_as_float(((unsigned)h) << 16); }
DEV unsigned pack2(float lo, float hi) { return (unsigned)f2bf(lo) | ((unsigned)f2bf(hi) << 16); }
DEV float wave_sum(float v) { for (int o = 32; o; o >>= 1) v += __shfl_xor(v, o); return v; }
DEV float wave_max(float v) { for (int o = 32; o; o >>= 1) v = fmaxf(v, __shfl_xor(v, o)); return v; }
DEV float silu_f(float x) { return x / (1.0f + __expf(-x)); }
DEV float gelu_f(float x) { return 0.5f * x * (1.0f + erff(x * 0.70710678118654752f)); }

__global__ void k_prep(const float* lq1, const float* lk1, const float* lq2, const float* lk2, unsigned char* ws) {
    float* rope = (float*)(ws + OFF_ROPE);
    for (int t = threadIdx.x; t < 1024; t += blockDim.x) {
        const int pos = t >> 4, j = t & 15;
        const float inv = powf(10000.0f, -(float)j / 16.0f);
        const float ang = (float)pos * inv;
        rope[2 * t] = cosf(ang); rope[2 * t + 1] = sinf(ang);
    }
    if (threadIdx.x < 64) {
        const int l = threadIdx.x;
        const float a = wave_sum(lq1[l] * lk1[l]), b = wave_sum(lq2[l] * lk2[l]);
        if (l == 0) *(float*)(ws + OFF_LAM) = expf(a) - expf(b) + LAM_INIT;
    }
}

__global__ void __launch_bounds__(256) k_mod(const float* c, const float* c_ctx, const float* w_mod, const float* b_mod, unsigned char* ws) {
    extern __shared__ float sv[];
    for (int i = threadIdx.x; i < 17 * 1024; i += blockDim.x) { const float v = i < 16384 ? c[i] : c_ctx[i - 16384]; sv[i] = silu_f(v); }
    __syncthreads();
    float* mod = (float*)(ws + OFF_MOD);
    const int col = threadIdx.x & 31, kg = threadIdx.x >> 5, nkg = blockDim.x >> 5, dper = 1024 / nkg;
    for (int u = blockIdx.x; u < 192; u += gridDim.x) {
        const int e = u * 32 + col;
        float acc[17];
#pragma unroll
        for (int r = 0; r < 17; ++r) acc[r] = 0.f;
        for (int d = kg * dper; d < (kg + 1) * dper; ++d) {
            const float w = w_mod[(size_t)d * 6144 + e];
#pragma unroll
            for (int r = 0; r < 17; ++r) acc[r] += sv[r * 1024 + d] * w;
        }
        __syncthreads();
        float* red = sv + 17 * 1024;
#pragma unroll
        for (int r = 0; r < 17; ++r) red[(kg * 17 + r) * 32 + col] = acc[r];
        __syncthreads();
        for (int i = threadIdx.x; i < 17 * 32; i += blockDim.x) {
            const int r = i >> 5, cc = i & 31; float s = 0.f;
            for (int g = 0; g < nkg; ++g) s += red[(g * 17 + r) * 32 + cc];
            mod[r * 6144 + u * 32 + cc] = s + b_mod[u * 32 + cc];
        }
        __syncthreads();
    }
}

DEV void conv_tile(const float* src, int ldn, int k0, int n0, bf16_t* dst, int ldk, int rbase, int rstride, float* tile  ) {
    const int tid = threadIdx.x;
    for (int i = tid; i < 64 * 16; i += blockDim.x) {
        const int r = i >> 4, c4 = i & 15;
        const float4 v = *(const float4*)(src + (size_t)(k0 + r) * ldn + n0 + c4 * 4);
        tile[r * 65 + c4 * 4 + 0] = v.x; tile[r * 65 + c4 * 4 + 1] = v.y; tile[r * 65 + c4 * 4 + 2] = v.z; tile[r * 65 + c4 * 4 + 3] = v.w;
    }
    __syncthreads();
    for (int i = tid; i < 64 * 8; i += blockDim.x) {
        const int n = i >> 3, kc = (i & 7) * 8, nn = n0 + n;
        const int row = rbase + (nn >> 7) * rstride + (nn & 127);
        uint4 o;
        o.x = pack2(tile[(kc + 0) * 65 + n], tile[(kc + 1) * 65 + n]); o.y = pack2(tile[(kc + 2) * 65 + n], tile[(kc + 3) * 65 + n]);
        o.z = pack2(tile[(kc + 4) * 65 + n], tile[(kc + 5) * 65 + n]); o.w = pack2(tile[(kc + 6) * 65 + n], tile[(kc + 7) * 65 + n]);
        *(uint4*)(dst + (size_t)row * ldk + k0 + kc) = o;
    }
    __syncthreads();
}
__global__ void __launch_bounds__(256) k_conv(const float* w_in, const float* w_out, const float* sg_w, const float* wg, const float* wu, const float* wd, unsigned char* ws) {
    __shared__ float tile[64 * 65];
    bf16_t* WinT = (bf16_t*)(ws + OFF_WIN); bf16_t* WoutT = (bf16_t*)(ws + OFF_WOUT); bf16_t* SgW = (bf16_t*)(ws + OFF_SGW);
    bf16_t* WguT = (bf16_t*)(ws + OFF_WGU); bf16_t* WdT = (bf16_t*)(ws + OFF_WD);
    constexpr int U_IN = 16 * 40, U_OUT = 16 * 16, U_E = 32 * 256;
    constexpr int TOT = U_IN + U_OUT + 3 * U_E;
    for (int u = blockIdx.x; u < TOT; u += gridDim.x) {
        int v = u;
        if (v < U_IN) { conv_tile(w_in, 2560, (v % 16) * 64, (v / 16) * 64, WinT, 1024, 0, 128, tile); continue; }
        v -= U_IN;
        if (v < U_OUT) { conv_tile(w_out, 1024, (v % 16) * 64, (v / 16) * 64, WoutT, 1024, 0, 128, tile); continue; }
        v -= U_OUT;
        const int which = v / U_E, w = v % U_E, e = w / 256, t = w % 256, k0 = (t % 16) * 64, n0 = (t / 16) * 64;
        if (which == 0) conv_tile(wg + (size_t)e * 1048576, 1024, k0, n0, WguT + (size_t)e * 2048 * 1024, 1024, 0, 256, tile);
        else if (which == 1) conv_tile(wu + (size_t)e * 1048576, 1024, k0, n0, WguT + (size_t)e * 2048 * 1024, 1024, 128, 256, tile);
        else conv_tile(wd + (size_t)e * 1048576, 1024, k0, n0, WdT + (size_t)e * 1024 * 1024, 1024, 0, 128, tile);
    }
    for (int i = blockIdx.x * blockDim.x + threadIdx.x; i < 65536 / 4; i += gridDim.x * blockDim.x) {
        const float4 v = *(const float4*)(sg_w + i * 4);
        uint2 o; o.x = pack2(v.x, v.y); o.y = pack2(v.z, v.w);
        *(uint2*)(SgW + i * 4) = o;
    }
}

__global__ void __launch_bounds__(256) k_modulate(const float* x, const float* ctx, unsigned char* ws) {
    const float* mod = (const float*)(ws + OFF_MOD);
    bf16_t* h = (bf16_t*)(ws + OFF_A); bf16_t* hc = (bf16_t*)(ws + OFF_A + 128 * MiB);
    const size_t n8 = (size_t)(NTOK + NCTX) * 128;
    for (size_t i = (size_t)blockIdx.x * blockDim.x + threadIdx.x; i < n8; i += (size_t)gridDim.x * blockDim.x) {
        const int row = (int)(i >> 7), c = (int)(i & 127) * 8;
        const float* src; bf16_t* dst; const float* m;
        if (row < NTOK) { src = x + (size_t)row * D + c; dst = h + (size_t)row * D + c; m = mod + (row / L) * 6144; }
        else { const int r = row - NTOK; src = ctx + (size_t)r * D + c; dst = hc + (size_t)r * D + c; m = mod + 16 * 6144; }
        const float4 a = *(const float4*)src, b = *(const float4*)(src + 4);
        const float4 s0 = *(const float4*)(m + c), s1 = *(const float4*)(m + c + 4);
        const float4 t0 = *(const float4*)(m + 1024 + c), t1 = *(const float4*)(m + 1024 + c + 4);
        uint4 o;
        o.x = pack2(a.x * (1.f + t0.x) + s0.x, a.y * (1.f + t0.y) + s0.y); o.y = pack2(a.z * (1.f + t0.z) + s0.z, a.w * (1.f + t0.w) + s0.w);
        o.z = pack2(b.x * (1.f + t1.x) + s1.x, b.y * (1.f + t1.y) + s1.y); o.w = pack2(b.z * (1.f + t1.z) + s1.z, b.w * (1.f + t1.w) + s1.w);
        *(uint4*)dst = o;
    }
}

struct EpiIn {
    unsigned char* ws; int ctx;
    DEV void operator()(int row, int col0, int tx, const float (&v)[4], const float (&)[4]) const {
        const float* rope = (const float*)(ws + OFF_ROPE);
        bf16_t* qb = (bf16_t*)(ws + OFF_B); bf16_t* kb = (bf16_t*)(ws + OFF_B + 32 * MiB); bf16_t* vb = (bf16_t*)(ws + OFF_B + 68 * MiB);
        bf16_t* zb = (bf16_t*)(ws + OFF_A + 64 * MiB);
        int c0 = col0; size_t krow;
        if (ctx) { c0 += 512; krow = (size_t)(row / CTX) * KEYS + L + (row % CTX); }
        else krow = (size_t)(row / L) * KEYS + (row % L);
        if (c0 < 1024) {
            float o[4] = {v[0], v[1], v[2], v[3]};
            if (!ctx) {
                const int l = row % L, p0 = l >> 6, p1 = l & 63;
                const float sc = c0 < 512 ? 0.125f : 1.0f;
                const float cA = rope[(p0 * 16 + tx) * 2], sA = rope[(p0 * 16 + tx) * 2 + 1], cB = rope[(p1 * 16 + tx) * 2], sB = rope[(p1 * 16 + tx) * 2 + 1];
                o[0] = (v[0] * cA - v[1] * sA) * sc; o[1] = (v[1] * cA + v[0] * sA) * sc;
                o[2] = (v[2] * cB - v[3] * sB) * sc; o[3] = (v[3] * cB + v[2] * sB) * sc;
            }
            if (c0 < 512) { bf16_t* dst = qb + (size_t)(c0 >> 8) * ((size_t)NTOK * 256) + (size_t)row * 256 + (c0 & 255) + tx;
#pragma unroll
                for (int j = 0; j < 4; ++j) dst[16 * j] = f2bf(o[j]); }
            else { bf16_t* dst = kb + (size_t)((c0 - 512) >> 8) * ((size_t)B * KEYS * 256) + krow * 256 + (c0 & 255) + tx;
#pragma unroll
                for (int j = 0; j < 4; ++j) dst[16 * j] = f2bf(o[j]); }
        } else if (c0 < 1536) {
            bf16_t* dst = vb + krow * 512 + (c0 - 1024) + tx;
#pragma unroll
            for (int j = 0; j < 4; ++j) dst[16 * j] = f2bf(v[j]);
        } else {
            bf16_t* dst = zb + (size_t)row * 1024 + (c0 - 1536) + tx;
#pragma unroll
            for (int j = 0; j < 4; ++j) dst[16 * j] = f2bf(gelu_f(v[j]));
        }
    }
};
struct EpiY {
    float* y;
    DEV void operator()(int row, int col0, int tx, const float (&v)[4], const float (&)[4]) const {
#pragma unroll
        for (int j = 0; j < 4; ++j) y[(size_t)row * D + col0 + tx + 16 * j] = v[j];
    }
};
struct EpiHid {
    bf16_t* hid;
    DEV void operator()(int row, int col0, int tx, const float (&g)[4], const float (&u)[4]) const {
#pragma unroll
        for (int j = 0; j < 4; ++j) hid[(size_t)row * D + col0 + tx + 16 * j] = f2bf(silu_f(g[j]) * u[j]);
    }
};
struct EpiY2 {
    bf16_t* y2;
    DEV void operator()(int row, int col0, int tx, const float (&v)[4], const float (&)[4]) const {
#pragma unroll
        for (int j = 0; j < 4; ++j) y2[(size_t)row * D + col0 + tx + 16 * j] = f2bf(v[j]);
    }
};

template <int MODE, class Epi>
__global__ void __launch_bounds__(256) k_gemm_naive(const bf16_t* A, const bf16_t* Bt, int M, int N, int K, int brow0, Epi epi, const unsigned char* ws) {
    __shared__ float As[16][64 + 4], Bs[16][64 + 4], B2s[16][64 + 4];
    const int ntn = N / 64;
    const int mt = blockIdx.x / ntn, nt = blockIdx.x % ntn;
    const int tid = threadIdx.x, tx = tid & 15, ty = tid >> 4;
    const int* slot_tok = (const int*)(ws + OFF_SLOTTOK); const int* tile_e = (const int*)(ws + OFF_TILEE);
    int e = 0;
    if (MODE != 0) { const int ntiles = tile_e[MAXT]; if (mt / 4 >= ntiles) return; e = tile_e[mt / 4]; }
    const int lr = tid >> 2, lk = (tid & 3) * 4;
    size_t arow = (size_t)(mt * 64 + lr);
    if (MODE == 1) arow = (size_t)slot_tok[mt * 64 + lr];
    const bf16_t* ap = A + arow * K + lk;
    const int bc = nt * 64 + lr;
    size_t brow;
    if (MODE == 0) brow = (size_t)(brow0 + bc);
    else if (MODE == 1) brow = (size_t)e * 2048 + (bc >> 7) * 256 + (bc & 127);
    else brow = (size_t)e * 1024 + bc;
    const bf16_t* bp = Bt + brow * K + lk;
    float acc[4][4], acc2[4][4];
#pragma unroll
    for (int i = 0; i < 4; ++i)
#pragma unroll
        for (int j = 0; j < 4; ++j) { acc[i][j] = 0.f; acc2[i][j] = 0.f; }
    for (int k0 = 0; k0 < K; k0 += 16) {
        const uint2 av = *(const uint2*)(ap + k0), bv = *(const uint2*)(bp + k0);
        As[lk + 0][lr] = bf2f((bf16_t)(av.x & 0xffff)); As[lk + 1][lr] = bf2f((bf16_t)(av.x >> 16)); As[lk + 2][lr] = bf2f((bf16_t)(av.y & 0xffff)); As[lk + 3][lr] = bf2f((bf16_t)(av.y >> 16));
        Bs[lk + 0][lr] = bf2f((bf16_t)(bv.x & 0xffff)); Bs[lk + 1][lr] = bf2f((bf16_t)(bv.x >> 16)); Bs[lk + 2][lr] = bf2f((bf16_t)(bv.y & 0xffff)); Bs[lk + 3][lr] = bf2f((bf16_t)(bv.y >> 16));
        if (MODE == 1) { const uint2 cv = *(const uint2*)(bp + (size_t)128 * K + k0);
            B2s[lk + 0][lr] = bf2f((bf16_t)(cv.x & 0xffff)); B2s[lk + 1][lr] = bf2f((bf16_t)(cv.x >> 16)); B2s[lk + 2][lr] = bf2f((bf16_t)(cv.y & 0xffff)); B2s[lk + 3][lr] = bf2f((bf16_t)(cv.y >> 16)); }
        __syncthreads();
#pragma unroll
        for (int k = 0; k < 16; ++k) {
            float a[4], b[4], b2[4];
#pragma unroll
            for (int i = 0; i < 4; ++i) a[i] = As[k][ty * 4 + i];
#pragma unroll
            for (int j = 0; j < 4; ++j) { b[j] = Bs[k][tx + 16 * j]; if (MODE == 1) b2[j] = B2s[k][tx + 16 * j]; }
#pragma unroll
            for (int i = 0; i < 4; ++i)
#pragma unroll
                for (int j = 0; j < 4; ++j) { acc[i][j] += a[i] * b[j]; if (MODE == 1) acc2[i][j] += a[i] * b2[j]; }
        }
        __syncthreads();
    }
#pragma unroll
    for (int i = 0; i < 4; ++i) epi(mt * 64 + ty * 4 + i, nt * 64, tx, acc[i], acc2[i]);
}

__global__ void __launch_bounds__(256) k_sg_ln(const float* ln_g, const float* ln_b, unsigned char* ws) {
    bf16_t* zb = (bf16_t*)(ws + OFF_A + 64 * MiB);
    const int wid = threadIdx.x >> 6, lane = threadIdx.x & 63, nw = blockDim.x >> 6;
    for (int row = blockIdx.x * nw + wid; row < NTOK; row += gridDim.x * nw) {
        bf16_t* p = zb + (size_t)row * 1024 + 512 + lane * 8;
        const uint4 r = *(const uint4*)p;
        float v[8] = {bf2f((bf16_t)(r.x & 0xffff)), bf2f((bf16_t)(r.x >> 16)), bf2f((bf16_t)(r.y & 0xffff)), bf2f((bf16_t)(r.y >> 16)),
                      bf2f((bf16_t)(r.z & 0xffff)), bf2f((bf16_t)(r.z >> 16)), bf2f((bf16_t)(r.w & 0xffff)), bf2f((bf16_t)(r.w >> 16))};
        float s = 0.f;
#pragma unroll
        for (int j = 0; j < 8; ++j) s += v[j];
        const float mu = wave_sum(s) * (1.0f / 512.0f);
        float q = 0.f;
#pragma unroll
        for (int j = 0; j < 8; ++j) { const float d = v[j] - mu; q += d * d; }
        const float rstd = rsqrtf(wave_sum(q) * (1.0f / 512.0f) + EPS);
        float o[8];
#pragma unroll
        for (int j = 0; j < 8; ++j) o[j] = (v[j] - mu) * rstd * ln_g[lane * 8 + j] + ln_b[lane * 8 + j];
        uint4 w; w.x = pack2(o[0], o[1]); w.y = pack2(o[2], o[3]); w.z = pack2(o[4], o[5]); w.w = pack2(o[6], o[7]);
        *(uint4*)p = w;
    }
}
__global__ void __launch_bounds__(256) k_sg_mix(const float* sg_b, unsigned char* ws) {
    const bf16_t* zb = (const bf16_t*)(ws + OFF_A + 64 * MiB); const bf16_t* sgw = (const bf16_t*)(ws + OFF_SGW);
    bf16_t* mix = (bf16_t*)(ws + OFF_C);
    const size_t tot = (size_t)NTOK * 512;
    for (size_t i = (size_t)blockIdx.x * blockDim.x + threadIdx.x; i < tot; i += (size_t)gridDim.x * blockDim.x) {
        const int row = (int)(i >> 9), col = (int)(i & 511), g = col >> 7, p = row & 127, base = row & ~127;
        const bf16_t* w = sgw + (size_t)(g * 128 + p) * 128;
        float s = 0.f;
        for (int q = 0; q < 128; ++q) s += bf2f(w[q]) * bf2f(zb[(size_t)(base + q) * 1024 + 512 + col]);
        s += sg_b[g * 128 + p];
        mix[(size_t)row * 1024 + 512 + col] = f2bf(bf2f(zb[(size_t)row * 1024 + col]) * s);
    }
}

__global__ void __launch_bounds__(128) k_attn_naive(const float* subln_g, unsigned char* ws) {
    __shared__ float sc[2][2][KEYS];
    __shared__ float qs[2][2][64];
    const bf16_t* qb = (const bf16_t*)(ws + OFF_B); const bf16_t* kb = (const bf16_t*)(ws + OFF_B + 32 * MiB); const bf16_t* vb = (const bf16_t*)(ws + OFF_B + 68 * MiB);
    bf16_t* mix = (bf16_t*)(ws + OFF_C);
    const float lam = *(const float*)(ws + OFF_LAM);
    const int wid = threadIdx.x >> 6, lane = threadIdx.x & 63;
    const int item = blockIdx.x * 2 + wid;
    const int row = item >> 2, h = item & 3, b = row / L;
    for (int m = 0; m < 2; ++m) qs[wid][m][lane] = bf2f(qb[(size_t)m * NTOK * 256 + (size_t)row * 256 + h * 64 + lane]);
    __syncthreads();
    float mx[2] = {-1e30f, -1e30f};
    for (int kk = 0; kk < KEYS / 64; ++kk) {
        const int key = kk * 64 + lane;
        for (int m = 0; m < 2; ++m) {
            const bf16_t* kp = kb + (size_t)m * B * KEYS * 256 + ((size_t)b * KEYS + key) * 256 + h * 64;
            float s = 0.f;
            for (int d8 = 0; d8 < 8; ++d8) {
                const uint4 r = *(const uint4*)(kp + d8 * 8);
                const float* q = &qs[wid][m][d8 * 8];
                s += q[0] * bf2f((bf16_t)(r.x & 0xffff)) + q[1] * bf2f((bf16_t)(r.x >> 16)) + q[2] * bf2f((bf16_t)(r.y & 0xffff)) + q[3] * bf2f((bf16_t)(r.y >> 16))
                   + q[4] * bf2f((bf16_t)(r.z & 0xffff)) + q[5] * bf2f((bf16_t)(r.z >> 16)) + q[6] * bf2f((bf16_t)(r.w & 0xffff)) + q[7] * bf2f((bf16_t)(r.w >> 16));
            }
            sc[wid][m][key] = s; mx[m] = fmaxf(mx[m], s);
        }
    }
    float inv[2];
    for (int m = 0; m < 2; ++m) {
        const float M = wave_max(mx[m]); float s = 0.f;
        for (int kk = 0; kk < KEYS / 64; ++kk) { const float p = __expf(sc[wid][m][kk * 64 + lane] - M); sc[wid][m][kk * 64 + lane] = p; s += p; }
        inv[m] = 1.0f / wave_sum(s);
    }
    for (int kk = 0; kk < KEYS / 64; ++kk) { const int key = kk * 64 + lane; sc[wid][0][key] = sc[wid][0][key] * inv[0] - lam * sc[wid][1][key] * inv[1]; }
    __syncthreads();
    float o0 = 0.f, o1 = 0.f;
    const bf16_t* vp = vb + (size_t)b * KEYS * 512 + h * 128 + lane * 2;
    for (int key = 0; key < KEYS; ++key) {
        const unsigned r = *(const unsigned*)(vp + (size_t)key * 512);
        const float a = sc[wid][0][key];
        o0 += a * bf2f((bf16_t)(r & 0xffff)); o1 += a * bf2f((bf16_t)(r >> 16));
    }
    const float ss = wave_sum(o0 * o0 + o1 * o1) * (1.0f / 128.0f);
    const float r = rsqrtf(ss + EPS) * (1.0f - LAM_INIT);
    *(unsigned*)(mix + (size_t)row * 1024 + h * 128 + lane * 2) = pack2(o0 * r * subln_g[lane * 2], o1 * r * subln_g[lane * 2 + 1]);
}

__global__ void __launch_bounds__(256) k_ln1_router(const float* x, const float* ln_g, const float* ln_b, const float* wgr, const float* bgr, const float* wer, const float* ber,
                                                    float* x1out, unsigned char* ws) {
    const float* mod = (const float*)(ws + OFF_MOD); const float* y = (const float*)(ws + OFF_A);
    bf16_t* t = (bf16_t*)(ws + OFF_C);
    int* tok_e = (int*)(ws + OFF_TOKE); int* tok_p = (int*)(ws + OFF_TOKP); float* tok_w = (float*)(ws + OFF_TOKW);
    unsigned* cnt = (unsigned*)(ws + OFF_CTL) + CW_CNT;
    const int wid = threadIdx.x >> 6, lane = threadIdx.x & 63, nw = blockDim.x >> 6;
    for (int row = blockIdx.x * nw + wid; row < NTOK; row += gridDim.x * nw) {
        const float* m = mod + (row / L) * 6144;
        float v[16];
        float s = 0.f;
#pragma unroll
        for (int i = 0; i < 4; ++i) {
            const int c = 4 * lane + 256 * i;
            const float4 a = *(const float4*)(x + (size_t)row * D + c), yy = *(const float4*)(y + (size_t)row * D + c), g = *(const float4*)(m + 2048 + c);
            v[4 * i + 0] = ALPHA * a.x + g.x * yy.x; v[4 * i + 1] = ALPHA * a.y + g.y * yy.y; v[4 * i + 2] = ALPHA * a.z + g.z * yy.z; v[4 * i + 3] = ALPHA * a.w + g.w * yy.w;
            s += (v[4 * i] + v[4 * i + 1]) + (v[4 * i + 2] + v[4 * i + 3]);
        }
        const float mu = wave_sum(s) * (1.0f / 1024.0f);
        float q = 0.f;
#pragma unroll
        for (int j = 0; j < 16; ++j) { const float d = v[j] - mu; q += d * d; }
        const float rstd = rsqrtf(wave_sum(q) * (1.0f / 1024.0f) + EPS);
        float acc[36];
#pragma unroll
        for (int o = 0; o < 36; ++o) acc[o] = 0.f;
#pragma unroll
        for (int i = 0; i < 4; ++i) {
            const int c = 4 * lane + 256 * i;
            const float4 g = *(const float4*)(ln_g + c), bb = *(const float4*)(ln_b + c), sh = *(const float4*)(m + 3072 + c), scl = *(const float4*)(m + 4096 + c);
            float4 xo;
            xo.x = (v[4 * i + 0] - mu) * rstd * g.x + bb.x; xo.y = (v[4 * i + 1] - mu) * rstd * g.y + bb.y; xo.z = (v[4 * i + 2] - mu) * rstd * g.z + bb.z; xo.w = (v[4 * i + 3] - mu) * rstd * g.w + bb.w;
            *(float4*)(x1out + (size_t)row * D + c) = xo;
            float tt[4] = {xo.x * (1.f + scl.x) + sh.x, xo.y * (1.f + scl.y) + sh.y, xo.z * (1.f + scl.z) + sh.z, xo.w * (1.f + scl.w) + sh.w};
            uint2 o2; o2.x = pack2(tt[0], tt[1]); o2.y = pack2(tt[2], tt[3]);
            *(uint2*)(t + (size_t)row * D + c) = o2;
#pragma unroll
            for (int j = 0; j < 4; ++j) {
                const float4 wg4 = *(const float4*)(wgr + (size_t)(c + j) * 4);
                acc[0] += tt[j] * wg4.x; acc[1] += tt[j] * wg4.y; acc[2] += tt[j] * wg4.z; acc[3] += tt[j] * wg4.w;
#pragma unroll
                for (int o4 = 0; o4 < 8; ++o4) { const float4 w4 = *(const float4*)(wer + (size_t)(c + j) * 32 + o4 * 4);
                    acc[4 + o4 * 4 + 0] += tt[j] * w4.x; acc[4 + o4 * 4 + 1] += tt[j] * w4.y; acc[4 + o4 * 4 + 2] += tt[j] * w4.z; acc[4 + o4 * 4 + 3] += tt[j] * w4.w; }
            }
        }
#pragma unroll
        for (int o = 0; o < 36; ++o) acc[o] = wave_sum(acc[o]);
        float gl[4]; int gs = 0;
#pragma unroll
        for (int g = 0; g < 4; ++g) gl[g] = acc[g] + bgr[g];
        float gmax = gl[0];
#pragma unroll
        for (int g = 1; g < 4; ++g) if (gl[g] > gmax) { gmax = gl[g]; gs = g; }
        float gsum = 0.f;
#pragma unroll
        for (int g = 0; g < 4; ++g) gsum += expf(gl[g] - gmax);
        const float gw = 1.0f / gsum;
        float el[8];
#pragma unroll
        for (int j = 0; j < 8; ++j) { float vsel = acc[4 + j];
#pragma unroll
            for (int g = 1; g < 4; ++g) vsel = (gs == g) ? acc[4 + g * 8 + j] : vsel;
            el[j] = vsel + ber[gs * 8 + j]; }
        int i0 = 0; float v0 = el[0];
#pragma unroll
        for (int j = 1; j < 8; ++j) if (el[j] > v0) { v0 = el[j]; i0 = j; }
        int i1 = -1; float v1 = -3.0e38f;
#pragma unroll
        for (int j = 0; j < 8; ++j) if (j != i0 && (i1 < 0 || el[j] > v1)) { v1 = el[j]; i1 = j; }
        const float ex = expf(v1 - v0), w0 = gw / (1.0f + ex), w1 = gw * ex / (1.0f + ex);
        if (lane == 0) {
            const int e0 = gs * 8 + i0, e1 = gs * 8 + i1;
            tok_e[row * 2] = e0; tok_e[row * 2 + 1] = e1; tok_w[row * 2] = w0; tok_w[row * 2 + 1] = w1;
            tok_p[row * 2] = (int)atomicAdd(&cnt[e0], 1u); tok_p[row * 2 + 1] = (int)atomicAdd(&cnt[e1], 1u);
        }
    }
}

__global__ void __launch_bounds__(256) k_route_assign(unsigned char* ws) {
    __shared__ int base[NE], cn[NE];
    const unsigned* cnt = (const unsigned*)(ws + OFF_CTL) + CW_CNT;
    const int* tok_e = (const int*)(ws + OFF_TOKE); const int* tok_p = (const int*)(ws + OFF_TOKP);
    int* tok_s = (int*)(ws + OFF_TOKS); int* slot_tok = (int*)(ws + OFF_SLOTTOK); int* tile_e = (int*)(ws + OFF_TILEE);
    if (threadIdx.x == 0) {
        int t = 0;
        for (int e = 0; e < NE; ++e) { const int c = (int)cnt[e]; cn[e] = c; base[e] = t * 256; const int nt = (c + 255) / 256;
            if (blockIdx.x == 0) for (int i = 0; i < nt; ++i) tile_e[t + i] = e;
            t += nt; }
        if (blockIdx.x == 0) tile_e[MAXT] = t;
    }
    __syncthreads();
    for (int i = blockIdx.x * blockDim.x + threadIdx.x; i < NTOK * 2; i += gridDim.x * blockDim.x) {
        const int s = base[tok_e[i]] + tok_p[i];
        tok_s[i] = s; slot_tok[s] = i >> 1;
    }
    if (blockIdx.x == 0) for (int e = 0; e < NE; ++e) { const int c = cn[e], end = ((c + 255) / 256) * 256; for (int j = c + threadIdx.x; j < end; j += blockDim.x) slot_tok[base[e] + j] = 0; }
}

__global__ void __launch_bounds__(256) k_final(const float* ln_g, const float* ln_b, float* out, unsigned char* ws) {
    const float* mod = (const float*)(ws + OFF_MOD); const bf16_t* y2 = (const bf16_t*)(ws + OFF_B);
    const int* tok_s = (const int*)(ws + OFF_TOKS); const float* tok_w = (const float*)(ws + OFF_TOKW);
    const int wid = threadIdx.x >> 6, lane = threadIdx.x & 63, nw = blockDim.x >> 6;
    for (int row = blockIdx.x * nw + wid; row < NTOK; row += gridDim.x * nw) {
        const float* m = mod + (row / L) * 6144 + 5120;
        const int s0 = tok_s[row * 2], s1 = tok_s[row * 2 + 1]; const float w0 = tok_w[row * 2], w1 = tok_w[row * 2 + 1];
        float v[16]; float s = 0.f;
#pragma unroll
        for (int i = 0; i < 4; ++i) {
            const int c = 4 * lane + 256 * i;
            const float4 a = *(const float4*)(out + (size_t)row * D + c), g = *(const float4*)(m + c);
            const uint2 r0 = *(const uint2*)(y2 + (size_t)s0 * D + c), r1 = *(const uint2*)(y2 + (size_t)s1 * D + c);
            const float f0 = w0 * bf2f((bf16_t)(r0.x & 0xffff)) + w1 * bf2f((bf16_t)(r1.x & 0xffff)), f1 = w0 * bf2f((bf16_t)(r0.x >> 16)) + w1 * bf2f((bf16_t)(r1.x >> 16));
            const float f2 = w0 * bf2f((bf16_t)(r0.y & 0xffff)) + w1 * bf2f((bf16_t)(r1.y & 0xffff)), f3 = w0 * bf2f((bf16_t)(r0.y >> 16)) + w1 * bf2f((bf16_t)(r1.y >> 16));
            v[4 * i + 0] = ALPHA * a.x + g.x * f0; v[4 * i + 1] = ALPHA * a.y + g.y * f1; v[4 * i + 2] = ALPHA * a.z + g.z * f2; v[4 * i + 3] = ALPHA * a.w + g.w * f3;
            s += (v[4 * i] + v[4 * i + 1]) + (v[4 * i + 2] + v[4 * i + 3]);
        }
        const float mu = wave_sum(s) * (1.0f / 1024.0f);
        float q = 0.f;
#pragma unroll
        for (int j = 0; j < 16; ++j) { const float d = v[j] - mu; q += d * d; }
        const float rstd = rsqrtf(wave_sum(q) * (1.0f / 1024.0f) + EPS);
#pragma unroll
        for (int i = 0; i < 4; ++i) {
            const int c = 4 * lane + 256 * i;
            const float4 g = *(const float4*)(ln_g + c), bb = *(const float4*)(ln_b + c);
            float4 o;
            o.x = (v[4 * i + 0] - mu) * rstd * g.x + bb.x; o.y = (v[4 * i + 1] - mu) * rstd * g.y + bb.y; o.z = (v[4 * i + 2] - mu) * rstd * g.z + bb.z; o.w = (v[4 * i + 3] - mu) * rstd * g.w + bb.w;
            *(float4*)(out + (size_t)row * D + c) = o;
        }
    }
}

extern "C" void kernel_launch(void* const* d_in, const int* in_sizes, int n_in, void* d_out, int out_size, void* d_ws, size_t ws_size, hipStream_t stream) {
    (void)in_sizes; (void)n_in; (void)out_size;
    if (ws_size < WS_END) { fprintf(stderr, "workspace too small: %zu < %zu\n", ws_size, (size_t)WS_END); return; }
    const float* x = (const float*)d_in[0]; const float* c = (const float*)d_in[1]; const float* ctx = (const float*)d_in[2]; const float* c_ctx = (const float*)d_in[3];
    const float* w_mod = (const float*)d_in[4]; const float* b_mod = (const float*)d_in[5]; const float* w_in = (const float*)d_in[6];
    const float* lq1 = (const float*)d_in[7]; const float* lk1 = (const float*)d_in[8]; const float* lq2 = (const float*)d_in[9]; const float* lk2 = (const float*)d_in[10];
    const float* subln_g = (const float*)d_in[11]; const float* sg_ln_g = (const float*)d_in[12]; const float* sg_ln_b = (const float*)d_in[13];
    const float* sg_w = (const float*)d_in[14]; const float* sg_b = (const float*)d_in[15]; const float* w_out = (const float*)d_in[16];
    const float* ln1_g = (const float*)d_in[17]; const float* ln1_b = (const float*)d_in[18];
    const float* rgw = (const float*)d_in[19]; const float* rgb = (const float*)d_in[20]; const float* rew = (const float*)d_in[21]; const float* reb = (const float*)d_in[22];
    const float* ewg = (const float*)d_in[23]; const float* ewu = (const float*)d_in[24]; const float* ewd = (const float*)d_in[25];
    const float* ln2_g = (const float*)d_in[26]; const float* ln2_b = (const float*)d_in[27];
    unsigned char* ws = (unsigned char*)d_ws; float* out = (float*)d_out;

    hipMemsetAsync(ws + OFF_CTL, 0, 65536, stream);
    k_prep<<<1, 256, 0, stream>>>(lq1, lk1, lq2, lk2, ws);
    static bool attr = false;
    if (!attr) { hipFuncSetAttribute((const void*)k_mod, hipFuncAttributeMaxDynamicSharedMemorySize, 96 * 1024); attr = true; }
    k_mod<<<192, 256, (17 * 1024 + 8 * 17 * 32) * 4, stream>>>(c, c_ctx, w_mod, b_mod, ws);
    k_conv<<<2048, 256, 0, stream>>>(w_in, w_out, sg_w, ewg, ewu, ewd, ws);
    k_modulate<<<2048, 256, 0, stream>>>(x, ctx, ws);
    { EpiIn e{ws, 0}; k_gemm_naive<0, EpiIn><<<(NTOK / 64) * (INC / 64), 256, 0, stream>>>((const bf16_t*)(ws + OFF_A), (const bf16_t*)(ws + OFF_WIN), NTOK, INC, D, 0, e, ws); }
    { EpiIn e{ws, 1}; k_gemm_naive<0, EpiIn><<<(NCTX / 64) * (1024 / 64), 256, 0, stream>>>((const bf16_t*)(ws + OFF_A + 128 * MiB), (const bf16_t*)(ws + OFF_WIN), NCTX, 1024, D, 512, e, ws); }
    k_sg_ln<<<2048, 256, 0, stream>>>(sg_ln_g, sg_ln_b, ws);
    k_sg_mix<<<4096, 256, 0, stream>>>(sg_b, ws);
    k_attn_naive<<<NTOK * 4 / 2, 128, 0, stream>>>(subln_g, ws);
    { EpiY e{(float*)(ws + OFF_A)}; k_gemm_naive<0, EpiY><<<(NTOK / 64) * (D / 64), 256, 0, stream>>>((const bf16_t*)(ws + OFF_C), (const bf16_t*)(ws + OFF_WOUT), NTOK, D, D, 0, e, ws); }
    k_ln1_router<<<2048, 256, 0, stream>>>(x, ln1_g, ln1_b, rgw, rgb, rew, reb, out, ws);
    k_route_assign<<<256, 256, 0, stream>>>(ws);
    { EpiHid e{(bf16_t*)(ws + OFF_A)}; k_gemm_naive<1, EpiHid><<<(PMAX / 64) * (D / 64), 256, 0, stream>>>((const bf16_t*)(ws + OFF_C), (const bf16_t*)(ws + OFF_WGU), PMAX, D, D, 0, e, ws); }
    { EpiY2 e{(bf16_t*)(ws + OFF_B)}; k_gemm_naive<2, EpiY2><<<(PMAX / 64) * (D / 64), 256, 0, stream>>>((const bf16_t*)(ws + OFF_A), (const bf16_t*)(ws + OFF_WD), PMAX, D, D, 0, e, ws); }
    k_final<<<2048, 256, 0, stream>>>(ln2_g, ln2_b, out, ws);
}
```

```cpp
#include <hip/hip_runtime.h>
#include <cstdint>
#include <cstdio>

typedef unsigned short bf16_t;
#define DEV __device__ __forceinline__

namespace cfg {
constexpr int B = 16, L = 2048, D = 1024, NTOK = B * L, CTX = 256, NCTX = B * CTX, KEYS = L + CTX;
constexpr int INC = 2560, NE = 32, PMAX = 73728, MAXT = 288;
constexpr float EPS = 1e-5f, ALPHA = 1.189207115002721f, LAM_INIT = 0.2f;
constexpr size_t MiB = 1048576;
constexpr size_t OFF_CTL = 0;
constexpr size_t OFF_MOD = 65536;
constexpr size_t OFF_ROPE = OFF_MOD + 17 * 6144 * 4;
constexpr size_t OFF_LAM = OFF_ROPE + 8192;
constexpr size_t OFF_TOKE = OFF_LAM + 256;
constexpr size_t OFF_TOKP = OFF_TOKE + 262144;
constexpr size_t OFF_TOKW = OFF_TOKP + 262144;
constexpr size_t OFF_TOKS = OFF_TOKW + 262144;
constexpr size_t OFF_SLOTTOK = OFF_TOKS + 262144;
constexpr size_t OFF_TILEE = OFF_SLOTTOK + PMAX * 4;
constexpr size_t OFF_WIN = 2 * MiB;
constexpr size_t OFF_WOUT = 7 * MiB;
constexpr size_t OFF_SGW = 9 * MiB;
constexpr size_t OFF_WGU = 10 * MiB;
constexpr size_t OFF_WD = 138 * MiB;
constexpr size_t OFF_A = 202 * MiB;
constexpr size_t OFF_B = 346 * MiB;
constexpr size_t OFF_C = 490 * MiB;
constexpr size_t WS_END = 554 * MiB;
constexpr int CW_CNT = 4096;
}
using namespace cfg;

DEV bf16_t f2bf(float f) { unsigned u = __float_as_uint(f); u += 0x7fffu + ((u >> 16) & 1u); return (bf16_t)(u >> 16); }
DEV float bf2f(bf16_t h) { return __uint_as_float(((unsigned)h) << 16); }
DEV unsigned pack2(float lo, float hi) { return (unsigned)f2bf(lo) | ((unsigned)f2bf(hi) << 16); }
DEV float wave_sum(float v) { for (int o = 32; o; o >>= 1) v += __shfl_xor(v, o); return v; }
DEV float wave_max(float v) { for (int o = 32; o; o >>= 1) v = fmaxf(v, __shfl_xor(v, o)); return v; }
DEV float silu_f(float x) { return x / (1.0f + __expf(-x)); }
DEV float gelu_f(float x) { return 0.5f * x * (1.0f + erff(x * 0.70710678118654752f)); }

__global__ void k_prep(const float* lq1, const float* lk1, const float* lq2, const float* lk2, unsigned char* ws) {
    float* rope = (float*)(ws + OFF_ROPE);
    for (int t = threadIdx.x; t < 1024; t += blockDim.x) {
        const int pos = t >> 4, j = t & 15;
        const float inv = powf(10000.0f, -(float)j / 16.0f);
        const float ang = (float)pos * inv;
        rope[2 * t] = cosf(ang); rope[2 * t + 1] = sinf(ang);
    }
    if (threadIdx.x < 64) {
        const int l = threadIdx.x;
        const float a = wave_sum(lq1[l] * lk1[l]), b = wave_sum(lq2[l] * lk2[l]);
        if (l == 0) *(float*)(ws + OFF_LAM) = expf(a) - expf(b) + LAM_INIT;
    }
}

__global__ void __launch_bounds__(256) k_mod(const float* c, const float* c_ctx, const float* w_mod, const float* b_mod, unsigned char* ws) {
    extern __shared__ float sv[];
    for (int i = threadIdx.x; i < 17 * 1024; i += blockDim.x) { const float v = i < 16384 ? c[i] : c_ctx[i - 16384]; sv[i] = silu_f(v); }
    __syncthreads();
    float* mod = (float*)(ws + OFF_MOD);
    const int col = threadIdx.x & 31, kg = threadIdx.x >> 5, nkg = blockDim.x >> 5, dper = 1024 / nkg;
    for (int u = blockIdx.x; u < 192; u += gridDim.x) {
        const int e = u * 32 + col;
        float acc[17];
#pragma unroll
        for (int r = 0; r < 17; ++r) acc[r] = 0.f;
        for (int d = kg * dper; d < (kg + 1) * dper; ++d) {
            const float w = w_mod[(size_t)d * 6144 + e];
#pragma unroll
            for (int r = 0; r < 17; ++r) acc[r] += sv[r * 1024 + d] * w;
        }
        __syncthreads();
        float* red = sv + 17 * 1024;
#pragma unroll
        for (int r = 0; r < 17; ++r) red[(kg * 17 + r) * 32 + col] = acc[r];
        __syncthreads();
        for (int i = threadIdx.x; i < 17 * 32; i += blockDim.x) {
            const int r = i >> 5, cc = i & 31; float s = 0.f;
            for (int g = 0; g < nkg; ++g) s += red[(g * 17 + r) * 32 + cc];
            mod[r * 6144 + u * 32 + cc] = s + b_mod[u * 32 + cc];
        }
        __syncthreads();
    }
}

DEV void conv_tile(const float* src, int ldn, int k0, int n0, bf16_t* dst, int ldk, int rbase, int rstride, float* tile  ) {
    const int tid = threadIdx.x;
    for (int i = tid; i < 64 * 16; i += blockDim.x) {
        const int r = i >> 4, c4 = i & 15;
        const float4 v = *(const float4*)(src + (size_t)(k0 + r) * ldn + n0 + c4 * 4);
        tile[r * 65 + c4 * 4 + 0] = v.x; tile[r * 65 + c4 * 4 + 1] = v.y; tile[r * 65 + c4 * 4 + 2] = v.z; tile[r * 65 + c4 * 4 + 3] = v.w;
    }
    __syncthreads();
    for (int i = tid; i < 64 * 8; i += blockDim.x) {
        const int n = i >> 3, kc = (i & 7) * 8, nn = n0 + n;
        const int row = rbase + (nn >> 7) * rstride + (nn & 127);
        uint4 o;
        o.x = pack2(tile[(kc + 0) * 65 + n], tile[(kc + 1) * 65 + n]); o.y = pack2(tile[(kc + 2) * 65 + n], tile[(kc + 3) * 65 + n]);
        o.z = pack2(tile[(kc + 4) * 65 + n], tile[(kc + 5) * 65 + n]); o.w = pack2(tile[(kc + 6) * 65 + n], tile[(kc + 7) * 65 + n]);
        *(uint4*)(dst + (size_t)row * ldk + k0 + kc) = o;
    }
    __syncthreads();
}
__global__ void __launch_bounds__(256) k_conv(const float* w_in, const float* w_out, const float* sg_w, const float* wg, const float* wu, const float* wd, unsigned char* ws) {
    __shared__ float tile[64 * 65];
    bf16_t* WinT = (bf16_t*)(ws + OFF_WIN); bf16_t* WoutT = (bf16_t*)(ws + OFF_WOUT); bf16_t* SgW = (bf16_t*)(ws + OFF_SGW);
    bf16_t* WguT = (bf16_t*)(ws + OFF_WGU); bf16_t* WdT = (bf16_t*)(ws + OFF_WD);
    constexpr int U_IN = 16 * 40, U_OUT = 16 * 16, U_E = 32 * 256;
    constexpr int TOT = U_IN + U_OUT + 3 * U_E;
    for (int u = blockIdx.x; u < TOT; u += gridDim.x) {
        int v = u;
        if (v < U_IN) { conv_tile(w_in, 2560, (v % 16) * 64, (v / 16) * 64, WinT, 1024, 0, 128, tile); continue; }
        v -= U_IN;
        if (v < U_OUT) { conv_tile(w_out, 1024, (v % 16) * 64, (v / 16) * 64, WoutT, 1024, 0, 128, tile); continue; }
        v -= U_OUT;
        const int which = v / U_E, w = v % U_E, e = w / 256, t = w % 256, k0 = (t % 16) * 64, n0 = (t / 16) * 64;
        if (which == 0) conv_tile(wg + (size_t)e * 1048576, 1024, k0, n0, WguT + (size_t)e * 2048 * 1024, 1024, 0, 256, tile);
        else if (which == 1) conv_tile(wu + (size_t)e * 1048576, 1024, k0, n0, WguT + (size_t)e * 2048 * 1024, 1024, 128, 256, tile);
        else conv_tile(wd + (size_t)e * 1048576, 1024, k0, n0, WdT + (size_t)e * 1024 * 1024, 1024, 0, 128, tile);
    }
    for (int i = blockIdx.x * blockDim.x + threadIdx.x; i < 65536 / 4; i += gridDim.x * blockDim.x) {
        const float4 v = *(const float4*)(sg_w + i * 4);
        uint2 o; o.x = pack2(v.x, v.y); o.y = pack2(v.z, v.w);
        *(uint2*)(SgW + i * 4) = o;
    }
}

__global__ void __launch_bounds__(256) k_modulate(const float* x, const float* ctx, unsigned char* ws) {
    const float* mod = (const float*)(ws + OFF_MOD);
    bf16_t* h = (bf16_t*)(ws + OFF_A); bf16_t* hc = (bf16_t*)(ws + OFF_A + 128 * MiB);
    const size_t n8 = (size_t)(NTOK + NCTX) * 128;
    for (size_t i = (size_t)blockIdx.x * blockDim.x + threadIdx.x; i < n8; i += (size_t)gridDim.x * blockDim.x) {
        const int row = (int)(i >> 7), c = (int)(i & 127) * 8;
        const float* src; bf16_t* dst; const float* m;
        if (row < NTOK) { src = x + (size_t)row * D + c; dst = h + (size_t)row * D + c; m = mod + (row / L) * 6144; }
        else { const int r = row - NTOK; src = ctx + (size_t)r * D + c; dst = hc + (size_t)r * D + c; m = mod + 16 * 6144; }
        const float4 a = *(const float4*)src, b = *(const float4*)(src + 4);
        const float4 s0 = *(const float4*)(m + c), s1 = *(const float4*)(m + c + 4);
        const float4 t0 = *(const float4*)(m + 1024 + c), t1 = *(const float4*)(m + 1024 + c + 4);
        uint4 o;
        o.x = pack2(a.x * (1.f + t0.x) + s0.x, a.y * (1.f + t0.y) + s0.y); o.y = pack2(a.z * (1.f + t0.z) + s0.z, a.w * (1.f + t0.w) + s0.w);
        o.z = pack2(b.x * (1.f + t1.x) + s1.x, b.y * (1.f + t1.y) + s1.y); o.w = pack2(b.z * (1.f + t1.z) + s1.z, b.w * (1.f + t1.w) + s1.w);
        *(uint4*)dst = o;
    }
}

struct EpiIn {
    unsigned char* ws; int ctx;
    DEV void operator()(int row, int col0, int tx, const float (&v)[4], const float (&)[4]) const {
        const float* rope = (const float*)(ws + OFF_ROPE);
        bf16_t* qb = (bf16_t*)(ws + OFF_B); bf16_t* kb = (bf16_t*)(ws + OFF_B + 32 * MiB); bf16_t* vb = (bf16_t*)(ws + OFF_B + 68 * MiB);
        bf16_t* zb = (bf16_t*)(ws + OFF_A + 64 * MiB);
        int c0 = col0; size_t krow;
        if (ctx) { c0 += 512; krow = (size_t)(row / CTX) * KEYS + L + (row % CTX); }
        else krow = (size_t)(row / L) * KEYS + (row % L);
        if (c0 < 1024) {
            float o[4] = {v[0], v[1], v[2], v[3]};
            if (!ctx) {
                const int l = row % L, p0 = l >> 6, p1 = l & 63;
                const float sc = c0 < 512 ? 0.125f : 1.0f;
                const float cA = rope[(p0 * 16 + tx) * 2], sA = rope[(p0 * 16 + tx) * 2 + 1], cB = rope[(p1 * 16 + tx) * 2], sB = rope[(p1 * 16 + tx) * 2 + 1];
                o[0] = (v[0] * cA - v[1] * sA) * sc; o[1] = (v[1] * cA + v[0] * sA) * sc;
                o[2] = (v[2] * cB - v[3] * sB) * sc; o[3] = (v[3] * cB + v[2] * sB) * sc;
            }
            if (c0 < 512) { bf16_t* dst = qb + (size_t)(c0 >> 8) * ((size_t)NTOK * 256) + (size_t)row * 256 + (c0 & 255) + tx;
#pragma unroll
                for (int j = 0; j < 4; ++j) dst[16 * j] = f2bf(o[j]); }
            else { bf16_t* dst = kb + (size_t)((c0 - 512) >> 8) * ((size_t)B * KEYS * 256) + krow * 256 + (c0 & 255) + tx;
#pragma unroll
                for (int j = 0; j < 4; ++j) dst[16 * j] = f2bf(o[j]); }
        } else if (c0 < 1536) {
            bf16_t* dst = vb + krow * 512 + (c0 - 1024) + tx;
#pragma unroll
            for (int j = 0; j < 4; ++j) dst[16 * j] = f2bf(v[j]);
        } else {
            bf16_t* dst = zb + (size_t)row * 1024 + (c0 - 1536) + tx;
#pragma unroll
            for (int j = 0; j < 4; ++j) dst[16 * j] = f2bf(gelu_f(v[j]));
        }
    }
};
struct EpiY {
    float* y;
    DEV void operator()(int row, int col0, int tx, const float (&v)[4], const float (&)[4]) const {
#pragma unroll
        for (int j = 0; j < 4; ++j) y[(size_t)row * D + col0 + tx + 16 * j] = v[j];
    }
};
struct EpiHid {
    bf16_t* hid;
    DEV void operator()(int row, int col0, int tx, const float (&g)[4], const float (&u)[4]) const {
#pragma unroll
        for (int j = 0; j < 4; ++j) hid[(size_t)row * D + col0 + tx + 16 * j] = f2bf(silu_f(g[j]) * u[j]);
    }
};
struct EpiY2 {
    bf16_t* y2;
    DEV void operator()(int row, int col0, int tx, const float (&v)[4], const float (&)[4]) const {
#pragma unroll
        for (int j = 0; j < 4; ++j) y2[(size_t)row * D + col0 + tx + 16 * j] = f2bf(v[j]);
    }
};

template <int MODE, class Epi>
__global__ void __launch_bounds__(256) k_gemm_naive(const bf16_t* A, const bf16_t* Bt, int M, int N, int K, int brow0, Epi epi, const unsigned char* ws) {
    __shared__ float As[16][64 + 4], Bs[16][64 + 4], B2s[16][64 + 4];
    const int ntn = N / 64;
    const int mt = blockIdx.x / ntn, nt = blockIdx.x % ntn;
    const int tid = threadIdx.x, tx = tid & 15, ty = tid >> 4;
    const int* slot_tok = (const int*)(ws + OFF_SLOTTOK); const int* tile_e = (const int*)(ws + OFF_TILEE);
    int e = 0;
    if (MODE != 0) { const int ntiles = tile_e[MAXT]; if (mt / 4 >= ntiles) return; e = tile_e[mt / 4]; }
    const int lr = tid >> 2, lk = (tid & 3) * 4;
    size_t arow = (size_t)(mt * 64 + lr);
    if (MODE == 1) arow = (size_t)slot_tok[mt * 64 + lr];
    const bf16_t* ap = A + arow * K + lk;
    const int bc = nt * 64 + lr;
    size_t brow;
    if (MODE == 0) brow = (size_t)(brow0 + bc);
    else if (MODE == 1) brow = (size_t)e * 2048 + (bc >> 7) * 256 + (bc & 127);
    else brow = (size_t)e * 1024 + bc;
    const bf16_t* bp = Bt + brow * K + lk;
    float acc[4][4], acc2[4][4];
#pragma unroll
    for (int i = 0; i < 4; ++i)
#pragma unroll
        for (int j = 0; j < 4; ++j) { acc[i][j] = 0.f; acc2[i][j] = 0.f; }
    for (int k0 = 0; k0 < K; k0 += 16) {
        const uint2 av = *(const uint2*)(ap + k0), bv = *(const uint2*)(bp + k0);
        As[lk + 0][lr] = bf2f((bf16_t)(av.x & 0xffff)); As[lk + 1][lr] = bf2f((bf16_t)(av.x >> 16)); As[lk + 2][lr] = bf2f((bf16_t)(av.y & 0xffff)); As[lk + 3][lr] = bf2f((bf16_t)(av.y >> 16));
        Bs[lk + 0][lr] = bf2f((bf16_t)(bv.x & 0xffff)); Bs[lk + 1][lr] = bf2f((bf16_t)(bv.x >> 16)); Bs[lk + 2][lr] = bf2f((bf16_t)(bv.y & 0xffff)); Bs[lk + 3][lr] = bf2f((bf16_t)(bv.y >> 16));
        if (MODE == 1) { const uint2 cv = *(const uint2*)(bp + (size_t)128 * K + k0);
            B2s[lk + 0][lr] = bf2f((bf16_t)(cv.x & 0xffff)); B2s[lk + 1][lr] = bf2f((bf16_t)(cv.x >> 16)); B2s[lk + 2][lr] = bf2f((bf16_t)(cv.y & 0xffff)); B2s[lk + 3][lr] = bf2f((bf16_t)(cv.y >> 16)); }
        __syncthreads();
#pragma unroll
        for (int k = 0; k < 16; ++k) {
            float a[4], b[4], b2[4];
#pragma unroll
            for (int i = 0; i < 4; ++i) a[i] = As[k][ty * 4 + i];
#pragma unroll
            for (int j = 0; j < 4; ++j) { b[j] = Bs[k][tx + 16 * j]; if (MODE == 1) b2[j] = B2s[k][tx + 16 * j]; }
#pragma unroll
            for (int i = 0; i < 4; ++i)
#pragma unroll
                for (int j = 0; j < 4; ++j) { acc[i][j] += a[i] * b[j]; if (MODE == 1) acc2[i][j] += a[i] * b2[j]; }
        }
        __syncthreads();
    }
#pragma unroll
    for (int i = 0; i < 4; ++i) epi(mt * 64 + ty * 4 + i, nt * 64, tx, acc[i], acc2[i]);
}


namespace pg8 {
#define PG8_LAS __attribute__((address_space(3)))
typedef short bf16x8 __attribute__((ext_vector_type(8)));
typedef float f32x4 __attribute__((ext_vector_type(4)));
typedef float f32x2 __attribute__((ext_vector_type(2)));
typedef unsigned u32x4 __attribute__((ext_vector_type(4)));
typedef unsigned u32x2 __attribute__((ext_vector_type(2)));
constexpr int BM = 256, BK = 64, HALF = 128, HTB = HALF * BK * 2, STAGE_BYTES = 8 * HTB, NXCD = 8, WGM = 8;
__host__ __device__ __forceinline__ int lds_byte(int r, int c) { const int st = (r >> 4) * 2 + (c >> 5), rr = r & 15, cc = c & 31, ob = rr * 64 + cc * 2; return st * 1024 + (ob ^ (((ob >> 9) & 1) << 5)); }
__host__ __device__ __forceinline__ void stage_rc(int b, int& R, int& C) { const int st = b / 1024, sb = b % 1024, swz = sb ^ (((sb >> 9) & 1) << 5); R = (st >> 1) * 16 + swz / 64; C = (st & 1) * 32 + (swz % 64) / 2; }
__host__ __device__ __forceinline__ int perm32(int rho) { const int n = rho >> 4, i = rho & 15; return 8 * (i >> 2) + 4 * n + (i & 3); }

struct Unit { int pm, pn, pb; };
struct Gemm { const bf16_t* A; const bf16_t* Bt; const int* rowmap; int K; };

struct TileOrder {
    int nM, nN, nwg, G, c;
    __device__ __forceinline__ void init(int nM_, int nN_, int G_, int c_) { nM = nM_; nN = nN_; nwg = nM * nN; G = G_; c = c_; }
    __device__ __forceinline__ bool map(int i, int& pm, int& pn) const {
        const long L = (long)i * G + c; if (L >= nwg) return false;
        int wgid = (int)L; { const int q = nwg / NXCD, r = nwg % NXCD, xcd = wgid % NXCD, off = wgid / NXCD; wgid = (xcd < r ? xcd * (q + 1) : r * (q + 1) + (xcd - r) * q) + off; }
        const int nig = WGM * nN, gid = wgid / nig, fm = gid * WGM, gsz = (nM - fm) < WGM ? (nM - fm) : WGM;
        pm = fm + ((wgid % nig) % gsz); pn = (wgid % nig) / gsz; return true;
    }
};
struct PlainOrder : TileOrder {
    int pb0;
    __device__ __forceinline__ bool next(int i, Unit& u) const { if (!map(i, u.pm, u.pn)) return false; u.pb = pb0 + u.pn; return true; }
};
struct MoeOrder : TileOrder {
    const int* tile_e; int tpe;
    __device__ __forceinline__ bool next(int i, Unit& u) const { if (!map(i, u.pm, u.pn)) return false; u.pb = tile_e[u.pm] * tpe + u.pn; return true; }
};

__device__ __forceinline__ unsigned cvt_pk_bf16(float lo, float hi) { unsigned r; asm volatile("v_cvt_pk_bf16_f32 %0, %1, %2" : "=v"(r) : "v"(lo), "v"(hi)); return r; }
__device__ __forceinline__ f32x2 gelu_pk(f32x2 v) {
    const f32x2 av = __builtin_elementwise_abs(v), d = av * 0.2316418882f + 1.0f;
    f32x2 t; t.x = __builtin_amdgcn_rcpf(d.x); t.y = __builtin_amdgcn_rcpf(d.y);
    f32x2 q = t * 0.5307027145f + (-0.7265760135f); q = q * t + 0.7107068705f; q = q * t + (-0.142248368f); q = q * t + 0.127414796f; q = q * t;
    const f32x2 s = (v * v) * (-0.72134752044f);
    f32x2 e; e.x = __builtin_amdgcn_exp2f(s.x); e.y = __builtin_amdgcn_exp2f(s.y);
    const f32x2 m = v * (q * e), r = v - m;
    f32x2 o; o.x = v.x < 0.f ? m.x : r.x; o.y = v.y < 0.f ? m.y : r.y; return o;
}

struct EpiInProj {
    static constexpr bool PERM = false;
    unsigned char* ws; int ctx; int pad;
    __device__ __forceinline__ void operator()(const f32x4 (&acc)[2][2][4][2], const Unit& u, int wr, int wc, int fr, int fq) const {
        const float* rope = (const float*)(ws + OFF_ROPE);
        bf16_t* qb = (bf16_t*)(ws + OFF_B); bf16_t* kb = (bf16_t*)(ws + OFF_B + 32 * MiB); bf16_t* vb = (bf16_t*)(ws + OFF_B + 68 * MiB); bf16_t* zb = (bf16_t*)(ws + OFF_A + 64 * MiB);
        const int gc0 = (ctx ? 512 : 0) + u.pn * BM;
#pragma unroll
        for (int ai = 0; ai < 2; ++ai)
#pragma unroll
            for (int m = 0; m < 4; ++m) {
                const int r = u.pm * BM + ai * HALF + wr * 64 + m * 16 + fr;
                size_t krow; int l;
                if (ctx) { krow = (size_t)(r / CTX) * KEYS + L + (r % CTX); l = 0; } else { l = r % L; krow = (size_t)(r / L) * KEYS + l; }
#pragma unroll
                for (int bj = 0; bj < 2; ++bj) {
                    const int gc = gc0 + bj * HALF + wc * 32;
                    const f32x4 a0 = acc[ai][bj][m][0], a1 = acc[ai][bj][m][1];
                    if (gc < 1024) {
                        f32x4 lo = a0, hi = a1;
                        if (!ctx) {
                            const int pos = ((gc >> 5) & 1) ? (l & 63) : (l >> 6);
                            const float* rp = rope + (pos * 16 + 4 * fq) * 2;
                            const f32x4 c01 = *(const f32x4*)rp, c23 = *(const f32x4*)(rp + 4);
                            const float sc = gc < 512 ? 0.125f : 1.0f;
                            lo[0] = (a0[0] * c01[0] - a1[0] * c01[1]) * sc; hi[0] = (a1[0] * c01[0] + a0[0] * c01[1]) * sc;
                            lo[1] = (a0[1] * c01[2] - a1[1] * c01[3]) * sc; hi[1] = (a1[1] * c01[2] + a0[1] * c01[3]) * sc;
                            lo[2] = (a0[2] * c23[0] - a1[2] * c23[1]) * sc; hi[2] = (a1[2] * c23[0] + a0[2] * c23[1]) * sc;
                            lo[3] = (a0[3] * c23[2] - a1[3] * c23[3]) * sc; hi[3] = (a1[3] * c23[2] + a0[3] * c23[3]) * sc;
                        }
                        bf16_t* dst;
                        if (gc < 512) dst = qb + (size_t)(gc >> 8) * ((size_t)NTOK * 256) + (size_t)r * 256 + (gc & 255) + 4 * fq;
                        else dst = kb + (size_t)((gc - 512) >> 8) * ((size_t)B * KEYS * 256) + krow * 256 + (gc & 255) + 4 * fq;
                        u32x2 w0, w1; w0.x = cvt_pk_bf16(lo[0], lo[1]); w0.y = cvt_pk_bf16(lo[2], lo[3]); w1.x = cvt_pk_bf16(hi[0], hi[1]); w1.y = cvt_pk_bf16(hi[2], hi[3]);
                        *(u32x2*)dst = w0; *(u32x2*)(dst + 16) = w1;
                    } else if (gc < 1536) {
                        bf16_t* dst = vb + krow * 512 + (gc - 1024) + 4 * fq;
                        u32x2 w0, w1; w0.x = cvt_pk_bf16(a0[0], a0[1]); w0.y = cvt_pk_bf16(a0[2], a0[3]); w1.x = cvt_pk_bf16(a1[0], a1[1]); w1.y = cvt_pk_bf16(a1[2], a1[3]);
                        *(u32x2*)dst = w0; *(u32x2*)(dst + 16) = w1;
                    } else {
                        bf16_t* dst = zb + (size_t)r * 1024 + (gc - 1536) + 4 * fq;
                        const f32x2 g0 = gelu_pk((f32x2){a0[0], a0[1]}), g1 = gelu_pk((f32x2){a0[2], a0[3]}), g2 = gelu_pk((f32x2){a1[0], a1[1]}), g3 = gelu_pk((f32x2){a1[2], a1[3]});
                        u32x2 w0, w1; w0.x = cvt_pk_bf16(g0.x, g0.y); w0.y = cvt_pk_bf16(g1.x, g1.y); w1.x = cvt_pk_bf16(g2.x, g2.y); w1.y = cvt_pk_bf16(g3.x, g3.y);
                        *(u32x2*)dst = w0; *(u32x2*)(dst + 16) = w1;
                    }
                }
            }
    }
};
struct EpiF32 {
    static constexpr bool PERM = false;
    float* O; int ldc; int pad;
    __device__ __forceinline__ void operator()(const f32x4 (&acc)[2][2][4][2], const Unit& u, int wr, int wc, int fr, int fq) const {
#pragma unroll
        for (int ai = 0; ai < 2; ++ai)
#pragma unroll
            for (int m = 0; m < 4; ++m) { float* rowp = O + (size_t)(u.pm * BM + ai * HALF + wr * 64 + m * 16 + fr) * ldc + u.pn * BM + wc * 32 + 4 * fq;
#pragma unroll
                for (int bj = 0; bj < 2; ++bj)
#pragma unroll
                    for (int n = 0; n < 2; ++n) *(f32x4*)(rowp + bj * HALF + 16 * n) = acc[ai][bj][m][n]; }
    }
};
struct EpiGateUp {
    static constexpr bool PERM = true;
    bf16_t* O;
    __device__ __forceinline__ void operator()(const f32x4 (&acc)[2][2][4][2], const Unit& u, int wr, int wc, int fr, int fq) const {
#pragma unroll
        for (int ai = 0; ai < 2; ++ai)
#pragma unroll
            for (int m = 0; m < 4; ++m) { bf16_t* dst = O + (size_t)(u.pm * BM + ai * HALF + wr * 64 + m * 16 + fr) * D + u.pn * HALF + wc * 32 + 8 * fq;
                float h[8];
#pragma unroll
                for (int n = 0; n < 2; ++n)
#pragma unroll
                    for (int j = 0; j < 4; ++j) { const float g = acc[ai][0][m][n][j], up = acc[ai][1][m][n][j]; h[4 * n + j] = g * __builtin_amdgcn_rcpf(1.0f + __expf(-g)) * up; }
                u32x4 w; w.x = cvt_pk_bf16(h[0], h[1]); w.y = cvt_pk_bf16(h[2], h[3]); w.z = cvt_pk_bf16(h[4], h[5]); w.w = cvt_pk_bf16(h[6], h[7]);
                *(u32x4*)dst = w; }
    }
};
struct EpiBf16 {
    static constexpr bool PERM = true;
    bf16_t* O; int ldc; int pad;
    __device__ __forceinline__ void operator()(const f32x4 (&acc)[2][2][4][2], const Unit& u, int wr, int wc, int fr, int fq) const {
#pragma unroll
        for (int ai = 0; ai < 2; ++ai)
#pragma unroll
            for (int m = 0; m < 4; ++m) { bf16_t* rowp = O + (size_t)(u.pm * BM + ai * HALF + wr * 64 + m * 16 + fr) * ldc + u.pn * BM + wc * 32 + 8 * fq;
#pragma unroll
                for (int bj = 0; bj < 2; ++bj) { const f32x4 v0 = acc[ai][bj][m][0], v1 = acc[ai][bj][m][1];
                    u32x4 w; w.x = cvt_pk_bf16(v0[0], v0[1]); w.y = cvt_pk_bf16(v0[2], v0[3]); w.z = cvt_pk_bf16(v1[0], v1[1]); w.w = cvt_pk_bf16(v1[2], v1[3]);
                    *(u32x4*)(rowp + bj * HALF) = w; } }
    }
};

template <class Epi, class Sched, bool GATHER>
__device__ __forceinline__ void gemm_phase(PG8_LAS unsigned char* lds, const Gemm g, const Sched& S, const Epi& E) {
    const int tid = threadIdx.x, wid = __builtin_amdgcn_readfirstlane(tid >> 6), lane = tid & 63, wr = wid >> 2, wc = wid & 3, fr = lane & 15, fq = lane >> 4;
    const int K = g.K, nt = K / BK;
    int RA[2]; unsigned colA[2], voffB[2];
#pragma unroll
    for (int i = 0; i < 2; ++i) { int R, C; stage_rc(tid * 16 + i * 8192, R, C); const int Rb = Epi::PERM ? ((R & ~31) + perm32(R & 31)) : R;
        RA[i] = R; colA[i] = (unsigned)C * 2u; voffB[i] = (unsigned)(Rb * K + C) * 2u; }
    const size_t kstep = (size_t)(BK * 2);
    const size_t hstep = (size_t)HALF * K * 2;
    const size_t tstep = 2 * hstep;
    const unsigned ldsw = (unsigned)wid * 1024u;
    const int aoff = lds_byte(wr * 64 + fr, fq * 8), boff = lds_byte(wc * 32 + fr, fq * 8);
#define PG8_AOFF(u, off) do { _Pragma("unroll") for (int _h = 0; _h < 2; ++_h) _Pragma("unroll") for (int _i = 0; _i < 2; ++_i) { \
        int _row = (u).pm * BM + _h * HALF + RA[_i]; if (GATHER) _row = g.rowmap[_row]; (off)[_h][_i] = (unsigned)_row * (unsigned)(K * 2) + colA[_i]; } } while (0)
#define PG8_SA(b, h) (((b) * 2 + (h)) * HTB)
#define PG8_SB(b, h) ((4 + (b) * 2 + (h)) * HTB)
#define PG8_STAGE(bufoff, gbase, voff) do { _Pragma("unroll") for (int _i = 0; _i < 2; ++_i) \
        __builtin_amdgcn_global_load_lds((const unsigned*)((const char*)(gbase) + (voff)[_i]), (PG8_LAS unsigned*)(lds + (bufoff) + ldsw + _i * 8192), 16, 0, 0); } while (0)
#define PG8_LDA(dst, b, h) do { _Pragma("unroll") for (int m = 0; m < 4; ++m) _Pragma("unroll") for (int k = 0; k < 2; ++k) dst[m][k] = *(const PG8_LAS bf16x8*)(lds + PG8_SA(b, h) + aoff + m * 2048 + k * 1024); } while (0)
#define PG8_LDB(dst, b, h) do { _Pragma("unroll") for (int n = 0; n < 2; ++n) _Pragma("unroll") for (int k = 0; k < 2; ++k) dst[n][k] = *(const PG8_LAS bf16x8*)(lds + PG8_SB(b, h) + boff + n * 2048 + k * 1024); } while (0)
#define PG8_MMA(ai, bj, At, Bt) do { __builtin_amdgcn_s_setprio(1); _Pragma("unroll") for (int m = 0; m < 4; ++m) _Pragma("unroll") for (int n = 0; n < 2; ++n) _Pragma("unroll") for (int k = 0; k < 2; ++k) \
        acc[ai][bj][m][n] = __builtin_amdgcn_mfma_f32_16x16x32_bf16(Bt[n][k], At[m][k], acc[ai][bj][m][n], 0, 0, 0); __builtin_amdgcn_s_setprio(0); } while (0)
#define PG8_WAIT_V(n) asm volatile("s_waitcnt vmcnt(" #n ")" ::: "memory")
#define PG8_WAIT_L(n) asm volatile("s_waitcnt lgkmcnt(" #n ")" ::: "memory")
#define PG8_BAR __builtin_amdgcn_s_barrier()
#define PG8_SCHED __builtin_amdgcn_sched_barrier(0)
    Unit cur, nxt; int ui = 0;
    if (!S.next(0, cur)) return;
    f32x4 acc[2][2][4][2];
#pragma unroll
    for (int a = 0; a < 2; ++a)
#pragma unroll
        for (int b = 0; b < 2; ++b)
#pragma unroll
            for (int m = 0; m < 4; ++m)
#pragma unroll
                for (int n = 0; n < 2; ++n) acc[a][b][m][n] = (f32x4){0.f, 0.f, 0.f, 0.f};
    bf16x8 At[4][2], B0[2][2], B1[2][2];
    const char* Ab = (const char*)g.A;
    unsigned offc[2][2], offn[2][2];
    PG8_AOFF(cur, offc);
    const char* cB = (const char*)g.Bt + (size_t)cur.pb * tstep;
    PG8_STAGE(PG8_SB(0, 0), cB, voffB); PG8_STAGE(PG8_SB(0, 1), cB + hstep, voffB); PG8_STAGE(PG8_SA(0, 0), Ab, offc[0]); PG8_STAGE(PG8_SA(0, 1), Ab, offc[1]);
    if (wr == 1) PG8_BAR;
    PG8_WAIT_V(2); PG8_BAR;
    PG8_STAGE(PG8_SB(1, 0), cB + kstep, voffB); PG8_STAGE(PG8_SA(1, 0), Ab + kstep, offc[0]); PG8_STAGE(PG8_SB(1, 1), cB + hstep + kstep, voffB);
    PG8_WAIT_V(6); PG8_BAR;
    for (;;) {
        const bool has_next = S.next(ui + 1, nxt);
        if (has_next) { PG8_AOFF(nxt, offn); }
        else {
#pragma unroll
            for (int h = 0; h < 2; ++h)
#pragma unroll
                for (int i = 0; i < 2; ++i) offn[h][i] = offc[h][i];
        }
        const char* nB = has_next ? (const char*)g.Bt + (size_t)nxt.pb * tstep : cB;
        for (int t = 0; t < nt; t += 2) {
            const bool last = (t == nt - 2);
            const char* a1 = Ab + (size_t)(t + 1) * kstep;
            const char* a2 = Ab + (last ? (size_t)0 : (size_t)(t + 2) * kstep); const char* b2 = last ? nB : cB + (size_t)(t + 2) * kstep;
            const char* a3 = a2 + kstep; const char* b3 = b2 + kstep;
            unsigned o2[2][2];
#pragma unroll
            for (int h = 0; h < 2; ++h)
#pragma unroll
                for (int i = 0; i < 2; ++i) o2[h][i] = last ? offn[h][i] : offc[h][i];
            PG8_LDB(B0, 0, 0); PG8_LDB(B1, 0, 1); PG8_SCHED; PG8_LDA(At, 0, 0); PG8_STAGE(PG8_SA(1, 1), a1, offc[1]);
            PG8_WAIT_V(8); PG8_WAIT_L(0); PG8_BAR; PG8_MMA(0, 0, At, B0); PG8_MMA(0, 1, At, B1); PG8_BAR; PG8_SCHED;
            PG8_LDA(At, 0, 1); PG8_STAGE(PG8_SB(0, 0), b2, voffB); PG8_STAGE(PG8_SB(0, 1), b2 + hstep, voffB); PG8_STAGE(PG8_SA(0, 0), a2, o2[0]);
            PG8_WAIT_V(8); PG8_WAIT_L(0); PG8_BAR; PG8_MMA(1, 0, At, B0); PG8_MMA(1, 1, At, B1); PG8_BAR; PG8_SCHED;
            PG8_LDB(B0, 1, 0); PG8_LDB(B1, 1, 1); PG8_SCHED; PG8_LDA(At, 1, 0); PG8_STAGE(PG8_SA(0, 1), a2, o2[1]);
            PG8_WAIT_V(8); PG8_WAIT_L(0); PG8_BAR; PG8_MMA(0, 0, At, B0); PG8_MMA(0, 1, At, B1); PG8_BAR; PG8_SCHED;
            PG8_LDA(At, 1, 1); PG8_STAGE(PG8_SB(1, 0), b3, voffB); PG8_STAGE(PG8_SB(1, 1), b3 + hstep, voffB); PG8_STAGE(PG8_SA(1, 0), a3, o2[0]);
            PG8_WAIT_V(8); PG8_WAIT_L(0); PG8_BAR; PG8_MMA(1, 0, At, B0); PG8_MMA(1, 1, At, B1); PG8_BAR; PG8_SCHED;
        }
        if (wr == 0) PG8_BAR;
        E(acc, cur, wr, wc, fr, fq);
        if (!has_next) break;
#pragma unroll
        for (int a = 0; a < 2; ++a)
#pragma unroll
            for (int b = 0; b < 2; ++b)
#pragma unroll
                for (int m = 0; m < 4; ++m)
#pragma unroll
                    for (int n = 0; n < 2; ++n) acc[a][b][m][n] = (f32x4){0.f, 0.f, 0.f, 0.f};
        cur = nxt; cB = nB; ++ui;
#pragma unroll
        for (int h = 0; h < 2; ++h)
#pragma unroll
            for (int i = 0; i < 2; ++i) offc[h][i] = offn[h][i];
        if (wr == 1) PG8_BAR;
    }
    PG8_WAIT_V(0);
    PG8_BAR;
#undef PG8_AOFF
#undef PG8_SA
#undef PG8_SB
#undef PG8_STAGE
#undef PG8_LDA
#undef PG8_LDB
#undef PG8_MMA
#undef PG8_WAIT_V
#undef PG8_WAIT_L
#undef PG8_BAR
#undef PG8_SCHED
}
}

template <class Epi, int MODE>
__global__ void __launch_bounds__(512, 2) k_gemm_fast(const bf16_t* A, const bf16_t* Bt, int nM, int nN, int pb0, int K, Epi E, const unsigned char* ws) {
    extern __shared__ __attribute__((aligned(16))) unsigned char lds_dyn[];
    pg8::Gemm g{A, Bt, (const int*)(ws + OFF_SLOTTOK), K};
    if (MODE == 0) { pg8::PlainOrder S; S.init(nM, nN, gridDim.x, blockIdx.x); S.pb0 = pb0; pg8::gemm_phase<Epi, pg8::PlainOrder, false>((PG8_LAS unsigned char*)lds_dyn, g, S, E); }
    else { const int* tile_e = (const int*)(ws + OFF_TILEE); pg8::MoeOrder S; S.init(tile_e[MAXT], nN, gridDim.x, blockIdx.x); S.tile_e = tile_e; S.tpe = (MODE == 1) ? 8 : 4;
        pg8::gemm_phase<Epi, pg8::MoeOrder, MODE == 1>((PG8_LAS unsigned char*)lds_dyn, g, S, E); }
}

__global__ void __launch_bounds__(256) k_sg_ln(const float* ln_g, const float* ln_b, unsigned char* ws) {
    bf16_t* zb = (bf16_t*)(ws + OFF_A + 64 * MiB);
    const int wid = threadIdx.x >> 6, lane = threadIdx.x & 63, nw = blockDim.x >> 6;
    for (int row = blockIdx.x * nw + wid; row < NTOK; row += gridDim.x * nw) {
        bf16_t* p = zb + (size_t)row * 1024 + 512 + lane * 8;
        const uint4 r = *(const uint4*)p;
        float v[8] = {bf2f((bf16_t)(r.x & 0xffff)), bf2f((bf16_t)(r.x >> 16)), bf2f((bf16_t)(r.y & 0xffff)), bf2f((bf16_t)(r.y >> 16)),
                      bf2f((bf16_t)(r.z & 0xffff)), bf2f((bf16_t)(r.z >> 16)), bf2f((bf16_t)(r.w & 0xffff)), bf2f((bf16_t)(r.w >> 16))};
        float s = 0.f;
#pragma unroll
        for (int j = 0; j < 8; ++j) s += v[j];
        const float mu = wave_sum(s) * (1.0f / 512.0f);
        float q = 0.f;
#pragma unroll
        for (int j = 0; j < 8; ++j) { const float d = v[j] - mu; q += d * d; }
        const float rstd = rsqrtf(wave_sum(q) * (1.0f / 512.0f) + EPS);
        float o[8];
#pragma unroll
        for (int j = 0; j < 8; ++j) o[j] = (v[j] - mu) * rstd * ln_g[lane * 8 + j] + ln_b[lane * 8 + j];
        uint4 w; w.x = pack2(o[0], o[1]); w.y = pack2(o[2], o[3]); w.z = pack2(o[4], o[5]); w.w = pack2(o[6], o[7]);
        *(uint4*)p = w;
    }
}
__global__ void __launch_bounds__(256) k_sg_mix(const float* sg_b, unsigned char* ws) {
    const bf16_t* zb = (const bf16_t*)(ws + OFF_A + 64 * MiB); const bf16_t* sgw = (const bf16_t*)(ws + OFF_SGW);
    bf16_t* mix = (bf16_t*)(ws + OFF_C);
    const size_t tot = (size_t)NTOK * 512;
    for (size_t i = (size_t)blockIdx.x * blockDim.x + threadIdx.x; i < tot; i += (size_t)gridDim.x * blockDim.x) {
        const int row = (int)(i >> 9), col = (int)(i & 511), g = col >> 7, p = row & 127, base = row & ~127;
        const bf16_t* w = sgw + (size_t)(g * 128 + p) * 128;
        float s = 0.f;
        for (int q = 0; q < 128; ++q) s += bf2f(w[q]) * bf2f(zb[(size_t)(base + q) * 1024 + 512 + col]);
        s += sg_b[g * 128 + p];
        mix[(size_t)row * 1024 + 512 + col] = f2bf(bf2f(zb[(size_t)row * 1024 + col]) * s);
    }
}

__global__ void __launch_bounds__(128) k_attn_naive(const float* subln_g, unsigned char* ws) {
    __shared__ float sc[2][2][KEYS];
    __shared__ float qs[2][2][64];
    const bf16_t* qb = (const bf16_t*)(ws + OFF_B); const bf16_t* kb = (const bf16_t*)(ws + OFF_B + 32 * MiB); const bf16_t* vb = (const bf16_t*)(ws + OFF_B + 68 * MiB);
    bf16_t* mix = (bf16_t*)(ws + OFF_C);
    const float lam = *(const float*)(ws + OFF_LAM);
    const int wid = threadIdx.x >> 6, lane = threadIdx.x & 63;
    const int item = blockIdx.x * 2 + wid;
    const int row = item >> 2, h = item & 3, b = row / L;
    for (int m = 0; m < 2; ++m) qs[wid][m][lane] = bf2f(qb[(size_t)m * NTOK * 256 + (size_t)row * 256 + h * 64 + lane]);
    __syncthreads();
    float mx[2] = {-1e30f, -1e30f};
    for (int kk = 0; kk < KEYS / 64; ++kk) {
        const int key = kk * 64 + lane;
        for (int m = 0; m < 2; ++m) {
            const bf16_t* kp = kb + (size_t)m * B * KEYS * 256 + ((size_t)b * KEYS + key) * 256 + h * 64;
            float s = 0.f;
            for (int d8 = 0; d8 < 8; ++d8) {
                const uint4 r = *(const uint4*)(kp + d8 * 8);
                const float* q = &qs[wid][m][d8 * 8];
                s += q[0] * bf2f((bf16_t)(r.x & 0xffff)) + q[1] * bf2f((bf16_t)(r.x >> 16)) + q[2] * bf2f((bf16_t)(r.y & 0xffff)) + q[3] * bf2f((bf16_t)(r.y >> 16))
                   + q[4] * bf2f((bf16_t)(r.z & 0xffff)) + q[5] * bf2f((bf16_t)(r.z >> 16)) + q[6] * bf2f((bf16_t)(r.w & 0xffff)) + q[7] * bf2f((bf16_t)(r.w >> 16));
            }
            sc[wid][m][key] = s; mx[m] = fmaxf(mx[m], s);
        }
    }
    float inv[2];
    for (int m = 0; m < 2; ++m) {
        const float M = wave_max(mx[m]); float s = 0.f;
        for (int kk = 0; kk < KEYS / 64; ++kk) { const float p = __expf(sc[wid][m][kk * 64 + lane] - M); sc[wid][m][kk * 64 + lane] = p; s += p; }
        inv[m] = 1.0f / wave_sum(s);
    }
    for (int kk = 0; kk < KEYS / 64; ++kk) { const int key = kk * 64 + lane; sc[wid][0][key] = sc[wid][0][key] * inv[0] - lam * sc[wid][1][key] * inv[1]; }
    __syncthreads();
    float o0 = 0.f, o1 = 0.f;
    const bf16_t* vp = vb + (size_t)b * KEYS * 512 + h * 128 + lane * 2;
    for (int key = 0; key < KEYS; ++key) {
        const unsigned r = *(const unsigned*)(vp + (size_t)key * 512);
        const float a = sc[wid][0][key];
        o0 += a * bf2f((bf16_t)(r & 0xffff)); o1 += a * bf2f((bf16_t)(r >> 16));
    }
    const float ss = wave_sum(o0 * o0 + o1 * o1) * (1.0f / 128.0f);
    const float r = rsqrtf(ss + EPS) * (1.0f - LAM_INIT);
    *(unsigned*)(mix + (size_t)row * 1024 + h * 128 + lane * 2) = pack2(o0 * r * subln_g[lane * 2], o1 * r * subln_g[lane * 2 + 1]);
}

__global__ void __launch_bounds__(256) k_ln1_router(const float* x, const float* ln_g, const float* ln_b, const float* wgr, const float* bgr, const float* wer, const float* ber,
                                                    float* x1out, unsigned char* ws) {
    const float* mod = (const float*)(ws + OFF_MOD); const float* y = (const float*)(ws + OFF_A);
    bf16_t* t = (bf16_t*)(ws + OFF_C);
    int* tok_e = (int*)(ws + OFF_TOKE); int* tok_p = (int*)(ws + OFF_TOKP); float* tok_w = (float*)(ws + OFF_TOKW);
    unsigned* cnt = (unsigned*)(ws + OFF_CTL) + CW_CNT;
    const int wid = threadIdx.x >> 6, lane = threadIdx.x & 63, nw = blockDim.x >> 6;
    for (int row = blockIdx.x * nw + wid; row < NTOK; row += gridDim.x * nw) {
        const float* m = mod + (row / L) * 6144;
        float v[16];
        float s = 0.f;
#pragma unroll
        for (int i = 0; i < 4; ++i) {
            const int c = 4 * lane + 256 * i;
            const float4 a = *(const float4*)(x + (size_t)row * D + c), yy = *(const float4*)(y + (size_t)row * D + c), g = *(const float4*)(m + 2048 + c);
            v[4 * i + 0] = ALPHA * a.x + g.x * yy.x; v[4 * i + 1] = ALPHA * a.y + g.y * yy.y; v[4 * i + 2] = ALPHA * a.z + g.z * yy.z; v[4 * i + 3] = ALPHA * a.w + g.w * yy.w;
            s += (v[4 * i] + v[4 * i + 1]) + (v[4 * i + 2] + v[4 * i + 3]);
        }
        const float mu = wave_sum(s) * (1.0f / 1024.0f);
        float q = 0.f;
#pragma unroll
        for (int j = 0; j < 16; ++j) { const float d = v[j] - mu; q += d * d; }
        const float rstd = rsqrtf(wave_sum(q) * (1.0f / 1024.0f) + EPS);
        float acc[36];
#pragma unroll
        for (int o = 0; o < 36; ++o) acc[o] = 0.f;
#pragma unroll
        for (int i = 0; i < 4; ++i) {
            const int c = 4 * lane + 256 * i;
            const float4 g = *(const float4*)(ln_g + c), bb = *(const float4*)(ln_b + c), sh = *(const float4*)(m + 3072 + c), scl = *(const float4*)(m + 4096 + c);
            float4 xo;
            xo.x = (v[4 * i + 0] - mu) * rstd * g.x + bb.x; xo.y = (v[4 * i + 1] - mu) * rstd * g.y + bb.y; xo.z = (v[4 * i + 2] - mu) * rstd * g.z + bb.z; xo.w = (v[4 * i + 3] - mu) * rstd * g.w + bb.w;
            *(float4*)(x1out + (size_t)row * D + c) = xo;
            float tt[4] = {xo.x * (1.f + scl.x) + sh.x, xo.y * (1.f + scl.y) + sh.y, xo.z * (1.f + scl.z) + sh.z, xo.w * (1.f + scl.w) + sh.w};
            uint2 o2; o2.x = pack2(tt[0], tt[1]); o2.y = pack2(tt[2], tt[3]);
            *(uint2*)(t + (size_t)row * D + c) = o2;
#pragma unroll
            for (int j = 0; j < 4; ++j) {
                const float4 wg4 = *(const float4*)(wgr + (size_t)(c + j) * 4);
                acc[0] += tt[j] * wg4.x; acc[1] += tt[j] * wg4.y; acc[2] += tt[j] * wg4.z; acc[3] += tt[j] * wg4.w;
#pragma unroll
                for (int o4 = 0; o4 < 8; ++o4) { const float4 w4 = *(const float4*)(wer + (size_t)(c + j) * 32 + o4 * 4);
                    acc[4 + o4 * 4 + 0] += tt[j] * w4.x; acc[4 + o4 * 4 + 1] += tt[j] * w4.y; acc[4 + o4 * 4 + 2] += tt[j] * w4.z; acc[4 + o4 * 4 + 3] += tt[j] * w4.w; }
            }
        }
#pragma unroll
        for (int o = 0; o < 36; ++o) acc[o] = wave_sum(acc[o]);
        float gl[4]; int gs = 0;
#pragma unroll
        for (int g = 0; g < 4; ++g) gl[g] = acc[g] + bgr[g];
        float gmax = gl[0];
#pragma unroll
        for (int g = 1; g < 4; ++g) if (gl[g] > gmax) { gmax = gl[g]; gs = g; }
        float gsum = 0.f;
#pragma unroll
        for (int g = 0; g < 4; ++g) gsum += expf(gl[g] - gmax);
        const float gw = 1.0f / gsum;
        float el[8];
#pragma unroll
        for (int j = 0; j < 8; ++j) { float vsel = acc[4 + j];
#pragma unroll
            for (int g = 1; g < 4; ++g) vsel = (gs == g) ? acc[4 + g * 8 + j] : vsel;
            el[j] = vsel + ber[gs * 8 + j]; }
        int i0 = 0; float v0 = el[0];
#pragma unroll
        for (int j = 1; j < 8; ++j) if (el[j] > v0) { v0 = el[j]; i0 = j; }
        int i1 = -1; float v1 = -3.0e38f;
#pragma unroll
        for (int j = 0; j < 8; ++j) if (j != i0 && (i1 < 0 || el[j] > v1)) { v1 = el[j]; i1 = j; }
        const float ex = expf(v1 - v0), w0 = gw / (1.0f + ex), w1 = gw * ex / (1.0f + ex);
        if (lane == 0) {
            const int e0 = gs * 8 + i0, e1 = gs * 8 + i1;
            tok_e[row * 2] = e0; tok_e[row * 2 + 1] = e1; tok_w[row * 2] = w0; tok_w[row * 2 + 1] = w1;
            tok_p[row * 2] = (int)atomicAdd(&cnt[e0], 1u); tok_p[row * 2 + 1] = (int)atomicAdd(&cnt[e1], 1u);
        }
    }
}

__global__ void __launch_bounds__(256) k_route_assign(unsigned char* ws) {
    __shared__ int base[NE], cn[NE];
    const unsigned* cnt = (const unsigned*)(ws + OFF_CTL) + CW_CNT;
    const int* tok_e = (const int*)(ws + OFF_TOKE); const int* tok_p = (const int*)(ws + OFF_TOKP);
    int* tok_s = (int*)(ws + OFF_TOKS); int* slot_tok = (int*)(ws + OFF_SLOTTOK); int* tile_e = (int*)(ws + OFF_TILEE);
    if (threadIdx.x == 0) {
        int t = 0;
        for (int e = 0; e < NE; ++e) { const int c = (int)cnt[e]; cn[e] = c; base[e] = t * 256; const int nt = (c + 255) / 256;
            if (blockIdx.x == 0) for (int i = 0; i < nt; ++i) tile_e[t + i] = e;
            t += nt; }
        if (blockIdx.x == 0) tile_e[MAXT] = t;
    }
    __syncthreads();
    for (int i = blockIdx.x * blockDim.x + threadIdx.x; i < NTOK * 2; i += gridDim.x * blockDim.x) {
        const int s = base[tok_e[i]] + tok_p[i];
        tok_s[i] = s; slot_tok[s] = i >> 1;
    }
    if (blockIdx.x == 0) for (int e = 0; e < NE; ++e) { const int c = cn[e], end = ((c + 255) / 256) * 256; for (int j = c + threadIdx.x; j < end; j += blockDim.x) slot_tok[base[e] + j] = 0; }
}

__global__ void __launch_bounds__(256) k_final(const float* ln_g, const float* ln_b, float* out, unsigned char* ws) {
    const float* mod = (const float*)(ws + OFF_MOD); const bf16_t* y2 = (const bf16_t*)(ws + OFF_B);
    const int* tok_s = (const int*)(ws + OFF_TOKS); const float* tok_w = (const float*)(ws + OFF_TOKW);
    const int wid = threadIdx.x >> 6, lane = threadIdx.x & 63, nw = blockDim.x >> 6;
    for (int row = blockIdx.x * nw + wid; row < NTOK; row += gridDim.x * nw) {
        const float* m = mod + (row / L) * 6144 + 5120;
        const int s0 = tok_s[row * 2], s1 = tok_s[row * 2 + 1]; const float w0 = tok_w[row * 2], w1 = tok_w[row * 2 + 1];
        float v[16]; float s = 0.f;
#pragma unroll
        for (int i = 0; i < 4; ++i) {
            const int c = 4 * lane + 256 * i;
            const float4 a = *(const float4*)(out + (size_t)row * D + c), g = *(const float4*)(m + c);
            const uint2 r0 = *(const uint2*)(y2 + (size_t)s0 * D + c), r1 = *(const uint2*)(y2 + (size_t)s1 * D + c);
            const float f0 = w0 * bf2f((bf16_t)(r0.x & 0xffff)) + w1 * bf2f((bf16_t)(r1.x & 0xffff)), f1 = w0 * bf2f((bf16_t)(r0.x >> 16)) + w1 * bf2f((bf16_t)(r1.x >> 16));
            const float f2 = w0 * bf2f((bf16_t)(r0.y & 0xffff)) + w1 * bf2f((bf16_t)(r1.y & 0xffff)), f3 = w0 * bf2f((bf16_t)(r0.y >> 16)) + w1 * bf2f((bf16_t)(r1.y >> 16));
            v[4 * i + 0] = ALPHA * a.x + g.x * f0; v[4 * i + 1] = ALPHA * a.y + g.y * f1; v[4 * i + 2] = ALPHA * a.z + g.z * f2; v[4 * i + 3] = ALPHA * a.w + g.w * f3;
            s += (v[4 * i] + v[4 * i + 1]) + (v[4 * i + 2] + v[4 * i + 3]);
        }
        const float mu = wave_sum(s) * (1.0f / 1024.0f);
        float q = 0.f;
#pragma unroll
        for (int j = 0; j < 16; ++j) { const float d = v[j] - mu; q += d * d; }
        const float rstd = rsqrtf(wave_sum(q) * (1.0f / 1024.0f) + EPS);
#pragma unroll
        for (int i = 0; i < 4; ++i) {
            const int c = 4 * lane + 256 * i;
            const float4 g = *(const float4*)(ln_g + c), bb = *(const float4*)(ln_b + c);
            float4 o;
            o.x = (v[4 * i + 0] - mu) * rstd * g.x + bb.x; o.y = (v[4 * i + 1] - mu) * rstd * g.y + bb.y; o.z = (v[4 * i + 2] - mu) * rstd * g.z + bb.z; o.w = (v[4 * i + 3] - mu) * rstd * g.w + bb.w;
            *(float4*)(out + (size_t)row * D + c) = o;
        }
    }
}

extern "C" void kernel_launch(void* const* d_in, const int* in_sizes, int n_in, void* d_out, int out_size, void* d_ws, size_t ws_size, hipStream_t stream) {
    (void)in_sizes; (void)n_in; (void)out_size;
    if (ws_size < WS_END) { fprintf(stderr, "workspace too small: %zu < %zu\n", ws_size, (size_t)WS_END); return; }
    const float* x = (const float*)d_in[0]; const float* c = (const float*)d_in[1]; const float* ctx = (const float*)d_in[2]; const float* c_ctx = (const float*)d_in[3];
    const float* w_mod = (const float*)d_in[4]; const float* b_mod = (const float*)d_in[5]; const float* w_in = (const float*)d_in[6];
    const float* lq1 = (const float*)d_in[7]; const float* lk1 = (const float*)d_in[8]; const float* lq2 = (const float*)d_in[9]; const float* lk2 = (const float*)d_in[10];
    const float* subln_g = (const float*)d_in[11]; const float* sg_ln_g = (const float*)d_in[12]; const float* sg_ln_b = (const float*)d_in[13];
    const float* sg_w = (const float*)d_in[14]; const float* sg_b = (const float*)d_in[15]; const float* w_out = (const float*)d_in[16];
    const float* ln1_g = (const float*)d_in[17]; const float* ln1_b = (const float*)d_in[18];
    const float* rgw = (const float*)d_in[19]; const float* rgb = (const float*)d_in[20]; const float* rew = (const float*)d_in[21]; const float* reb = (const float*)d_in[22];
    const float* ewg = (const float*)d_in[23]; const float* ewu = (const float*)d_in[24]; const float* ewd = (const float*)d_in[25];
    const float* ln2_g = (const float*)d_in[26]; const float* ln2_b = (const float*)d_in[27];
    unsigned char* ws = (unsigned char*)d_ws; float* out = (float*)d_out;

    hipMemsetAsync(ws + OFF_CTL, 0, 65536, stream);
    k_prep<<<1, 256, 0, stream>>>(lq1, lk1, lq2, lk2, ws);
    static bool attr = false;
    if (!attr) { hipFuncSetAttribute((const void*)k_mod, hipFuncAttributeMaxDynamicSharedMemorySize, 96 * 1024); attr = true; }
    k_mod<<<192, 256, (17 * 1024 + 8 * 17 * 32) * 4, stream>>>(c, c_ctx, w_mod, b_mod, ws);
    k_conv<<<2048, 256, 0, stream>>>(w_in, w_out, sg_w, ewg, ewu, ewd, ws);
    k_modulate<<<2048, 256, 0, stream>>>(x, ctx, ws);
    static bool attr2 = false;
    if (!attr2) {
        (void)hipFuncSetAttribute((const void*)k_gemm_fast<pg8::EpiInProj, 0>, hipFuncAttributeMaxDynamicSharedMemorySize, pg8::STAGE_BYTES);
        (void)hipFuncSetAttribute((const void*)k_gemm_fast<pg8::EpiF32, 0>, hipFuncAttributeMaxDynamicSharedMemorySize, pg8::STAGE_BYTES);
        (void)hipFuncSetAttribute((const void*)k_gemm_fast<pg8::EpiGateUp, 1>, hipFuncAttributeMaxDynamicSharedMemorySize, pg8::STAGE_BYTES);
        (void)hipFuncSetAttribute((const void*)k_gemm_fast<pg8::EpiBf16, 2>, hipFuncAttributeMaxDynamicSharedMemorySize, pg8::STAGE_BYTES);
        attr2 = true;
    }
    { pg8::EpiInProj e{ws, 0, 0}; k_gemm_fast<pg8::EpiInProj, 0><<<256, 512, pg8::STAGE_BYTES, stream>>>((const bf16_t*)(ws + OFF_A), (const bf16_t*)(ws + OFF_WIN), NTOK / 256, INC / 256, 0, D, e, ws); }
    { pg8::EpiInProj e{ws, 1, 0}; k_gemm_fast<pg8::EpiInProj, 0><<<256, 512, pg8::STAGE_BYTES, stream>>>((const bf16_t*)(ws + OFF_A + 128 * MiB), (const bf16_t*)(ws + OFF_WIN), NCTX / 256, 4, 2, D, e, ws); }
    k_sg_ln<<<2048, 256, 0, stream>>>(sg_ln_g, sg_ln_b, ws);
    k_sg_mix<<<4096, 256, 0, stream>>>(sg_b, ws);
    k_attn_naive<<<NTOK * 4 / 2, 128, 0, stream>>>(subln_g, ws);
    { pg8::EpiF32 e{(float*)(ws + OFF_A), D, 0}; k_gemm_fast<pg8::EpiF32, 0><<<256, 512, pg8::STAGE_BYTES, stream>>>((const bf16_t*)(ws + OFF_C), (const bf16_t*)(ws + OFF_WOUT), NTOK / 256, D / 256, 0, D, e, ws); }
    k_ln1_router<<<2048, 256, 0, stream>>>(x, ln1_g, ln1_b, rgw, rgb, rew, reb, out, ws);
    k_route_assign<<<256, 256, 0, stream>>>(ws);
    { pg8::EpiGateUp e{(bf16_t*)(ws + OFF_A)}; k_gemm_fast<pg8::EpiGateUp, 1><<<256, 512, pg8::STAGE_BYTES, stream>>>((const bf16_t*)(ws + OFF_C), (const bf16_t*)(ws + OFF_WGU), 0, 8, 0, D, e, ws); }
    { pg8::EpiBf16 e{(bf16_t*)(ws + OFF_B), D, 0}; k_gemm_fast<pg8::EpiBf16, 2><<<256, 512, pg8::STAGE_BYTES, stream>>>((const bf16_t*)(ws + OFF_A), (const bf16_t*)(ws + OFF_WD), 0, 4, 0, D, e, ws); }
    k_final<<<2048, 256, 0, stream>>>(ln2_g, ln2_b, out, ws);
}
```

```cpp
#include <hip/hip_runtime.h>
#include <cstdint>
#include <cstdio>

typedef unsigned short bf16_t;
#define DEV __device__ __forceinline__
#define LAS __attribute__((address_space(3)))

namespace cfg {
constexpr int B = 16, L = 2048, D = 1024, NTOK = B * L, CTX = 256, NCTX = B * CTX, KEYS = L + CTX;
constexpr int INC = 2560, NE = 32, PMAX = 73728, MAXT = 288;
constexpr float EPS = 1e-5f, ALPHA = 1.189207115002721f, LAM_INIT = 0.2f;
constexpr size_t MiB = 1048576;
constexpr size_t OFF_CTL = 0;
constexpr size_t OFF_MOD = 65536;
constexpr size_t OFF_ROPE = OFF_MOD + 17 * 6144 * 4;
constexpr size_t OFF_LAM = OFF_ROPE + 8192;
constexpr size_t OFF_TOKE = OFF_LAM + 256;
constexpr size_t OFF_TOKP = OFF_TOKE + 262144;
constexpr size_t OFF_TOKW = OFF_TOKP + 262144;
constexpr size_t OFF_TOKS = OFF_TOKW + 262144;
constexpr size_t OFF_SLOTTOK = OFF_TOKS + 262144;
constexpr size_t OFF_TILEE = OFF_SLOTTOK + PMAX * 4;
constexpr size_t OFF_WIN = 2 * MiB;
constexpr size_t OFF_WOUT = 7 * MiB;
constexpr size_t OFF_SGW = 9 * MiB;
constexpr size_t OFF_WGU = 10 * MiB;
constexpr size_t OFF_C = 138 * MiB;
constexpr size_t OFF_Y2 = OFF_WGU;
constexpr size_t OFF_WD = 202 * MiB;
constexpr size_t OFF_A = 266 * MiB;
constexpr size_t OFF_B = 410 * MiB;
constexpr size_t OFF_DMAP = OFF_B + 64 * MiB;
constexpr size_t OFF_Y2E = OFF_B + 68 * MiB;
constexpr size_t WS_END = 554 * MiB;
constexpr int CW_BAR = 0;
constexpr int CW_CNT = 8192, CNT_STRIDE = 32;
constexpr int CW_HC = 4736;
constexpr int CW_SDONE = 4800;
constexpr int LDS_BYTES = 147456, MISC_OFF = 143360, ROPE_LDS = 131072;
constexpr int MOE_LDS = MISC_OFF + 128;
constexpr int MOE_TE = MOE_LDS, MOE_TP = MOE_LDS + 1280, MOE_BASE = MOE_LDS + 2560;
}
using namespace cfg;

DEV bf16_t f2bf(float f) { unsigned u = __float_as_uint(f); u += 0x7fffu + ((u >> 16) & 1u); return (bf16_t)(u >> 16); }
DEV float bf2f(bf16_t h) { return __uint_as_float(((unsigned)h) << 16); }
DEV unsigned pack2(float lo, float hi) { return (unsigned)f2bf(lo) | ((unsigned)f2bf(hi) << 16); }
DEV float wave_sum(float v) { for (int o = 32; o; o >>= 1) v += __shfl_xor(v, o); return v; }
DEV float wave_max(float v) { for (int o = 32; o; o >>= 1) v = fmaxf(v, __shfl_xor(v, o)); return v; }
DEV float silu_f(float x) { return x / (1.0f + __expf(-x)); }
DEV int opaque_tid() { int t = threadIdx.x; asm volatile("" : "+v"(t)); return t; }

#define XB_TMO      128
#define XB_XCNT(j)  (256  + 64 * (j))
#define XB_XSUB(j)  (1280 + 64 * (j))
#define XB_XGEN(j)  (2304 + 64 * (j))
#define XB_TOP      3328
#define XB_TOPGEN   3392
#define XCD_BAR_WORDS 3456
#define XB_SPIN_CAP (1u << 18)

__device__ __forceinline__ unsigned xb_ld(unsigned* p)              { return __hip_atomic_load(p, __ATOMIC_RELAXED, __HIP_MEMORY_SCOPE_AGENT); }
__device__ __forceinline__ unsigned xb_add(unsigned* p, unsigned v) { return __hip_atomic_fetch_add(p, v, __ATOMIC_RELAXED, __HIP_MEMORY_SCOPE_AGENT); }
__device__ __forceinline__ unsigned xb_xcc_id() { return (unsigned)__builtin_amdgcn_s_getreg((3 << 11) | 20) & 0xFu; }
#define XB_SPIN(cond, bar) do { unsigned _sp = 0; while (cond) { __builtin_amdgcn_s_sleep(1); \
    if ((++_sp & 255u) == 0u) { if (xb_ld(&(bar)[XB_TMO])) break; if (_sp > XB_SPIN_CAP) { atomicAdd(&(bar)[XB_TMO], 1u); break; } } } } while (0)

struct XcdBarrier {
    unsigned* bar; unsigned x;
    volatile LAS unsigned* st;
};

__device__ __forceinline__ XcdBarrier xcd_barrier_post(unsigned* bar, volatile LAS unsigned* st) {
    XcdBarrier b; b.bar = bar; b.x = xb_xcc_id(); b.st = st;
    if (threadIdx.x == 0) (void)xb_add(&bar[XB_XCNT(b.x)], 1u);
    return b;
}
__device__ __forceinline__ void xcd_barrier_complete(unsigned* bar, unsigned x, unsigned& nloc, unsigned& nx) {
    const unsigned G = gridDim.x * gridDim.y * gridDim.z;
    unsigned sum, cnt, mine, sp = 0u;
    for (;;) {
        sum = 0u; cnt = 0u; mine = 0u;
#pragma unroll
        for (unsigned j = 0; j < 16; ++j) { const unsigned c = xb_ld(&bar[XB_XCNT(j)]); sum += c; cnt += (c > 0u) ? 1u : 0u; mine = (j == x) ? c : mine; }
        if (sum == G) break;
        __builtin_amdgcn_s_sleep(1);
        if ((++sp & 255u) == 0u) { if (xb_ld(&bar[XB_TMO])) break; if (sp > XB_SPIN_CAP) { atomicAdd(&bar[XB_TMO], 1u); break; } }
    }
    nloc = mine > 0u ? mine : 1u; nx = cnt > 0u ? cnt : 1u;
}

__device__ __forceinline__ void xcd_barrier(const XcdBarrier& b) {
    asm volatile("s_waitcnt vmcnt(0)" ::: "memory");
    __syncthreads();
    if (threadIdx.x == 0) {
        unsigned* bar = b.bar;
        __builtin_amdgcn_s_waitcnt(0);
        unsigned nloc = b.st[0], nx = b.st[1];
        if (nloc == 0u) { xcd_barrier_complete(bar, b.x, nloc, nx); b.st[0] = nloc; b.st[1] = nx; }
        const unsigned old = xb_add(&bar[XB_XSUB(b.x)], 1u);
        const unsigned gen = old / nloc;
        if (old + 1u == (gen + 1u) * nloc) {
            __builtin_amdgcn_fence(__ATOMIC_RELEASE, "agent");
            asm volatile("s_waitcnt vmcnt(0)" ::: "memory");
            const unsigned og = xb_add(&bar[XB_TOP], 1u);
            const unsigned tg = og / nx;
            if (og + 1u == (tg + 1u) * nx) xb_add(&bar[XB_TOPGEN], 1u);
            else XB_SPIN(xb_ld(&bar[XB_TOPGEN]) == tg, bar);
            __builtin_amdgcn_fence(__ATOMIC_ACQUIRE, "agent");
            xb_add(&bar[XB_XGEN(b.x)], 1u);
            asm volatile("s_waitcnt vmcnt(0)" ::: "memory");
        } else {
            XB_SPIN(xb_ld(&bar[XB_XGEN(b.x)]) == gen, bar);
            __builtin_amdgcn_fence(__ATOMIC_ACQUIRE, "agent");
            asm volatile("s_waitcnt vmcnt(0)" ::: "memory");
        }
    }
    __syncthreads();
}

namespace pg8 {
#define PG8_LAS __attribute__((address_space(3)))
typedef short bf16x8 __attribute__((ext_vector_type(8)));
typedef float f32x4 __attribute__((ext_vector_type(4)));
typedef float f32x2 __attribute__((ext_vector_type(2)));
typedef unsigned u32x4 __attribute__((ext_vector_type(4)));
typedef unsigned u32x2 __attribute__((ext_vector_type(2)));
constexpr int BM = 256, BK = 64, HALF = 128, HTB = HALF * BK * 2, STAGE_BYTES = 8 * HTB, NXCD = 8, WGM = 8;
__host__ __device__ __forceinline__ int lds_byte(int r, int c) { const int st = (r >> 4) * 2 + (c >> 5), rr = r & 15, cc = c & 31, ob = rr * 64 + cc * 2; return st * 1024 + (ob ^ (((ob >> 9) & 1) << 5)); }
__host__ __device__ __forceinline__ void stage_rc(int b, int& R, int& C) { const int st = b / 1024, sb = b % 1024, swz = sb ^ (((sb >> 9) & 1) << 5); R = (st >> 1) * 16 + swz / 64; C = (st & 1) * 32 + (swz % 64) / 2; }
__host__ __device__ __forceinline__ int perm32(int rho) { const int n = rho >> 4, i = rho & 15; return 8 * (i >> 2) + 4 * n + (i & 3); }

struct Unit { int pm, pn, pb, ge, gp0, gcnt, ui; };
struct Gemm { const bf16_t* A; const bf16_t* Bt; const int* rowmap; int K; };

struct TileOrder {
    int nM, nN, nwg, G, c;
    __device__ __forceinline__ void init(int nM_, int nN_, int G_, int c_) { nM = nM_; nN = nN_; nwg = nM * nN; G = G_; c = c_; }
    __device__ __forceinline__ bool map(int i, int& pm, int& pn) const {
        const long L = (long)i * G + c; if (L >= nwg) return false;
        int wgid = (int)L; { const int q = nwg / NXCD, r = nwg % NXCD, xcd = wgid % NXCD, off = wgid / NXCD; wgid = (xcd < r ? xcd * (q + 1) : r * (q + 1) + (xcd - r) * q) + off; }
        const int nig = WGM * nN, gid = wgid / nig, fm = gid * WGM, gsz = (nM - fm) < WGM ? (nM - fm) : WGM;
        pm = fm + ((wgid % nig) % gsz); pn = (wgid % nig) / gsz; return true;
    }
};
struct PlainOrder : TileOrder {
    int pb0;
    __device__ __forceinline__ bool next(int i, Unit& u) const { if (!map(i, u.pm, u.pn)) return false; u.pb = pb0 + u.pn; u.ge = 0; u.gp0 = 0; u.gcnt = 0; u.ui = i; return true; }
};
struct MoeOrder : TileOrder {
    const PG8_LAS int* tile_e; const PG8_LAS int* tile_p0; const unsigned* cnt; int tpe; int pm0;
    __device__ __forceinline__ bool next(int i, Unit& u) const { if (!map(i, u.pm, u.pn)) return false; u.pm += pm0;
        const int e = tile_e[u.pm]; u.pb = e * tpe + u.pn; u.ge = e; u.gp0 = tile_p0[u.pm]; u.gcnt = (int)cnt[e * CNT_STRIDE]; u.ui = i; return true; }
};
struct OneOrder {
    int pm, pn, pb;
    __device__ __forceinline__ bool next(int i, Unit& u) const { if (i != 0) return false; u.pm = pm; u.pn = pn; u.pb = pb; u.ge = 0; u.gp0 = 0; u.gcnt = 0; u.ui = 0; return true; }
};

__device__ __forceinline__ unsigned cvt_pk_bf16(float lo, float hi) { unsigned r; asm volatile("v_cvt_pk_bf16_f32 %0, %1, %2" : "=v"(r) : "v"(lo), "v"(hi)); return r; }
__device__ __forceinline__ f32x2 gelu_pk(f32x2 v) {
    const f32x2 av = __builtin_elementwise_abs(v), d = av * 0.2316418882f + 1.0f;
    f32x2 t; t.x = __builtin_amdgcn_rcpf(d.x); t.y = __builtin_amdgcn_rcpf(d.y);
    f32x2 q = t * 0.5307027145f + (-0.7265760135f); q = q * t + 0.7107068705f; q = q * t + (-0.142248368f); q = q * t + 0.127414796f; q = q * t;
    const f32x2 s = (v * v) * (-0.72134752044f);
    f32x2 e; e.x = __builtin_amdgcn_exp2f(s.x); e.y = __builtin_amdgcn_exp2f(s.y);
    const f32x2 m = v * (q * e), r = v - m;
    f32x2 o; o.x = v.x < 0.f ? m.x : r.x; o.y = v.y < 0.f ? m.y : r.y; return o;
}

struct EpiInProj {
    static constexpr bool PERM = false;
    unsigned char* ws; PG8_LAS unsigned char* ropel; int ctx; int pad;
    __device__ __forceinline__ void operator()(const f32x4 (&acc)[2][2][4][2], const Unit& u, int wr, int wc, int fr, int fq) const {
        const PG8_LAS float* rope = (const PG8_LAS float*)ropel;
        bf16_t* qb = (bf16_t*)(ws + OFF_B); bf16_t* kb = (bf16_t*)(ws + OFF_B + 32 * MiB); bf16_t* vb = (bf16_t*)(ws + OFF_B + 68 * MiB); bf16_t* zb = (bf16_t*)(ws + OFF_A + 64 * MiB);
        const int gc0 = (ctx ? 512 : 0) + u.pn * BM;
#pragma unroll
        for (int ai = 0; ai < 2; ++ai)
#pragma unroll
            for (int m = 0; m < 4; ++m) {
                const int r = u.pm * BM + ai * HALF + wr * 64 + m * 16 + fr;
                size_t krow; int l;
                if (ctx) { krow = (size_t)(r / CTX) * KEYS + L + (r % CTX); l = 0; } else { l = r % L; krow = (size_t)(r / L) * KEYS + l; }
#pragma unroll
                for (int bj = 0; bj < 2; ++bj) {
                    const int gc = gc0 + bj * HALF + wc * 32;
                    const f32x4 a0 = acc[ai][bj][m][0], a1 = acc[ai][bj][m][1];
                    if (gc < 1024) {
                        f32x4 lo = a0, hi = a1;
                        if (!ctx) {
                            const int pos = ((gc >> 5) & 1) ? (l & 63) : (l >> 6);
                            const PG8_LAS float* rp = rope + (pos * 16 + 4 * fq) * 2;
                            const f32x4 c01 = *(const PG8_LAS f32x4*)rp, c23 = *(const PG8_LAS f32x4*)(rp + 4);
                            const float sc = gc < 512 ? 0.125f * 1.4426950408889634f : 1.0f;
                            lo[0] = (a0[0] * c01[0] - a1[0] * c01[1]) * sc; hi[0] = (a1[0] * c01[0] + a0[0] * c01[1]) * sc;
                            lo[1] = (a0[1] * c01[2] - a1[1] * c01[3]) * sc; hi[1] = (a1[1] * c01[2] + a0[1] * c01[3]) * sc;
                            lo[2] = (a0[2] * c23[0] - a1[2] * c23[1]) * sc; hi[2] = (a1[2] * c23[0] + a0[2] * c23[1]) * sc;
                            lo[3] = (a0[3] * c23[2] - a1[3] * c23[3]) * sc; hi[3] = (a1[3] * c23[2] + a0[3] * c23[3]) * sc;
                        }
                        bf16_t* dst;
                        if (gc < 512) dst = qb + (size_t)(gc >> 8) * ((size_t)NTOK * 256) + (size_t)r * 256 + (gc & 255) + 4 * fq;
                        else dst = kb + (size_t)((gc - 512) >> 8) * ((size_t)B * KEYS * 256) + krow * 256 + (gc & 255) + 4 * fq;
                        u32x2 w0, w1; w0.x = cvt_pk_bf16(lo[0], lo[1]); w0.y = cvt_pk_bf16(lo[2], lo[3]); w1.x = cvt_pk_bf16(hi[0], hi[1]); w1.y = cvt_pk_bf16(hi[2], hi[3]);
                        *(u32x2*)dst = w0; *(u32x2*)(dst + 16) = w1;
                    } else if (gc < 1536) {
                        bf16_t* dst = vb + krow * 512 + (gc - 1024) + 4 * fq;
                        u32x2 w0, w1; w0.x = cvt_pk_bf16(a0[0], a0[1]); w0.y = cvt_pk_bf16(a0[2], a0[3]); w1.x = cvt_pk_bf16(a1[0], a1[1]); w1.y = cvt_pk_bf16(a1[2], a1[3]);
                        *(u32x2*)dst = w0; *(u32x2*)(dst + 16) = w1;
                    } else {
                        bf16_t* dst = zb + (size_t)r * 1024 + (gc - 1536) + 4 * fq;
                        const f32x2 g0 = gelu_pk((f32x2){a0[0], a0[1]}), g1 = gelu_pk((f32x2){a0[2], a0[3]}), g2 = gelu_pk((f32x2){a1[0], a1[1]}), g3 = gelu_pk((f32x2){a1[2], a1[3]});
                        u32x2 w0, w1; w0.x = cvt_pk_bf16(g0.x, g0.y); w0.y = cvt_pk_bf16(g1.x, g1.y); w1.x = cvt_pk_bf16(g2.x, g2.y); w1.y = cvt_pk_bf16(g3.x, g3.y);
                        *(u32x2*)dst = w0; *(u32x2*)(dst + 16) = w1;
                    }
                }
            }
    }
};
struct EpiF32 {
    static constexpr bool PERM = false;
    float* O; int ldc; int pad;
    __device__ __forceinline__ void operator()(const f32x4 (&acc)[2][2][4][2], const Unit& u, int wr, int wc, int fr, int fq) const {
#pragma unroll
        for (int ai = 0; ai < 2; ++ai)
#pragma unroll
            for (int m = 0; m < 4; ++m) { float* rowp = O + (size_t)(u.pm * BM + ai * HALF + wr * 64 + m * 16 + fr) * ldc + u.pn * BM + wc * 32 + 4 * fq;
#pragma unroll
                for (int bj = 0; bj < 2; ++bj)
#pragma unroll
                    for (int n = 0; n < 2; ++n) *(f32x4*)(rowp + bj * HALF + 16 * n) = acc[ai][bj][m][n]; }
    }
};
struct EpiGateUp {
    static constexpr bool PERM = true;
    bf16_t* O; unsigned* sdone; int pub_ui; int pub_n;
    __device__ __forceinline__ void operator()(const f32x4 (&acc)[2][2][4][2], const Unit& u, int wr, int wc, int fr, int fq) const {
        store(acc, u, wr, wc, fr, fq);
        if (u.ui == pub_ui) {
            asm volatile("s_waitcnt vmcnt(0)" ::: "memory"); __builtin_amdgcn_s_barrier();
            if (threadIdx.x == 0) { __builtin_amdgcn_fence(__ATOMIC_RELEASE, "agent"); asm volatile("s_waitcnt vmcnt(0)" ::: "memory"); (void)xb_add(sdone, (unsigned)pub_n); }
        }
    }
    __device__ __forceinline__ void store(const f32x4 (&acc)[2][2][4][2], const Unit& u, int wr, int wc, int fr, int fq) const {
#pragma unroll
        for (int ai = 0; ai < 2; ++ai)
#pragma unroll
            for (int m = 0; m < 4; ++m) { bf16_t* dst = O + (size_t)(u.pm * BM + ai * HALF + wr * 64 + m * 16 + fr) * D + u.pn * HALF + wc * 32 + 8 * fq;
                float h[8];
#pragma unroll
                for (int n = 0; n < 2; ++n)
#pragma unroll
                    for (int j = 0; j < 4; ++j) { const float g = acc[ai][0][m][n][j], up = acc[ai][1][m][n][j]; h[4 * n + j] = g * __builtin_amdgcn_rcpf(1.0f + __expf(-g)) * up; }
                u32x4 w; w.x = cvt_pk_bf16(h[0], h[1]); w.y = cvt_pk_bf16(h[2], h[3]); w.z = cvt_pk_bf16(h[4], h[5]); w.w = cvt_pk_bf16(h[6], h[7]);
                *(u32x4*)dst = w; }
    }
};
struct EpiBf16 {
    static constexpr bool PERM = true;
    bf16_t* O; int ldc; int pad;
    __device__ __forceinline__ void operator()(const f32x4 (&acc)[2][2][4][2], const Unit& u, int wr, int wc, int fr, int fq) const {
#pragma unroll
        for (int ai = 0; ai < 2; ++ai)
#pragma unroll
            for (int m = 0; m < 4; ++m) { bf16_t* rowp = O + (size_t)(u.pm * BM + ai * HALF + wr * 64 + m * 16 + fr) * ldc + u.pn * BM + wc * 32 + 8 * fq;
#pragma unroll
                for (int bj = 0; bj < 2; ++bj) { const f32x4 v0 = acc[ai][bj][m][0], v1 = acc[ai][bj][m][1];
                    u32x4 w; w.x = cvt_pk_bf16(v0[0], v0[1]); w.y = cvt_pk_bf16(v0[2], v0[3]); w.z = cvt_pk_bf16(v1[0], v1[1]); w.w = cvt_pk_bf16(v1[2], v1[3]);
                    *(u32x4*)(rowp + bj * HALF) = w; } }
    }
};

template <class Epi, class Sched, bool GATHER>
__device__ __forceinline__ void gemm_phase(PG8_LAS unsigned char* lds, const Gemm g, const Sched& S, const Epi& E) {
    const int tid = opaque_tid(), wid = __builtin_amdgcn_readfirstlane(tid >> 6), lane = tid & 63, wr = wid >> 2, wc = wid & 3, fr = lane & 15, fq = lane >> 4;
    const int K = g.K, nt = K / BK;
    int RA[2]; unsigned colA[2], voffB[2];
#pragma unroll
    for (int i = 0; i < 2; ++i) { int R, C; stage_rc(tid * 16 + i * 8192, R, C); const int Rb = Epi::PERM ? ((R & ~31) + perm32(R & 31)) : R;
        RA[i] = R; colA[i] = (unsigned)C * 2u; voffB[i] = (unsigned)(Rb * K + C) * 2u; }
    const size_t kstep = (size_t)(BK * 2);
    const size_t hstep = (size_t)HALF * K * 2;
    const size_t tstep = 2 * hstep;
    const unsigned ldsw = (unsigned)wid * 1024u;
    const int aoff = lds_byte(wr * 64 + fr, fq * 8), boff = lds_byte(wc * 32 + fr, fq * 8);
#define PG8_AOFF(u, off) do { _Pragma("unroll") for (int _h = 0; _h < 2; ++_h) _Pragma("unroll") for (int _i = 0; _i < 2; ++_i) { \
        int _row = (u).pm * BM + _h * HALF + RA[_i]; if (GATHER) { const int _pos = (u).gp0 + _h * HALF + RA[_i]; _row = _pos < (u).gcnt ? g.rowmap[(u).ge * NTOK + _pos] : 0; } \
        (off)[_h][_i] = (unsigned)_row * (unsigned)(K * 2) + colA[_i]; } } while (0)
#define PG8_SA(b, h) (((b) * 2 + (h)) * HTB)
#define PG8_SB(b, h) ((4 + (b) * 2 + (h)) * HTB)
#define PG8_STAGE(bufoff, gbase, voff) do { _Pragma("unroll") for (int _i = 0; _i < 2; ++_i) \
        __builtin_amdgcn_global_load_lds((const unsigned*)((const char*)(gbase) + (voff)[_i]), (PG8_LAS unsigned*)(lds + (bufoff) + ldsw + _i * 8192), 16, 0, 0); } while (0)
#define PG8_LDA(dst, b, h) do { _Pragma("unroll") for (int m = 0; m < 4; ++m) _Pragma("unroll") for (int k = 0; k < 2; ++k) dst[m][k] = *(const PG8_LAS bf16x8*)(lds + PG8_SA(b, h) + aoff + m * 2048 + k * 1024); } while (0)
#define PG8_LDB(dst, b, h) do { _Pragma("unroll") for (int n = 0; n < 2; ++n) _Pragma("unroll") for (int k = 0; k < 2; ++k) dst[n][k] = *(const PG8_LAS bf16x8*)(lds + PG8_SB(b, h) + boff + n * 2048 + k * 1024); } while (0)
#define PG8_MMA(ai, bj, At, Bt) do { __builtin_amdgcn_s_setprio(1); _Pragma("unroll") for (int m = 0; m < 4; ++m) _Pragma("unroll") for (int n = 0; n < 2; ++n) _Pragma("unroll") for (int k = 0; k < 2; ++k) \
        acc[ai][bj][m][n] = __builtin_amdgcn_mfma_f32_16x16x32_bf16(Bt[n][k], At[m][k], acc[ai][bj][m][n], 0, 0, 0); __builtin_amdgcn_s_setprio(0); } while (0)
#define PG8_WAIT_V(n) asm volatile("s_waitcnt vmcnt(" #n ")" ::: "memory")
#define PG8_WAIT_L(n) asm volatile("s_waitcnt lgkmcnt(" #n ")" ::: "memory")
#define PG8_BAR __builtin_amdgcn_s_barrier()
#define PG8_SCHED __builtin_amdgcn_sched_barrier(0)
    Unit cur, nxt; int ui = 0;
    if (!S.next(0, cur)) return;
    f32x4 acc[2][2][4][2];
#pragma unroll
    for (int a = 0; a < 2; ++a)
#pragma unroll
        for (int b = 0; b < 2; ++b)
#pragma unroll
            for (int m = 0; m < 4; ++m)
#pragma unroll
                for (int n = 0; n < 2; ++n) acc[a][b][m][n] = (f32x4){0.f, 0.f, 0.f, 0.f};
    bf16x8 At[4][2], B0[2][2], B1[2][2];
    const char* Ab = (const char*)g.A;
    unsigned offc[2][2], offn[2][2];
    PG8_AOFF(cur, offc);
    const char* cB = (const char*)g.Bt + (size_t)cur.pb * tstep;
    PG8_STAGE(PG8_SB(0, 0), cB, voffB); PG8_STAGE(PG8_SB(0, 1), cB + hstep, voffB); PG8_STAGE(PG8_SA(0, 0), Ab, offc[0]); PG8_STAGE(PG8_SA(0, 1), Ab, offc[1]);
    if (wr == 1) PG8_BAR;
    PG8_WAIT_V(2); PG8_BAR;
    PG8_STAGE(PG8_SB(1, 0), cB + kstep, voffB); PG8_STAGE(PG8_SA(1, 0), Ab + kstep, offc[0]); PG8_STAGE(PG8_SB(1, 1), cB + hstep + kstep, voffB);
    PG8_WAIT_V(6); PG8_BAR;
    for (;;) {
        const bool has_next = S.next(ui + 1, nxt);
        if (has_next) { PG8_AOFF(nxt, offn); }
        else {
#pragma unroll
            for (int h = 0; h < 2; ++h)
#pragma unroll
                for (int i = 0; i < 2; ++i) offn[h][i] = offc[h][i];
        }
        const char* nB = has_next ? (const char*)g.Bt + (size_t)nxt.pb * tstep : cB;
        for (int t = 0; t < nt; t += 2) {
            const bool last = (t == nt - 2);
            const char* a1 = Ab + (size_t)(t + 1) * kstep;
            const char* a2 = Ab + (last ? (size_t)0 : (size_t)(t + 2) * kstep); const char* b2 = last ? nB : cB + (size_t)(t + 2) * kstep;
            const char* a3 = a2 + kstep; const char* b3 = b2 + kstep;
            unsigned o2[2][2];
#pragma unroll
            for (int h = 0; h < 2; ++h)
#pragma unroll
                for (int i = 0; i < 2; ++i) o2[h][i] = last ? offn[h][i] : offc[h][i];
            PG8_LDB(B0, 0, 0); PG8_LDB(B1, 0, 1); PG8_SCHED; PG8_LDA(At, 0, 0); PG8_STAGE(PG8_SA(1, 1), a1, offc[1]);
            PG8_WAIT_V(8); PG8_WAIT_L(0); PG8_BAR; PG8_MMA(0, 0, At, B0); PG8_MMA(0, 1, At, B1); PG8_BAR; PG8_SCHED;
            PG8_LDA(At, 0, 1); PG8_STAGE(PG8_SB(0, 0), b2, voffB); PG8_STAGE(PG8_SB(0, 1), b2 + hstep, voffB); PG8_STAGE(PG8_SA(0, 0), a2, o2[0]);
            PG8_WAIT_V(8); PG8_WAIT_L(0); PG8_BAR; PG8_MMA(1, 0, At, B0); PG8_MMA(1, 1, At, B1); PG8_BAR; PG8_SCHED;
            PG8_LDB(B0, 1, 0); PG8_LDB(B1, 1, 1); PG8_SCHED; PG8_LDA(At, 1, 0); PG8_STAGE(PG8_SA(0, 1), a2, o2[1]);
            PG8_WAIT_V(8); PG8_WAIT_L(0); PG8_BAR; PG8_MMA(0, 0, At, B0); PG8_MMA(0, 1, At, B1); PG8_BAR; PG8_SCHED;
            PG8_LDA(At, 1, 1); PG8_STAGE(PG8_SB(1, 0), b3, voffB); PG8_STAGE(PG8_SB(1, 1), b3 + hstep, voffB); PG8_STAGE(PG8_SA(1, 0), a3, o2[0]);
            PG8_WAIT_V(8); PG8_WAIT_L(0); PG8_BAR; PG8_MMA(1, 0, At, B0); PG8_MMA(1, 1, At, B1); PG8_BAR; PG8_SCHED;
        }
        if (wr == 0) PG8_BAR;
        E(acc, cur, wr, wc, fr, fq);
        if (!has_next) break;
#pragma unroll
        for (int a = 0; a < 2; ++a)
#pragma unroll
            for (int b = 0; b < 2; ++b)
#pragma unroll
                for (int m = 0; m < 4; ++m)
#pragma unroll
                    for (int n = 0; n < 2; ++n) acc[a][b][m][n] = (f32x4){0.f, 0.f, 0.f, 0.f};
        cur = nxt; cB = nB; ++ui;
#pragma unroll
        for (int h = 0; h < 2; ++h)
#pragma unroll
            for (int i = 0; i < 2; ++i) offc[h][i] = offn[h][i];
        if (wr == 1) PG8_BAR;
    }
    PG8_WAIT_V(0);
    PG8_BAR;
#undef PG8_AOFF
#undef PG8_SA
#undef PG8_SB
#undef PG8_STAGE
#undef PG8_LDA
#undef PG8_LDB
#undef PG8_MMA
#undef PG8_WAIT_V
#undef PG8_WAIT_L
#undef PG8_BAR
#undef PG8_SCHED
}
}


struct Params { const float* in[28]; float* out; unsigned char* ws; };
enum { I_X = 0, I_C, I_CTX, I_CCTX, I_WMOD, I_BMOD, I_WIN, I_LQ1, I_LK1, I_LQ2, I_LK2, I_SUBG, I_SGLNG, I_SGLNB, I_SGW, I_SGB, I_WOUT, I_LN1G, I_LN1B,
       I_RGW, I_RGB, I_REW, I_REB, I_EWG, I_EWU, I_EWD, I_LN2G, I_LN2B };

DEV void phase_prep(const Params& p) {
    const int tidx = opaque_tid();
    float* rope = (float*)(p.ws + OFF_ROPE);
    for (int t = tidx; t < 1024; t += blockDim.x) {
        const int pos = t >> 4, j = t & 15;
        const float inv = powf(10000.0f, -(float)j / 16.0f);
        const float ang = (float)pos * inv;
        rope[2 * t] = cosf(ang); rope[2 * t + 1] = sinf(ang);
    }
    if (tidx < 64) {
        const int l = tidx;
        const float a = wave_sum(p.in[I_LQ1][l] * p.in[I_LK1][l]), b = wave_sum(p.in[I_LQ2][l] * p.in[I_LK2][l]);
        if (l == 0) *(float*)(p.ws + OFF_LAM) = expf(a) - expf(b) + LAM_INIT;
    }
}
DEV void phase_mod(const Params& p, unsigned char* lds) {
    const int tidx = opaque_tid();
    if ((int)blockIdx.x >= 192) return;
    float* sv = (float*)lds; float* red = sv + 17 * 1024;
    const float* c = p.in[I_C]; const float* c_ctx = p.in[I_CCTX]; const float* w_mod = p.in[I_WMOD]; const float* b_mod = p.in[I_BMOD];
    for (int i = tidx; i < 17 * 1024; i += blockDim.x) { const float v = i < 16384 ? c[i] : c_ctx[i - 16384]; sv[i] = silu_f(v); }
    __syncthreads();
    float* mod = (float*)(p.ws + OFF_MOD);
    const int col = tidx & 31, kg = tidx >> 5, nkg = blockDim.x >> 5, dper = 1024 / nkg;
    for (int u = blockIdx.x; u < 192; u += gridDim.x) {
        const int e = u * 32 + col;
        float acc[17];
#pragma unroll
        for (int r = 0; r < 17; ++r) acc[r] = 0.f;
        for (int d = kg * dper; d < (kg + 1) * dper; ++d) {
            const float w = w_mod[(size_t)d * 6144 + e];
#pragma unroll
            for (int r = 0; r < 17; ++r) acc[r] += sv[r * 1024 + d] * w;
        }
#pragma unroll
        for (int r = 0; r < 17; ++r) red[(kg * 17 + r) * 32 + col] = acc[r];
        __syncthreads();
        for (int i = tidx; i < 17 * 32; i += blockDim.x) {
            const int r = i >> 5, cc = i & 31; float s = 0.f;
            for (int g = 0; g < nkg; ++g) s += red[(g * 17 + r) * 32 + cc];
            mod[r * 6144 + u * 32 + cc] = s + b_mod[u * 32 + cc];
        }
        __syncthreads();
    }
}
DEV void conv_item(const float* W, int N, bf16_t* WT, int rbase, int rstride, LAS float* scr, int item, int lane) {
    const int nblk = N / 32, kb = item / nblk, nb = item % nblk, k0 = 64 * kb, n0 = 32 * nb;
#pragma unroll 8
    for (int i = 0; i < 32; ++i) { const int kk = 2 * i + (lane >> 5); scr[kk * 33 + (lane & 31)] = W[(size_t)(k0 + kk) * N + n0 + (lane & 31)]; }
    asm volatile("s_waitcnt lgkmcnt(0)" ::: "memory");
    const int c = lane & 7;
    const int r0 = rbase + (n0 >> 7) * rstride + (n0 & 127);
#pragma unroll
    for (int j = 0; j < 4; ++j) { const int n = (lane >> 3) + 8 * j; const LAS float* s = scr + (8 * c) * 33 + n;
        pg8::u32x4 o; o.x = pack2(s[0 * 33], s[1 * 33]); o.y = pack2(s[2 * 33], s[3 * 33]); o.z = pack2(s[4 * 33], s[5 * 33]); o.w = pack2(s[6 * 33], s[7 * 33]);
        *(pg8::u32x4*)(WT + (size_t)(r0 + n) * 1024 + k0 + 8 * c) = o; }
    asm volatile("s_waitcnt lgkmcnt(0)" ::: "memory");
}
DEV void phase_conv(const Params& p, LAS unsigned char* lds) {
    const int tidx = opaque_tid();
    const int tid = opaque_tid(), wave = __builtin_amdgcn_readfirstlane(tid >> 6), lane = tid & 63, nwv = blockDim.x >> 6;
    LAS float* scr = (LAS float*)(lds + wave * 8448);
    unsigned char* ws = p.ws;
    bf16_t* WinT = (bf16_t*)(ws + OFF_WIN); bf16_t* WoutT = (bf16_t*)(ws + OFF_WOUT); bf16_t* SgW = (bf16_t*)(ws + OFF_SGW);
    bf16_t* WguT = (bf16_t*)(ws + OFF_WGU); bf16_t* WdT = (bf16_t*)(ws + OFF_WD);
    constexpr int I_IN = 16 * 80, I_OUT = 16 * 32, I_E = 16 * 32;
    constexpr int TOT = I_IN + I_OUT + 3 * NE * I_E;
    const int gw = blockIdx.x * nwv + wave, NGW = gridDim.x * nwv;
    for (int it = gw; it < TOT; it += NGW) {
        int v = it;
        if (v < I_IN) { conv_item(p.in[I_WIN], 2560, WinT, 0, 128, scr, v, lane); continue; }
        v -= I_IN;
        if (v < I_OUT) { conv_item(p.in[I_WOUT], 1024, WoutT, 0, 128, scr, v, lane); continue; }
        v -= I_OUT;
        const int which = v / (NE * I_E), w = v % (NE * I_E), e = w / I_E, item = w % I_E;
        if (which == 0) conv_item(p.in[I_EWG] + (size_t)e * 1048576, 1024, WguT + (size_t)e * 2048 * 1024, 0, 256, scr, item, lane);
        else if (which == 1) conv_item(p.in[I_EWU] + (size_t)e * 1048576, 1024, WguT + (size_t)e * 2048 * 1024, 128, 256, scr, item, lane);
        else conv_item(p.in[I_EWD] + (size_t)e * 1048576, 1024, WdT + (size_t)e * 1024 * 1024, 0, 128, scr, item, lane);
    }
    const float* sg_w = p.in[I_SGW];
    for (int i = blockIdx.x * blockDim.x + tidx; i < 65536 / 8; i += gridDim.x * blockDim.x) {
        const int g = i >> 11, pr = (i >> 4) & 127, q0 = (i & 15) * 8;
        const float4 v0 = *(const float4*)(sg_w + (size_t)(g * 128 + pr) * 128 + q0), v1 = *(const float4*)(sg_w + (size_t)(g * 128 + pr) * 128 + q0 + 4);
        uint4 o; o.x = pack2(v0.x, v0.y); o.y = pack2(v0.z, v0.w); o.z = pack2(v1.x, v1.y); o.w = pack2(v1.z, v1.w);
        const int ks = q0 >> 4, h2 = (q0 >> 3) & 1, lane = h2 * 32 + (pr & 31);
        *(uint4*)(SgW + ((size_t)(((g * 4 + (pr >> 5)) * 8 + ks) * 64 + lane)) * 8) = o;
    }
}
DEV void unpack8(const uint4& r, float (&v)[8]) {
    v[0] = bf2f((bf16_t)(r.x & 0xffff)); v[1] = bf2f((bf16_t)(r.x >> 16)); v[2] = bf2f((bf16_t)(r.y & 0xffff)); v[3] = bf2f((bf16_t)(r.y >> 16));
    v[4] = bf2f((bf16_t)(r.z & 0xffff)); v[5] = bf2f((bf16_t)(r.z >> 16)); v[6] = bf2f((bf16_t)(r.w & 0xffff)); v[7] = bf2f((bf16_t)(r.w >> 16));
}
DEV void modulate_rows(const float* src, bf16_t* dst, const float* m, int row_lo, int nrows, int wid, int lane, int nw) {
    float sh[2][8], sc[2][8];
#pragma unroll
    for (int i = 0; i < 2; ++i)
#pragma unroll
        for (int j = 0; j < 8; ++j) { sh[i][j] = m[8 * lane + 512 * i + j]; sc[i][j] = 1.0f + m[1024 + 8 * lane + 512 * i + j]; }
    for (int r = wid; r < nrows; r += 2 * nw) {
        float4 a[2][2][2]; bool ok[2];
#pragma unroll
        for (int u = 0; u < 2; ++u) { const int rr = r + u * nw; ok[u] = rr < nrows; const float* s = src + (size_t)(row_lo + (ok[u] ? rr : r)) * D + 8 * lane;
#pragma unroll
            for (int i = 0; i < 2; ++i) { a[u][i][0] = *(const float4*)(s + 512 * i); a[u][i][1] = *(const float4*)(s + 512 * i + 4); } }
#pragma unroll
        for (int u = 0; u < 2; ++u) if (ok[u]) { bf16_t* d = dst + (size_t)(row_lo + r + u * nw) * D + 8 * lane;
#pragma unroll
            for (int i = 0; i < 2; ++i) { const float4 x0 = a[u][i][0], x1 = a[u][i][1]; uint4 o;
                o.x = pack2(x0.x * sc[i][0] + sh[i][0], x0.y * sc[i][1] + sh[i][1]); o.y = pack2(x0.z * sc[i][2] + sh[i][2], x0.w * sc[i][3] + sh[i][3]);
                o.z = pack2(x1.x * sc[i][4] + sh[i][4], x1.y * sc[i][5] + sh[i][5]); o.w = pack2(x1.z * sc[i][6] + sh[i][6], x1.w * sc[i][7] + sh[i][7]);
                *(uint4*)(d + 512 * i) = o; } }
    }
}
DEV void phase_modulate_ctx(const Params& p) {
    const int tidx = opaque_tid(), wid = tidx >> 6, lane = tidx & 63, nw = blockDim.x >> 6;
    const float* mod = (const float*)(p.ws + OFF_MOD); bf16_t* hc = (bf16_t*)(p.ws + OFF_A + 128 * MiB);
    for (int panel = blockIdx.x; panel < NCTX / 16; panel += gridDim.x) modulate_rows(p.in[I_CTX], hc, mod + 16 * 6144, panel * 16, 16, wid, lane, nw);
}
DEV void phase_modulate_x(const Params& p, LAS unsigned char* lds) {
    const int tidx = opaque_tid(), lane = tidx & 63;
    const float* mod = (const float*)(p.ws + OFF_MOD); const float* src = p.in[I_X];
    bf16_t* h = (bf16_t*)(p.ws + OFF_A);
    LAS unsigned* ticket = (LAS unsigned*)(lds + MISC_OFF + 72);
    const int G = (int)gridDim.x, skip = G > 64 ? 64 : 0, nwork = G - skip, widx = (int)blockIdx.x - skip;
    if (widx < 0) return;
    const int quad_lo = (int)(((long)widx * (NTOK / 4)) / nwork), quad_hi = (int)(((long)(widx + 1) * (NTOK / 4)) / nwork);
    int curb = -1;
    float sh[2][8], sc[2][8];
    for (;;) {
        unsigned tk = 0; if (lane == 0) tk = __hip_atomic_fetch_add(ticket, 1u, __ATOMIC_RELAXED, __HIP_MEMORY_SCOPE_WORKGROUP);
        const int t = __builtin_amdgcn_readfirstlane((int)tk);
        if (t >= quad_hi - quad_lo) break;
        const int row = 4 * (quad_lo + t), b = row / L;
        float4 a[4][2][2];
#pragma unroll
        for (int u = 0; u < 4; ++u) { const float* s = src + (size_t)(row + u) * D + 8 * lane;
#pragma unroll
            for (int i = 0; i < 2; ++i) { a[u][i][0] = *(const float4*)(s + 512 * i); a[u][i][1] = *(const float4*)(s + 512 * i + 4); } }
        if (b != curb) { curb = b; const float* m = mod + b * 6144;
#pragma unroll
            for (int i = 0; i < 2; ++i)
#pragma unroll
                for (int j = 0; j < 8; ++j) { sh[i][j] = m[8 * lane + 512 * i + j]; sc[i][j] = 1.0f + m[1024 + 8 * lane + 512 * i + j]; } }
#pragma unroll
        for (int u = 0; u < 4; ++u) { bf16_t* d = h + (size_t)(row + u) * D + 8 * lane;
#pragma unroll
            for (int i = 0; i < 2; ++i) { const float4 x0 = a[u][i][0], x1 = a[u][i][1]; uint4 o;
                o.x = pack2(x0.x * sc[i][0] + sh[i][0], x0.y * sc[i][1] + sh[i][1]); o.y = pack2(x0.z * sc[i][2] + sh[i][2], x0.w * sc[i][3] + sh[i][3]);
                o.z = pack2(x1.x * sc[i][4] + sh[i][4], x1.y * sc[i][5] + sh[i][5]); o.w = pack2(x1.z * sc[i][6] + sh[i][6], x1.w * sc[i][7] + sh[i][7]);
                *(uint4*)(d + 512 * i) = o; } }
    }
}
DEV int moe_early_tiles(int Mt, int G) {
    const int R = (8 * Mt) % G, Rd = (4 * Mt) % G;
    return (R > 0 && Rd > 0 && Rd <= G - R && (Rd & 3) == 0 && Rd <= 4 * 128 && Rd <= 4 * Mt) ? Rd / 4 : 0;
}
DEV void moe_tables(const Params& p, LAS unsigned char* lds) {
    const int tidx = opaque_tid();
    if (tidx < 64) {
        const unsigned* cnt = (const unsigned*)(p.ws + OFF_CTL) + CW_CNT;
        LAS int* tile_e = (LAS int*)(lds + MOE_TE); LAS int* tile_p0 = (LAS int*)(lds + MOE_TP); LAS int* base = (LAS int*)(lds + MOE_BASE);
        const int e = tidx & 31, nt = tidx < 32 ? (int)((cnt[e * CNT_STRIDE] + 255u) >> 8) : 0;
        int incl = nt;
        for (int o = 1; o < 32; o <<= 1) { const int v = __shfl_up(incl, o); if ((tidx & 63) >= o) incl += v; }
        if (tidx < 32) {
            const int t0 = incl - nt;
            base[e] = t0 * 256;
            for (int i = 0; i < nt; ++i) { tile_e[t0 + i] = e; tile_p0[t0 + i] = i * 256; }
            if (tidx == 31) tile_e[MAXT] = incl;
        }
    }
    asm volatile("s_waitcnt lgkmcnt(0)" ::: "memory"); __syncthreads();
}
DEV void phase_final(const Params& p, LAS unsigned char* lds) {
    const int tidx = opaque_tid(), wid = __builtin_amdgcn_readfirstlane(tidx >> 6), lane = tidx & 63, nw = blockDim.x >> 6;
    float* out = p.out; unsigned char* ws = p.ws;
    const float* mod = (const float*)(ws + OFF_MOD); const bf16_t* y2 = (const bf16_t*)(ws + OFF_Y2); const bf16_t* x1b = (const bf16_t*)(ws + OFF_B);
    const int* tok_e = (const int*)(ws + OFF_TOKE); const int* tok_p = (const int*)(ws + OFF_TOKP); const float* tok_w = (const float*)(ws + OFF_TOKW);
    const LAS int* base = (const LAS int*)(lds + MOE_BASE);
    const bf16_t* y2e = (const bf16_t*)(ws + OFF_Y2E); const int early_rows = 256 * moe_early_tiles(((const LAS int*)(lds + MOE_TE))[MAXT], (int)gridDim.x);
    float lg[2][8], lb[2][8];
#pragma unroll
    for (int i = 0; i < 2; ++i)
#pragma unroll
        for (int j = 0; j < 8; ++j) { lg[i][j] = p.in[I_LN2G][8 * lane + 512 * i + j]; lb[i][j] = p.in[I_LN2B][8 * lane + 512 * i + j]; }
    for (int panel = blockIdx.x; panel < NTOK / 128; panel += gridDim.x) {
        const float* m = mod + (panel * 128 / L) * 6144 + 5120;
        float g2[2][8];
#pragma unroll
        for (int i = 0; i < 2; ++i)
#pragma unroll
            for (int j = 0; j < 8; ++j) g2[i][j] = m[8 * lane + 512 * i + j];
        for (int r = wid; r < 128; r += 2 * nw) {
            float v[2][16]; float mu[2], rstd[2];
#pragma unroll
            for (int u = 0; u < 2; ++u) {
                const int row = panel * 128 + r + u * nw;
                const int s0 = base[tok_e[row * 2]] + tok_p[row * 2], s1 = base[tok_e[row * 2 + 1]] + tok_p[row * 2 + 1]; const float w0 = tok_w[row * 2], w1 = tok_w[row * 2 + 1];
                float s = 0.f;
#pragma unroll
                for (int i = 0; i < 2; ++i) {
                    const int c = 8 * lane + 512 * i;
                    float xa[8], ya[8], yb[8];
                    unpack8(*(const uint4*)(x1b + (size_t)row * D + c), xa); unpack8(*(const uint4*)((s0 < early_rows ? y2e : y2) + (size_t)s0 * D + c), ya); unpack8(*(const uint4*)((s1 < early_rows ? y2e : y2) + (size_t)s1 * D + c), yb);
#pragma unroll
                    for (int j = 0; j < 8; ++j) { const float val = ALPHA * xa[j] + g2[i][j] * (w0 * ya[j] + w1 * yb[j]); v[u][8 * i + j] = val; s += val; }
                }
                mu[u] = s;
            }
#pragma unroll
            for (int u = 0; u < 2; ++u) {
                mu[u] = wave_sum(mu[u]) * (1.0f / 1024.0f);
                float q = 0.f;
#pragma unroll
                for (int j = 0; j < 16; ++j) { const float d = v[u][j] - mu[u]; q += d * d; }
                rstd[u] = rsqrtf(wave_sum(q) * (1.0f / 1024.0f) + EPS);
            }
#pragma unroll
            for (int u = 0; u < 2; ++u) {
                float* orow = out + (size_t)(panel * 128 + r + u * nw) * D + 8 * lane;
#pragma unroll
                for (int i = 0; i < 2; ++i) {
                    float4 o0, o1;
                    o0.x = (v[u][8 * i + 0] - mu[u]) * rstd[u] * lg[i][0] + lb[i][0]; o0.y = (v[u][8 * i + 1] - mu[u]) * rstd[u] * lg[i][1] + lb[i][1];
                    o0.z = (v[u][8 * i + 2] - mu[u]) * rstd[u] * lg[i][2] + lb[i][2]; o0.w = (v[u][8 * i + 3] - mu[u]) * rstd[u] * lg[i][3] + lb[i][3];
                    o1.x = (v[u][8 * i + 4] - mu[u]) * rstd[u] * lg[i][4] + lb[i][4]; o1.y = (v[u][8 * i + 5] - mu[u]) * rstd[u] * lg[i][5] + lb[i][5];
                    o1.z = (v[u][8 * i + 6] - mu[u]) * rstd[u] * lg[i][6] + lb[i][6]; o1.w = (v[u][8 * i + 7] - mu[u]) * rstd[u] * lg[i][7] + lb[i][7];
                    *(float4*)(orow + 512 * i) = o0; *(float4*)(orow + 512 * i + 4) = o1;
                }
            }
        }
    }
}

namespace att {
typedef short s16x8 __attribute__((ext_vector_type(8)));
typedef short s16x4 __attribute__((ext_vector_type(4)));
typedef float f32x16 __attribute__((ext_vector_type(16)));
typedef float f32x4 __attribute__((ext_vector_type(4)));
typedef unsigned u32x2 __attribute__((ext_vector_type(2)));
constexpr int KBUF = 16384, VOFF = 49152, VBUF = 16384, NUNITS = B * 4 * (L / 128), NT = KEYS / 64;
constexpr float THR = 60.0f;
typedef float f32x2 __attribute__((ext_vector_type(2)));
typedef __bf16 bf16x2 __attribute__((ext_vector_type(2)));
DEV unsigned cvtpk(float lo, float hi) { const f32x2 v = {lo, hi}; return __builtin_bit_cast(unsigned, __builtin_convertvector(v, bf16x2)); }
DEV s16x8 pack8(const f32x16& v, int o) {
    union { unsigned u[4]; s16x8 s; } x;
    x.u[0] = cvtpk(v[o + 0], v[o + 1]); x.u[1] = cvtpk(v[o + 2], v[o + 3]); x.u[2] = cvtpk(v[o + 4], v[o + 5]); x.u[3] = cvtpk(v[o + 6], v[o + 7]);
    return x.s;
}
template <int OFF> DEV void tr_rd(s16x4& r, unsigned addr) { asm volatile("ds_read_b64_tr_b16 %0, %1 offset:%2" : "=&v"(r) : "v"(addr), "i"(OFF)); }
struct Ctx {
    const bf16_t* k1; const bf16_t* k2; const bf16_t* v;
    unsigned ksrc, vsrc0, vsrc1;
    unsigned kaddr[4]; unsigned vaddr[2][4];
    int wid, map;
};
DEV void stageK(const Ctx& c, LAS unsigned char* lds, int t, int kb) {
    const size_t rk = (size_t)t * 64 * 256;
    __builtin_amdgcn_global_load_lds((const unsigned*)(c.k1 + rk + c.ksrc), (LAS unsigned*)(lds + kb * KBUF + c.wid * 1024), 16, 0, 0);
    __builtin_amdgcn_global_load_lds((const unsigned*)(c.k2 + rk + c.ksrc), (LAS unsigned*)(lds + kb * KBUF + 8192 + c.wid * 1024), 16, 0, 0);
}
DEV void stageV(const Ctx& c, LAS unsigned char* lds, int t, int vb) {
    const size_t rv = (size_t)t * 64 * 512;
    __builtin_amdgcn_global_load_lds((const unsigned*)(c.v + rv + c.vsrc0), (LAS unsigned*)(lds + VOFF + vb * VBUF + c.wid * 1024), 16, 0, 0);
    __builtin_amdgcn_global_load_lds((const unsigned*)(c.v + rv + c.vsrc1), (LAS unsigned*)(lds + VOFF + vb * VBUF + 8192 + c.wid * 1024), 16, 0, 0);
}
DEV void qk(const Ctx& c, LAS unsigned char* lds, unsigned kboff, const s16x8 (&qf)[4], f32x16& S0, f32x16& S1) {
    const LAS unsigned char* kb = lds + kboff;
#pragma unroll
    for (int r = 0; r < 16; ++r) { S0[r] = 0.f; S1[r] = 0.f; }
    s16x8 ka[4], kc[4];
#pragma unroll
    for (int s = 0; s < 4; ++s) { ka[s] = *(const LAS s16x8*)(kb + c.kaddr[s]); kc[s] = *(const LAS s16x8*)(kb + 4096 + c.kaddr[s]); }
#pragma unroll
    for (int s = 0; s < 4; ++s) {
        S0 = __builtin_amdgcn_mfma_f32_32x32x16_bf16(ka[s], qf[s], S0, 0, 0, 0);
        S1 = __builtin_amdgcn_mfma_f32_32x32x16_bf16(kc[s], qf[s], S1, 0, 0, 0);
    }
}
DEV int imax3(int a, int b, int c) { return max(max(a, b), c); }
DEV void softmax_pv(const Ctx& c, unsigned vbase, f32x16& S0, f32x16& S1, f32x16 (&O)[4], float& m, float& l, bool first) {
    int i0 = imax3(__float_as_int(S0[0]), __float_as_int(S1[0]), __float_as_int(S0[1])), i1 = imax3(__float_as_int(S0[4]), __float_as_int(S1[4]), __float_as_int(S0[5]));
    int i2 = imax3(__float_as_int(S0[8]), __float_as_int(S1[8]), __float_as_int(S0[9])), i3 = imax3(__float_as_int(S0[12]), __float_as_int(S1[12]), __float_as_int(S0[13]));
    i0 = imax3(i0, __float_as_int(S1[1]), __float_as_int(S0[2])); i1 = imax3(i1, __float_as_int(S1[5]), __float_as_int(S0[6])); i2 = imax3(i2, __float_as_int(S1[9]), __float_as_int(S0[10])); i3 = imax3(i3, __float_as_int(S1[13]), __float_as_int(S0[14]));
    i0 = imax3(i0, __float_as_int(S1[2]), __float_as_int(S0[3])); i1 = imax3(i1, __float_as_int(S1[6]), __float_as_int(S0[7])); i2 = imax3(i2, __float_as_int(S1[10]), __float_as_int(S0[11])); i3 = imax3(i3, __float_as_int(S1[14]), __float_as_int(S0[15]));
    i0 = imax3(i0, __float_as_int(S1[3]), i1); i2 = imax3(i2, __float_as_int(S1[7]), i3);
    const int im = imax3(i0, i2, max(__float_as_int(S1[11]), __float_as_int(S1[15])));
    const bool simple = !first && !__any((im > __float_as_int(THR)) || (m != 0.f));
    if (!simple) {
        const float mref = first ? 0.f : m;
#pragma unroll
        for (int r = 0; r < 16; ++r) { S0[r] -= mref; S1[r] -= mref; }
        float t0 = fmaxf(fmaxf(S0[0], S1[0]), S0[1]), t1 = fmaxf(fmaxf(S0[4], S1[4]), S0[5]), t2 = fmaxf(fmaxf(S0[8], S1[8]), S0[9]), t3 = fmaxf(fmaxf(S0[12], S1[12]), S0[13]);
        t0 = fmaxf(fmaxf(t0, S1[1]), S0[2]); t1 = fmaxf(fmaxf(t1, S1[5]), S0[6]); t2 = fmaxf(fmaxf(t2, S1[9]), S0[10]); t3 = fmaxf(fmaxf(t3, S1[13]), S0[14]);
        t0 = fmaxf(fmaxf(t0, S1[2]), S0[3]); t1 = fmaxf(fmaxf(t1, S1[6]), S0[7]); t2 = fmaxf(fmaxf(t2, S1[10]), S0[11]); t3 = fmaxf(fmaxf(t3, S1[14]), S0[15]);
        t0 = fmaxf(fmaxf(t0, S1[3]), t1); t2 = fmaxf(fmaxf(t2, S1[7]), t3);
        float tm = fmaxf(fmaxf(t0, t2), fmaxf(S1[11], S1[15]));
        { const auto rr = __builtin_amdgcn_permlane32_swap(__float_as_uint(tm), __float_as_uint(tm), false, false);
          tm = fmaxf(__uint_as_float(rr[0]), __uint_as_float(rr[1])); }
        const float d = first ? ((fabsf(tm) > THR) ? tm : 0.f) : ((tm > THR) ? tm : 0.f);
        if (__any(d != 0.f)) {
            const float al = first ? 1.0f : __builtin_amdgcn_exp2f(-d);
            l *= al;
#pragma unroll
            for (int eb = 0; eb < 4; ++eb)
#pragma unroll
                for (int r = 0; r < 16; ++r) O[eb][r] *= al;
#pragma unroll
            for (int r = 0; r < 16; ++r) { S0[r] -= d; S1[r] -= d; }
        }
        m = mref + d;
    }
#pragma unroll
    for (int r = 0; r < 16; ++r) { S0[r] = __builtin_amdgcn_exp2f(S0[r]); S1[r] = __builtin_amdgcn_exp2f(S1[r]); }
    float ls0 = S0[0], ls1 = S0[8], ls2 = S1[0], ls3 = S1[8];
#pragma unroll
    for (int r = 1; r < 8; ++r) { ls0 += S0[r]; ls1 += S0[r + 8]; ls2 += S1[r]; ls3 += S1[r + 8]; }
    l += (ls0 + ls1) + (ls2 + ls3);
    s16x8 pf[4];
    pf[0] = pack8(S0, 0); pf[1] = pack8(S0, 8); pf[2] = pack8(S1, 0); pf[3] = pack8(S1, 8);
    unsigned va[2][4];
#pragma unroll
    for (int t = 0; t < 2; ++t)
#pragma unroll
        for (int eb = 0; eb < 4; ++eb) va[t][eb] = vbase + c.vaddr[t][eb];
    s16x4 g0[2][4][2], g1[2][4][2];
#pragma unroll
    for (int eb = 0; eb < 4; ++eb) { tr_rd<0>(g0[0][eb][0], va[0][eb]); tr_rd<0>(g0[0][eb][1], va[1][eb]); tr_rd<4096>(g0[1][eb][0], va[0][eb]); tr_rd<4096>(g0[1][eb][1], va[1][eb]); }
    asm volatile("s_waitcnt lgkmcnt(0)"
                 : "+v"(g0[0][0][0]), "+v"(g0[0][0][1]), "+v"(g0[0][1][0]), "+v"(g0[0][1][1]), "+v"(g0[0][2][0]), "+v"(g0[0][2][1]), "+v"(g0[0][3][0]), "+v"(g0[0][3][1]),
                   "+v"(g0[1][0][0]), "+v"(g0[1][0][1]), "+v"(g0[1][1][0]), "+v"(g0[1][1][1]), "+v"(g0[1][2][0]), "+v"(g0[1][2][1]), "+v"(g0[1][3][0]), "+v"(g0[1][3][1]));
#pragma unroll
    for (int eb = 0; eb < 4; ++eb) { tr_rd<8192>(g1[0][eb][0], va[0][eb]); tr_rd<8192>(g1[0][eb][1], va[1][eb]); tr_rd<12288>(g1[1][eb][0], va[0][eb]); tr_rd<12288>(g1[1][eb][1], va[1][eb]); }
#pragma unroll
    for (int k2 = 0; k2 < 2; ++k2)
#pragma unroll
        for (int eb = 0; eb < 4; ++eb) {
            const s16x8 vf = __builtin_shufflevector(g0[k2][eb][0], g0[k2][eb][1], 0, 1, 2, 3, 4, 5, 6, 7);
            O[eb] = __builtin_amdgcn_mfma_f32_32x32x16_bf16(vf, pf[k2], O[eb], 0, 0, 0);
        }
    asm volatile("s_waitcnt lgkmcnt(0)"
                 : "+v"(g1[0][0][0]), "+v"(g1[0][0][1]), "+v"(g1[0][1][0]), "+v"(g1[0][1][1]), "+v"(g1[0][2][0]), "+v"(g1[0][2][1]), "+v"(g1[0][3][0]), "+v"(g1[0][3][1]),
                   "+v"(g1[1][0][0]), "+v"(g1[1][0][1]), "+v"(g1[1][1][0]), "+v"(g1[1][1][1]), "+v"(g1[1][2][0]), "+v"(g1[1][2][1]), "+v"(g1[1][3][0]), "+v"(g1[1][3][1]));
#pragma unroll
    for (int k2 = 0; k2 < 2; ++k2)
#pragma unroll
        for (int eb = 0; eb < 4; ++eb) {
            const s16x8 vf = __builtin_shufflevector(g1[k2][eb][0], g1[k2][eb][1], 0, 1, 2, 3, 4, 5, 6, 7);
            O[eb] = __builtin_amdgcn_mfma_f32_32x32x16_bf16(vf, pf[2 + k2], O[eb], 0, 0, 0);
        }
}
#define ATT_BAR() do { asm volatile("s_waitcnt vmcnt(0) lgkmcnt(0)" ::: "memory"); __builtin_amdgcn_s_barrier(); asm volatile("" ::: "memory"); } while (0)
DEV void attn_phase(const Params& p, LAS unsigned char* lds) {
    const int tid = opaque_tid(), wid = __builtin_amdgcn_readfirstlane(tid >> 6), lane = tid & 63;
    const int map = wid >> 2, rg = wid & 3, h2 = lane >> 5, ql = lane & 31;
    unsigned char* ws = p.ws;
    const bf16_t* qbase = (const bf16_t*)(ws + OFF_B) + (size_t)map * NTOK * 256;
    const bf16_t* k1base = (const bf16_t*)(ws + OFF_B + 32 * MiB); const bf16_t* k2base = k1base + (size_t)B * KEYS * 256;
    const bf16_t* vbase = (const bf16_t*)(ws + OFF_B + 68 * MiB);
    bf16_t* mix = (bf16_t*)(ws + OFF_C);
    const float* subg = p.in[I_SUBG];
    const float lam = *(const float*)(ws + OFF_LAM);
    Ctx c; c.wid = wid; c.map = map;
    { const int key = tid >> 3, ch = (tid & 7) ^ ((key >> 1) & 7); c.ksrc = (unsigned)(key * 256 + ch * 8); }
    { const int s0 = tid, k0 = s0 >> 4, c0 = (s0 & 15) ^ (((k0 & 3) << 2) | ((k0 >> 2) & 3)); c.vsrc0 = (unsigned)(k0 * 512 + c0 * 8);
      const int s1 = tid + 512, k1 = s1 >> 4, c1 = (s1 & 15) ^ (((k1 & 3) << 2) | ((k1 >> 2) & 3)); c.vsrc1 = (unsigned)(k1 * 512 + c1 * 8); }
    { const unsigned xk = (unsigned)(ql >> 1) & 7u;
#pragma unroll
      for (int s = 0; s < 4; ++s) c.kaddr[s] = (unsigned)ql * 128u + ((((unsigned)(2 * s + h2)) ^ xk) << 4);
      const unsigned q_ = (unsigned)(lane & 15) >> 2, p_ = (unsigned)lane & 3u, blk = (unsigned)(lane >> 4) & 1u;
#pragma unroll
      for (int t = 0; t < 2; ++t)
#pragma unroll
          for (int eb = 0; eb < 4; ++eb)
              c.vaddr[t][eb] = 256u * (4u * h2 + 8u * t + q_) + 16u * ((((unsigned)eb ^ q_) << 2) | ((2u * blk + (p_ >> 1)) ^ (unsigned)(h2 + 2 * t))) + 8u * (p_ & 1u);
    }
    const int G = gridDim.x, bid = blockIdx.x;
    for (int i = 0;; ++i) {
        int unit;
        if (G == 256) { if (i >= 4) break; const int j = i * 32 + (bid >> 3); unit = ((bid & 7) * 8 + (j >> 4)) * 16 + (j & 15); }
        else { unit = i * G + bid; if (unit >= NUNITS) break; }
        const int bh = unit >> 4, qblk = unit & 15, b = bh >> 2, h = bh & 3;
        c.k1 = k1base + (size_t)b * KEYS * 256 + h * 64; c.k2 = k2base + (size_t)b * KEYS * 256 + h * 64; c.v = vbase + (size_t)b * KEYS * 512 + h * 128;
        const int row = b * L + qblk * 128 + rg * 32 + ql;
        s16x8 qf[4];
        { const bf16_t* qrow = qbase + (size_t)row * 256 + h * 64;
#pragma unroll
          for (int s = 0; s < 4; ++s) qf[s] = *(const s16x8*)(qrow + (2 * s + h2) * 8); }
        f32x16 O[4];
#pragma unroll
        for (int eb = 0; eb < 4; ++eb)
#pragma unroll
            for (int r = 0; r < 16; ++r) O[eb][r] = 0.f;
        float m = 0.f, l = 0.f;
        const unsigned ldsb = (unsigned)(__UINTPTR_TYPE__)lds, kmap = (unsigned)(map * 8192);
        stageK(c, lds, 0, 0); stageV(c, lds, 0, 0); stageK(c, lds, 1, 1);
        ATT_BAR();
        f32x16 Sa0, Sa1, Sb0, Sb1;
        qk(c, lds, kmap, qf, Sa0, Sa1);
        int k1i = 1, k2i = 2;
        for (int t = 0; t < NT; t += 2) {
            if (t + 2 < NT) stageK(c, lds, t + 2, k2i);
            stageV(c, lds, t + 1, 1);
            qk(c, lds, (unsigned)(k1i * KBUF) + kmap, qf, Sb0, Sb1);
            softmax_pv(c, ldsb + (unsigned)VOFF, Sa0, Sa1, O, m, l, t == 0);
            { const int n = (k2i == 2) ? 0 : k2i + 1; k1i = k2i; k2i = n; }
            ATT_BAR();
            if (t + 3 < NT) stageK(c, lds, t + 3, k2i);
            if (t + 2 < NT) { stageV(c, lds, t + 2, 0); qk(c, lds, (unsigned)(k1i * KBUF) + kmap, qf, Sa0, Sa1); }
            softmax_pv(c, ldsb + (unsigned)(VOFF + VBUF), Sb0, Sb1, O, m, l, false);
            { const int n = (k2i == 2) ? 0 : k2i + 1; k1i = k2i; k2i = n; }
            ATT_BAR();
        }
        float lt; { const auto rr = __builtin_amdgcn_permlane32_swap(__float_as_uint(l), __float_as_uint(l), false, false); lt = __uint_as_float(rr[0]) + __uint_as_float(rr[1]); }
        LAS float* xch = (LAS float*)(lds + rg * 16384);
        if (map == 1) {
            const float sc = -lam / lt;
#pragma unroll
            for (int eb = 0; eb < 4; ++eb)
#pragma unroll
                for (int r = 0; r < 16; ++r) xch[(eb * 32 + (r & 3) + 8 * (r >> 2) + 4 * h2) * 32 + ql] = O[eb][r] * sc;
        }
        asm volatile("s_waitcnt lgkmcnt(0)" ::: "memory"); __builtin_amdgcn_s_barrier(); asm volatile("" ::: "memory");
        if (map == 0) {
            const float sc = 1.0f / lt;
            float ss = 0.f;
#pragma unroll
            for (int eb = 0; eb < 4; ++eb)
#pragma unroll
                for (int r = 0; r < 16; ++r) { const float o = O[eb][r] * sc + xch[(eb * 32 + (r & 3) + 8 * (r >> 2) + 4 * h2) * 32 + ql]; O[eb][r] = o; ss += o * o; }
            ss += __shfl_xor(ss, 32);
            const float rn = rsqrtf(ss * (1.0f / 128.0f) + EPS) * (1.0f - LAM_INIT);
            bf16_t* orow = mix + (size_t)row * 1024 + h * 128;
#pragma unroll
            for (int eb = 0; eb < 4; ++eb)
#pragma unroll
                for (int g4 = 0; g4 < 4; ++g4) {
                    const int e0 = eb * 32 + 8 * g4 + 4 * h2;
                    const f32x4 gg = *(const f32x4*)(subg + e0);
                    u32x2 w; w.x = cvtpk(O[eb][4 * g4 + 0] * rn * gg[0], O[eb][4 * g4 + 1] * rn * gg[1]); w.y = cvtpk(O[eb][4 * g4 + 2] * rn * gg[2], O[eb][4 * g4 + 3] * rn * gg[3]);
                    *(u32x2*)(orow + e0) = w;
                }
        }
        asm volatile("s_waitcnt lgkmcnt(0)" ::: "memory"); __builtin_amdgcn_s_barrier(); asm volatile("" ::: "memory");
    }
    asm volatile("s_waitcnt vmcnt(0) lgkmcnt(0)" ::: "memory"); __builtin_amdgcn_s_barrier(); asm volatile("" ::: "memory");
}
}


namespace sg {
typedef short s16x8 __attribute__((ext_vector_type(8)));
typedef short s16x4 __attribute__((ext_vector_type(4)));
typedef float f32x16 __attribute__((ext_vector_type(16)));
typedef unsigned u32x2 __attribute__((ext_vector_type(2)));
typedef unsigned u32x4 __attribute__((ext_vector_type(4)));
typedef float f32x2 __attribute__((ext_vector_type(2)));
typedef __bf16 bf16x2 __attribute__((ext_vector_type(2)));
DEV unsigned cvtpk(float lo, float hi) { const f32x2 v = {lo, hi}; return __builtin_bit_cast(unsigned, __builtin_convertvector(v, bf16x2)); }
DEV void sg_phase(const Params& p, LAS unsigned char* lds) {
    const int tid = opaque_tid(), wid = __builtin_amdgcn_readfirstlane(tid >> 6), lane = tid & 63, h2 = lane >> 5, ql = lane & 31;
    unsigned char* ws = p.ws;
    const bf16_t* zb = (const bf16_t*)(ws + OFF_A + 64 * MiB); const bf16_t* sgw = (const bf16_t*)(ws + OFF_SGW);
    bf16_t* mix = (bf16_t*)(ws + OFF_C);
    const float* sg_b = p.in[I_SGB];
    float gam[8], bet[8];
#pragma unroll
    for (int j = 0; j < 8; ++j) { gam[j] = p.in[I_SGLNG][lane * 8 + j]; bet[j] = p.in[I_SGLNB][lane * 8 + j]; }
    const unsigned q_ = (unsigned)(lane & 15) >> 2, p_ = (unsigned)lane & 3u, blk = (unsigned)(lane >> 4) & 1u;
    const int cb = wid >> 1, pb0 = (wid & 1) * 2;
    unsigned traddr[2];
#pragma unroll
    for (int t = 0; t < 2; ++t)
        traddr[t] = 256u * (8u * h2 + 4u * t + q_) + 16u * ((((unsigned)cb ^ q_) << 2) | ((2u * blk + (p_ >> 1)) ^ ((2u * h2 + t) & 3u))) + 8u * (p_ & 1u);
    for (int unit = blockIdx.x; unit < NTOK / 128; unit += gridDim.x) {
        const int row0 = unit * 128;
#pragma unroll 4
        for (int rr = 0; rr < 16; ++rr) {
            const int q = wid * 16 + rr;
            const uint4 r = *(const uint4*)(zb + (size_t)(row0 + q) * 1024 + 512 + lane * 8);
            float v[8] = {bf2f((bf16_t)(r.x & 0xffff)), bf2f((bf16_t)(r.x >> 16)), bf2f((bf16_t)(r.y & 0xffff)), bf2f((bf16_t)(r.y >> 16)),
                          bf2f((bf16_t)(r.z & 0xffff)), bf2f((bf16_t)(r.z >> 16)), bf2f((bf16_t)(r.w & 0xffff)), bf2f((bf16_t)(r.w >> 16))};
            float s = 0.f;
#pragma unroll
            for (int j = 0; j < 8; ++j) s += v[j];
            const float mu = wave_sum(s) * (1.0f / 512.0f);
            float qq = 0.f;
#pragma unroll
            for (int j = 0; j < 8; ++j) { v[j] -= mu; qq += v[j] * v[j]; }
            const float rstd = rsqrtf(wave_sum(qq) * (1.0f / 512.0f) + EPS);
            u32x4 w;
            w.x = cvtpk(v[0] * rstd * gam[0] + bet[0], v[1] * rstd * gam[1] + bet[1]); w.y = cvtpk(v[2] * rstd * gam[2] + bet[2], v[3] * rstd * gam[3] + bet[3]);
            w.z = cvtpk(v[4] * rstd * gam[4] + bet[4], v[5] * rstd * gam[5] + bet[5]); w.w = cvtpk(v[6] * rstd * gam[6] + bet[6], v[7] * rstd * gam[7] + bet[7]);
            const unsigned ch = (unsigned)lane & 15u, swz = (((unsigned)q & 3u) << 2) | (((unsigned)q >> 2) & 3u);
            *(LAS u32x4*)(lds + (lane >> 4) * 32768 + 256 * q + 16 * (ch ^ swz)) = w;
        }
        asm volatile("s_waitcnt lgkmcnt(0)" ::: "memory"); __builtin_amdgcn_s_barrier(); asm volatile("" ::: "memory");
#pragma unroll 1
        for (int g = 0; g < 4; ++g) {
            f32x16 acc[2];
#pragma unroll
            for (int j = 0; j < 2; ++j)
#pragma unroll
                for (int r = 0; r < 16; ++r) acc[j][r] = 0.f;
            const LAS unsigned char* tb = lds + g * 32768;
#pragma unroll
            for (int ks = 0; ks < 8; ++ks) {
                const s16x4 a = __builtin_amdgcn_ds_read_tr16_b64_v4i16((LAS s16x4*)(tb + traddr[0] + 4096 * ks));
                const s16x4 b2 = __builtin_amdgcn_ds_read_tr16_b64_v4i16((LAS s16x4*)(tb + traddr[1] + 4096 * ks));
                const s16x8 vf = __builtin_shufflevector(a, b2, 0, 1, 2, 3, 4, 5, 6, 7);
#pragma unroll
                for (int j = 0; j < 2; ++j) {
                    const s16x8 wf = *(const s16x8*)(sgw + (size_t)((((g * 4 + pb0 + j) * 8 + ks) * 64 + lane)) * 8);
                    acc[j] = __builtin_amdgcn_mfma_f32_32x32x16_bf16(vf, wf, acc[j], 0, 0, 0);
                }
            }
#pragma unroll
            for (int j = 0; j < 2; ++j) {
                const int ptok = (pb0 + j) * 32 + ql, row = row0 + ptok;
                const float bias = sg_b[g * 128 + ptok];
#pragma unroll
                for (int r4 = 0; r4 < 4; ++r4) {
                    const int c0 = g * 128 + cb * 32 + 8 * r4 + 4 * h2;
                    const uint2 u = *(const uint2*)(zb + (size_t)row * 1024 + c0);
                    u32x2 w;
                    w.x = cvtpk(bf2f((bf16_t)(u.x & 0xffff)) * (acc[j][4 * r4 + 0] + bias), bf2f((bf16_t)(u.x >> 16)) * (acc[j][4 * r4 + 1] + bias));
                    w.y = cvtpk(bf2f((bf16_t)(u.y & 0xffff)) * (acc[j][4 * r4 + 2] + bias), bf2f((bf16_t)(u.y >> 16)) * (acc[j][4 * r4 + 3] + bias));
                    *(u32x2*)(mix + (size_t)row * 1024 + 512 + c0) = w;
                }
            }
        }
        asm volatile("s_waitcnt lgkmcnt(0)" ::: "memory"); __builtin_amdgcn_s_barrier(); asm volatile("" ::: "memory");
    }
}
}


namespace rt {
typedef short s16x8 __attribute__((ext_vector_type(8)));
typedef float f32x4 __attribute__((ext_vector_type(4)));
typedef unsigned u32x2 __attribute__((ext_vector_type(2)));
typedef unsigned u32x4 __attribute__((ext_vector_type(4)));
constexpr int TROW = 2064;
constexpr int O_THI = 0, O_TLO = 16 * TROW, O_PART = 2 * 16 * TROW, O_LOG = O_PART + 8 * 16 * 48 * 4, O_VEC = O_LOG + 16 * 36 * 4, O_SEL = O_VEC + 5 * 4096;
DEV void ln1_router_phase(const Params& p, LAS unsigned char* lds) {
    const int tid = opaque_tid(), wid = __builtin_amdgcn_readfirstlane(tid >> 6), lane = tid & 63, fr = lane & 15, fq = lane >> 4;
    const float* x = p.in[I_X]; const float* ln_g = p.in[I_LN1G]; const float* ln_b = p.in[I_LN1B];
    const float* wgr = p.in[I_RGW]; const float* bgr = p.in[I_RGB]; const float* wer = p.in[I_REW]; const float* ber = p.in[I_REB];
    unsigned char* ws = p.ws; bf16_t* x1b = (bf16_t*)(ws + OFF_B);
    const float* mod = (const float*)(ws + OFF_MOD); const bf16_t* y = (const bf16_t*)(ws + OFF_A);
    bf16_t* tb = (bf16_t*)(ws + OFF_C);
    int* tok_e = (int*)(ws + OFF_TOKE); int* tok_p = (int*)(ws + OFF_TOKP); float* tok_w = (float*)(ws + OFF_TOKW); int* dmap = (int*)(ws + OFF_DMAP);
    unsigned* cnt = (unsigned*)(ws + OFF_CTL) + CW_CNT;
    s16x8 whi[3][4], wlo[3][4];
#pragma unroll
    for (int nt = 0; nt < 3; ++nt)
#pragma unroll
        for (int s = 0; s < 4; ++s)
#pragma unroll
            for (int j = 0; j < 8; ++j) {
                const int k = 128 * wid + 32 * s + 8 * fq + j, n = 16 * nt + fr;
                const float w = n < 4 ? wgr[k * 4 + n] : (n < 36 ? wer[k * 32 + (n - 4)] : 0.f);
                const bf16_t hi = f2bf(w); const bf16_t lo = f2bf(w - bf2f(hi));
                whi[nt][s][j] = (short)hi; wlo[nt][s][j] = (short)lo;
            }
    LAS int* sel_e = (LAS int*)(lds + O_SEL); LAS float* sel_w = (LAS float*)(lds + O_SEL + 1024); LAS int* sel_r = (LAS int*)(lds + O_SEL + 2048);
    LAS int* hist = (LAS int*)(lds + O_SEL + 3072); LAS int* gbase = (LAS int*)(lds + O_SEL + 3200); LAS float* bias = (LAS float*)(lds + O_SEL + 3328);
    if (tid < 36) bias[tid] = tid < 4 ? bgr[tid] : ber[tid - 4];
    for (int panel = blockIdx.x; panel < NTOK / 128; panel += gridDim.x) {
        const int row0 = panel * 128;
        const float* m = mod + (row0 / L) * 6144;
        float4 xr[2][2][2]; uint4 yr[2][2];
#define RT_LOAD(tile_) do { _Pragma("unroll") for (int rr_ = 0; rr_ < 2; ++rr_) _Pragma("unroll") for (int i_ = 0; i_ < 2; ++i_) { \
            const size_t o_ = (size_t)(row0 + (tile_) * 16 + wid * 2 + rr_) * D + 8 * lane + 512 * i_; \
            xr[rr_][i_][0] = *(const float4*)(x + o_); xr[rr_][i_][1] = *(const float4*)(x + o_ + 4); yr[rr_][i_] = *(const uint4*)(y + o_); } } while (0)
        RT_LOAD(0);
        { LAS float* vec = (LAS float*)(lds + O_VEC);
          for (int c = tid; c < 1024; c += 512) { const float g = ln_g[c], bb = ln_b[c], scl = m[4096 + c], sh = m[3072 + c];
              vec[c] = m[2048 + c]; vec[1024 + c] = g; vec[2048 + c] = bb; vec[3072 + c] = g * (1.f + scl); vec[4096 + c] = bb * (1.f + scl) + sh; } }
        if (tid < 32) hist[tid] = 0;
        asm volatile("s_waitcnt lgkmcnt(0)" ::: "memory"); __builtin_amdgcn_s_barrier(); asm volatile("" ::: "memory");
#pragma unroll 1
        for (int tile = 0; tile < 8; ++tile) {
#pragma unroll
            for (int rr = 0; rr < 2; ++rr) {
                const int lrow = wid * 2 + rr, row = row0 + tile * 16 + lrow;
                const LAS f32x4* vec = (const LAS f32x4*)(lds + O_VEC) + 2 * lane;
                float v[16]; float s = 0.f;
#pragma unroll
                for (int i = 0; i < 2; ++i) {
                    const float4 a0 = xr[rr][i][0], a1 = xr[rr][i][1];
                    float yv[8]; unpack8(yr[rr][i], yv);
                    const f32x4 g0 = vec[128 * i], g1 = vec[128 * i + 1];
                    v[8 * i + 0] = ALPHA * a0.x + g0[0] * yv[0]; v[8 * i + 1] = ALPHA * a0.y + g0[1] * yv[1]; v[8 * i + 2] = ALPHA * a0.z + g0[2] * yv[2]; v[8 * i + 3] = ALPHA * a0.w + g0[3] * yv[3];
                    v[8 * i + 4] = ALPHA * a1.x + g1[0] * yv[4]; v[8 * i + 5] = ALPHA * a1.y + g1[1] * yv[5]; v[8 * i + 6] = ALPHA * a1.z + g1[2] * yv[6]; v[8 * i + 7] = ALPHA * a1.w + g1[3] * yv[7];
#pragma unroll
                    for (int j = 0; j < 8; ++j) s += v[8 * i + j];
                }
                const float mu = wave_sum(s) * (1.0f / 1024.0f);
                float q = 0.f;
#pragma unroll
                for (int j = 0; j < 16; ++j) { v[j] -= mu; q += v[j] * v[j]; }
                const float rstd = rsqrtf(wave_sum(q) * (1.0f / 1024.0f) + EPS);
#pragma unroll
                for (int i = 0; i < 2; ++i) {
                    const int c = 8 * lane + 512 * i;
                    float xo[8], tt[8];
#pragma unroll
                    for (int h4 = 0; h4 < 2; ++h4) {
                        const f32x4 g = vec[256 + 128 * i + h4], bb = vec[512 + 128 * i + h4], g2 = vec[768 + 128 * i + h4], b2 = vec[1024 + 128 * i + h4];
#pragma unroll
                        for (int j = 0; j < 4; ++j) { const float n = v[8 * i + 4 * h4 + j] * rstd; xo[4 * h4 + j] = n * g[j] + bb[j]; tt[4 * h4 + j] = n * g2[j] + b2[j]; }
                    }
                    uint4 xb; xb.x = pack2(xo[0], xo[1]); xb.y = pack2(xo[2], xo[3]); xb.z = pack2(xo[4], xo[5]); xb.w = pack2(xo[6], xo[7]);
                    *(uint4*)(x1b + (size_t)row * D + c) = xb;
                    bf16_t hh[8];
#pragma unroll
                    for (int j = 0; j < 8; ++j) hh[j] = f2bf(tt[j]);
                    u32x4 hi4, lo4;
                    hi4.x = (unsigned)hh[0] | ((unsigned)hh[1] << 16); hi4.y = (unsigned)hh[2] | ((unsigned)hh[3] << 16); hi4.z = (unsigned)hh[4] | ((unsigned)hh[5] << 16); hi4.w = (unsigned)hh[6] | ((unsigned)hh[7] << 16);
                    lo4.x = pack2(tt[0] - bf2f(hh[0]), tt[1] - bf2f(hh[1])); lo4.y = pack2(tt[2] - bf2f(hh[2]), tt[3] - bf2f(hh[3]));
                    lo4.z = pack2(tt[4] - bf2f(hh[4]), tt[5] - bf2f(hh[5])); lo4.w = pack2(tt[6] - bf2f(hh[6]), tt[7] - bf2f(hh[7]));
                    { uint4 tw; tw.x = hi4.x; tw.y = hi4.y; tw.z = hi4.z; tw.w = hi4.w; *(uint4*)(tb + (size_t)row * D + c) = tw; }
                    *(LAS u32x4*)(lds + O_THI + lrow * TROW + c * 2) = hi4;
                    *(LAS u32x4*)(lds + O_TLO + lrow * TROW + c * 2) = lo4;
                }
            }
            if (tile < 7) RT_LOAD(tile + 1);
            asm volatile("s_waitcnt lgkmcnt(0)" ::: "memory"); __builtin_amdgcn_s_barrier(); asm volatile("" ::: "memory");
            f32x4 acc[3];
#pragma unroll
            for (int nt = 0; nt < 3; ++nt) acc[nt] = (f32x4){0.f, 0.f, 0.f, 0.f};
#pragma unroll
            for (int s = 0; s < 4; ++s) {
                const int kb = (128 * wid + 32 * s + 8 * fq) * 2;
                const s16x8 ahi = *(const LAS s16x8*)(lds + O_THI + fr * TROW + kb);
                const s16x8 alo = *(const LAS s16x8*)(lds + O_TLO + fr * TROW + kb);
#pragma unroll
                for (int nt = 0; nt < 3; ++nt) {
                    acc[nt] = __builtin_amdgcn_mfma_f32_16x16x32_bf16(ahi, whi[nt][s], acc[nt], 0, 0, 0);
                    acc[nt] = __builtin_amdgcn_mfma_f32_16x16x32_bf16(ahi, wlo[nt][s], acc[nt], 0, 0, 0);
                    acc[nt] = __builtin_amdgcn_mfma_f32_16x16x32_bf16(alo, whi[nt][s], acc[nt], 0, 0, 0);
                }
            }
            { LAS float* part = (LAS float*)(lds + O_PART) + wid * (16 * 48);
#pragma unroll
              for (int nt = 0; nt < 3; ++nt)
#pragma unroll
                  for (int r = 0; r < 4; ++r) part[(fq * 4 + r) * 48 + 16 * nt + fr] = acc[nt][r]; }
            asm volatile("s_waitcnt lgkmcnt(0)" ::: "memory"); __builtin_amdgcn_s_barrier(); asm volatile("" ::: "memory");
            for (int i = tid; i < 16 * 36; i += 512) {
                const int r = i / 36, o = i - r * 36; const LAS float* part = (const LAS float*)(lds + O_PART) + r * 48 + o;
                float sum = 0.f;
#pragma unroll
                for (int w = 0; w < 8; ++w) sum += part[w * (16 * 48)];
                ((LAS float*)(lds + O_LOG))[i] = sum;
            }
            asm volatile("s_waitcnt lgkmcnt(0)" ::: "memory"); __builtin_amdgcn_s_barrier(); asm volatile("" ::: "memory");
            if (tid < 16) {
                const int lr = tile * 16 + tid; const LAS float* lg = (const LAS float*)(lds + O_LOG) + tid * 36;
                float gl[4]; int gs = 0;
#pragma unroll
                for (int g = 0; g < 4; ++g) gl[g] = lg[g] + bias[g];
                float gmax = gl[0];
#pragma unroll
                for (int g = 1; g < 4; ++g) if (gl[g] > gmax) { gmax = gl[g]; gs = g; }
                float gsum = 0.f;
#pragma unroll
                for (int g = 0; g < 4; ++g) gsum += expf(gl[g] - gmax);
                const float gw = 1.0f / gsum;
                float el[8];
#pragma unroll
                for (int j = 0; j < 8; ++j) el[j] = lg[4 + gs * 8 + j] + bias[4 + gs * 8 + j];
                int i0 = 0; float v0 = el[0];
#pragma unroll
                for (int j = 1; j < 8; ++j) if (el[j] > v0) { v0 = el[j]; i0 = j; }
                int i1 = -1; float v1 = -3.0e38f;
#pragma unroll
                for (int j = 0; j < 8; ++j) if (j != i0 && (i1 < 0 || el[j] > v1)) { v1 = el[j]; i1 = j; }
                const float ex = expf(v1 - v0), w0 = gw / (1.0f + ex), w1 = gw * ex / (1.0f + ex);
                const int e0 = gs * 8 + i0, e1 = gs * 8 + i1;
                const int r0 = __hip_atomic_fetch_add(hist + e0, 1, __ATOMIC_RELAXED, __HIP_MEMORY_SCOPE_WORKGROUP), r1 = __hip_atomic_fetch_add(hist + e1, 1, __ATOMIC_RELAXED, __HIP_MEMORY_SCOPE_WORKGROUP);
                sel_e[2 * lr] = e0; sel_e[2 * lr + 1] = e1; sel_w[2 * lr] = w0; sel_w[2 * lr + 1] = w1; sel_r[2 * lr] = r0; sel_r[2 * lr + 1] = r1;
            }
        }
#undef RT_LOAD
        asm volatile("s_waitcnt lgkmcnt(0)" ::: "memory"); __builtin_amdgcn_s_barrier(); asm volatile("" ::: "memory");
        if (tid < 32) { const int h = hist[tid]; gbase[tid] = h > 0 ? (int)atomicAdd(&cnt[tid * CNT_STRIDE], (unsigned)h) : 0; }
        asm volatile("s_waitcnt vmcnt(0) lgkmcnt(0)" ::: "memory"); __builtin_amdgcn_s_barrier(); asm volatile("" ::: "memory");
        if (tid < 256) {
            const int e = sel_e[tid], pz = gbase[e] + sel_r[tid];
            tok_e[row0 * 2 + tid] = e; tok_p[row0 * 2 + tid] = pz; tok_w[row0 * 2 + tid] = sel_w[tid]; dmap[e * NTOK + pz] = row0 + (tid >> 1);
        }
        asm volatile("s_waitcnt lgkmcnt(0)" ::: "memory"); __builtin_amdgcn_s_barrier(); asm volatile("" ::: "memory");
    }
}
}

__global__ void __launch_bounds__(512, 2) mega_fwd(Params p) {
    extern __shared__ __attribute__((aligned(16))) unsigned char lds[];
    unsigned char* ws = p.ws;
    if (threadIdx.x < 4) ((volatile LAS unsigned*)((LAS unsigned char*)lds + MISC_OFF))[threadIdx.x] = 0u;
    if (threadIdx.x == 4) ((volatile LAS unsigned*)((LAS unsigned char*)lds + MISC_OFF))[18] = 0u;
    __syncthreads();
    const XcdBarrier bar = xcd_barrier_post((unsigned*)(ws + OFF_CTL) + CW_BAR, (volatile LAS unsigned*)((LAS unsigned char*)lds + MISC_OFF));
    PG8_LAS unsigned char* ring = (PG8_LAS unsigned char*)lds;
    const int G = gridDim.x, bid = blockIdx.x;

    if (bid == G - 1) phase_prep(p);
    phase_mod(p, lds);
    phase_conv(p, (LAS unsigned char*)lds);
    xcd_barrier(bar);
    phase_modulate_ctx(p);
    { asm volatile("s_waitcnt vmcnt(0)" ::: "memory"); __syncthreads();
      unsigned* hcc = (unsigned*)(ws + OFF_CTL) + CW_HC;
      if (threadIdx.x == 0) {
          __builtin_amdgcn_fence(__ATOMIC_RELEASE, "agent"); asm volatile("s_waitcnt vmcnt(0)" ::: "memory");
          for (int panel = bid; panel < NCTX / 16; panel += G) (void)xb_add(hcc + (panel * 16) / CTX, 1u);
      }
      pg8::PlainOrder S; S.init(NCTX / 256, 4, G, bid); S.pb0 = 2;
      int pm, pn;
      if (S.map(0, pm, pn)) {
          if (threadIdx.x == 0) {
              for (int i = 0; S.map(i, pm, pn); ++i) { unsigned spins = 0; while (xb_ld(hcc + pm) < (unsigned)(CTX / 16) && ++spins < (1u << 22)) __builtin_amdgcn_s_sleep(4); }
              __builtin_amdgcn_fence(__ATOMIC_ACQUIRE, "agent"); asm volatile("s_waitcnt vmcnt(0)" ::: "memory");
          }
          __syncthreads();
          pg8::Gemm g{(const bf16_t*)(ws + OFF_A + 128 * MiB), (const bf16_t*)(ws + OFF_WIN), nullptr, D};
          pg8::EpiInProj E{ws, ring + ROPE_LDS, 1, 0}; pg8::gemm_phase<pg8::EpiInProj, pg8::PlainOrder, false>(ring, g, S, E);
      } }
    phase_modulate_x(p, (LAS unsigned char*)lds);
    xcd_barrier(bar);
    { const int tx = opaque_tid(); const float* rg = (const float*)(ws + OFF_ROPE);
      for (int i = tx; i < 2048; i += 512) ((LAS float*)((LAS unsigned char*)lds + ROPE_LDS))[i] = rg[i];
      asm volatile("s_waitcnt vmcnt(0) lgkmcnt(0)" ::: "memory"); __syncthreads(); }
    { pg8::Gemm g{(const bf16_t*)(ws + OFF_A), (const bf16_t*)(ws + OFF_WIN), nullptr, D}; pg8::PlainOrder S; S.init(NTOK / 256, INC / 256, G, bid); S.pb0 = 0;
      pg8::EpiInProj E{ws, ring + ROPE_LDS, 0, 0}; pg8::gemm_phase<pg8::EpiInProj, pg8::PlainOrder, false>(ring, g, S, E); }
    xcd_barrier(bar);
    sg::sg_phase(p, (LAS unsigned char*)lds);
    att::attn_phase(p, (LAS unsigned char*)lds);
    xcd_barrier(bar);
    { pg8::Gemm g{(const bf16_t*)(ws + OFF_C), (const bf16_t*)(ws + OFF_WOUT), nullptr, D}; pg8::PlainOrder S; S.init(NTOK / 256, D / 256, G, bid); S.pb0 = 0;
      pg8::EpiBf16 E{(bf16_t*)(ws + OFF_A), D, 0}; pg8::gemm_phase<pg8::EpiBf16, pg8::PlainOrder, false>(ring, g, S, E); }
    xcd_barrier(bar);
    rt::ln1_router_phase(p, (LAS unsigned char*)lds);
    xcd_barrier(bar);
    moe_tables(p, (LAS unsigned char*)lds);
    const PG8_LAS int* tile_e = (const PG8_LAS int*)(ring + MOE_TE); const PG8_LAS int* tile_p0 = (const PG8_LAS int*)(ring + MOE_TP);
    const unsigned* ecnt = (const unsigned*)(ws + OFF_CTL) + CW_CNT;
    const int Mt = tile_e[MAXT], ns = moe_early_tiles(Mt, G);
    unsigned* sdone = (unsigned*)(ws + OFF_CTL) + CW_SDONE;
    { pg8::Gemm g{(const bf16_t*)(ws + OFF_C), (const bf16_t*)(ws + OFF_WGU), (const int*)(ws + OFF_DMAP), D};
      pg8::MoeOrder S; S.init(Mt, 8, G, bid); S.tile_e = tile_e; S.tile_p0 = tile_p0; S.cnt = ecnt; S.tpe = 8; S.pm0 = 0;
      int pub_ui = -1, pub_n = 0;
      if (ns > 0) { pg8::Unit u; for (int i = 0; S.next(i, u); ++i) if (u.pm < ns) { pub_ui = i; ++pub_n; } }
      pg8::EpiGateUp E{(bf16_t*)(ws + OFF_A), sdone, pub_ui, pub_n}; pg8::gemm_phase<pg8::EpiGateUp, pg8::MoeOrder, true>(ring, g, S, E);
      const int j = bid - (8 * Mt) % G;
      if (ns > 0 && j >= 0 && j < 4 * ns) {
          if (threadIdx.x == 0) { unsigned spins = 0; while (xb_ld(sdone) < (unsigned)(8 * ns) && ++spins < (1u << 22)) __builtin_amdgcn_s_sleep(4);
              __builtin_amdgcn_fence(__ATOMIC_ACQUIRE, "agent"); asm volatile("s_waitcnt vmcnt(0)" ::: "memory"); }
          __syncthreads();
          pg8::Gemm g2{(const bf16_t*)(ws + OFF_A), (const bf16_t*)(ws + OFF_WD), nullptr, D};
          pg8::OneOrder S1{j >> 2, j & 3, tile_e[j >> 2] * 4 + (j & 3)};
          pg8::EpiBf16 E2{(bf16_t*)(ws + OFF_Y2E), D, 0}; pg8::gemm_phase<pg8::EpiBf16, pg8::OneOrder, false>(ring, g2, S1, E2);
      } }
    xcd_barrier(bar);
    { pg8::Gemm g{(const bf16_t*)(ws + OFF_A), (const bf16_t*)(ws + OFF_WD), nullptr, D};
      pg8::MoeOrder S; S.init(Mt - ns, 4, G, bid); S.tile_e = tile_e; S.tile_p0 = tile_p0; S.cnt = ecnt; S.tpe = 4; S.pm0 = ns;
      pg8::EpiBf16 E{(bf16_t*)(ws + OFF_Y2), D, 0}; pg8::gemm_phase<pg8::EpiBf16, pg8::MoeOrder, false>(ring, g, S, E); }
    xcd_barrier(bar);
    phase_final(p, (LAS unsigned char*)lds);
}

extern "C" void kernel_launch(void* const* d_in, const int* in_sizes, int n_in, void* d_out, int out_size, void* d_ws, size_t ws_size, hipStream_t stream) {
    (void)in_sizes; (void)out_size;
    static int grid = 0;
    if (grid == 0) {
        if (n_in != 28 || ws_size < WS_END) { fprintf(stderr, "kernel_launch: expected 28 inputs and >= %zu bytes of workspace (got %d, %zu)\n", (size_t)WS_END, n_in, ws_size); grid = -1; return; }
        int dev = 0, cus = 0, per_cu = 0;
        if (hipGetDevice(&dev) != hipSuccess || hipDeviceGetAttribute(&cus, hipDeviceAttributeMultiprocessorCount, dev) != hipSuccess) { grid = -1; return; }
        if (hipFuncSetAttribute((const void*)mega_fwd, hipFuncAttributeMaxDynamicSharedMemorySize, LDS_BYTES) != hipSuccess) { fprintf(stderr, "kernel_launch: hipFuncSetAttribute failed\n"); grid = -1; return; }
        if (hipOccupancyMaxActiveBlocksPerMultiprocessor(&per_cu, (const void*)mega_fwd, 512, LDS_BYTES) != hipSuccess || per_cu < 1) { fprintf(stderr, "kernel_launch: occupancy query says %d\n", per_cu); per_cu = 1; }
        (void)hipGetLastError();
        grid = cus;
    }
    if (grid < 0) return;
    if (hipMemsetAsync((unsigned char*)d_ws + OFF_CTL, 0, 65536, stream) != hipSuccess) return;
    Params p{};
    for (int i = 0; i < 28; ++i) p.in[i] = (const float*)d_in[i];
    p.out = (float*)d_out; p.ws = (unsigned char*)d_ws;
    hipLaunchKernelGGL(mega_fwd, dim3(grid), dim3(512), LDS_BYTES, stream, p);
}
```

```cpp
#include <hip/hip_runtime.h>
#include <cstdint>
#include <cstdio>

typedef unsigned short bf16_t;
#define DEV __device__ __forceinline__
#define LAS __attribute__((address_space(3)))

namespace cfg {
constexpr int B = 16, L = 2048, D = 1024, NTOK = B * L, CTX = 256, NCTX = B * CTX, KEYS = L + CTX;
constexpr int INC = 2560, NE = 32, PMAX = 73728, MAXT = 288;
constexpr float EPS = 1e-5f, ALPHA = 1.189207115002721f, LAM_INIT = 0.2f;
constexpr size_t MiB = 1048576;
constexpr size_t OFF_CTL = 0;
constexpr size_t OFF_MOD = 65536;
constexpr size_t OFF_ROPE = OFF_MOD + 17 * 6144 * 4;
constexpr size_t OFF_LAM = OFF_ROPE + 8192;
constexpr size_t OFF_TOKE = OFF_LAM + 256;
constexpr size_t OFF_TOKP = OFF_TOKE + 262144;
constexpr size_t OFF_TOKW = OFF_TOKP + 262144;
constexpr size_t OFF_TOKS = OFF_TOKW + 262144;
constexpr size_t OFF_SLOTTOK = OFF_TOKS + 262144;
constexpr size_t OFF_TILEE = OFF_SLOTTOK + PMAX * 4;
constexpr size_t OFF_WIN = 2 * MiB;
constexpr size_t OFF_WOUT = 7 * MiB;
constexpr size_t OFF_SGW = 9 * MiB;
constexpr size_t OFF_WGU = 10 * MiB;
constexpr size_t OFF_C = 138 * MiB;
constexpr size_t OFF_Y2 = OFF_WGU;
constexpr size_t OFF_WD = 202 * MiB;
constexpr size_t OFF_A = 266 * MiB;
constexpr size_t OFF_B = 410 * MiB;
constexpr size_t OFF_DMAP = OFF_B + 64 * MiB;
constexpr size_t OFF_Y2E = OFF_B + 68 * MiB;
constexpr size_t WS_END = 554 * MiB;
constexpr int CW_BAR = 0;
constexpr int CW_CNT = 8192, CNT_STRIDE = 32;
constexpr int CW_HC = 4736;
constexpr int CW_SDONE = 4800;
constexpr int LDS_BYTES = 147456, MISC_OFF = 143360, ROPE_LDS = 131072;
constexpr int MOE_LDS = MISC_OFF + 128;
constexpr int MOE_TE = MOE_LDS, MOE_TP = MOE_LDS + 1280, MOE_BASE = MOE_LDS + 2560;
}
using namespace cfg;

DEV bf16_t f2bf(float f) { unsigned u = __float_as_uint(f); u += 0x7fffu + ((u >> 16) & 1u); return (bf16_t)(u >> 16); }
DEV float bf2f(bf16_t h) { return __uint_as_float(((unsigned)h) << 16); }
DEV unsigned pack2(float lo, float hi) { return (unsigned)f2bf(lo) | ((unsigned)f2bf(hi) << 16); }
DEV float wave_sum(float v) { for (int o = 32; o; o >>= 1) v += __shfl_xor(v, o); return v; }
DEV float wave_max(float v) { for (int o = 32; o; o >>= 1) v = fmaxf(v, __shfl_xor(v, o)); return v; }
DEV float silu_f(float x) { return x / (1.0f + __expf(-x)); }
DEV int opaque_tid() { int t = threadIdx.x; asm volatile("" : "+v"(t)); return t; }

#define XB_TMO      128
#define XB_XCNT(j)  (256  + 64 * (j))
#define XB_XSUB(j)  (1280 + 64 * (j))
#define XB_XGEN(j)  (2304 + 64 * (j))
#define XB_TOP      3328
#define XB_TOPGEN   3392
#define XCD_BAR_WORDS 3456
#define XB_SPIN_CAP (1u << 18)

__device__ __forceinline__ unsigned xb_ld(unsigned* p)              { return __hip_atomic_load(p, __ATOMIC_RELAXED, __HIP_MEMORY_SCOPE_AGENT); }
__device__ __forceinline__ unsigned xb_add(unsigned* p, unsigned v) { return __hip_atomic_fetch_add(p, v, __ATOMIC_RELAXED, __HIP_MEMORY_SCOPE_AGENT); }
__device__ __forceinline__ unsigned xb_xcc_id() { return (unsigned)__builtin_amdgcn_s_getreg((3 << 11) | 20) & 0xFu; }
#define XB_SPIN(cond, bar) do { unsigned _sp = 0; while (cond) { __builtin_amdgcn_s_sleep(1); \
    if ((++_sp & 255u) == 0u) { if (xb_ld(&(bar)[XB_TMO])) break; if (_sp > XB_SPIN_CAP) { atomicAdd(&(bar)[XB_TMO], 1u); break; } } } } while (0)

struct XcdBarrier {
    unsigned* bar; unsigned x;
    volatile LAS unsigned* st;
};

__device__ __forceinline__ XcdBarrier xcd_barrier_post(unsigned* bar, volatile LAS unsigned* st) {
    XcdBarrier b; b.bar = bar; b.x = xb_xcc_id(); b.st = st;
    if (threadIdx.x == 0) (void)xb_add(&bar[XB_XCNT(b.x)], 1u);
    return b;
}
__device__ __forceinline__ void xcd_barrier_complete(unsigned* bar, unsigned x, unsigned& nloc, unsigned& nx) {
    const unsigned G = gridDim.x * gridDim.y * gridDim.z;
    unsigned sum, cnt, mine, sp = 0u;
    for (;;) {
        sum = 0u; cnt = 0u; mine = 0u;
#pragma unroll
        for (unsigned j = 0; j < 16; ++j) { const unsigned c = xb_ld(&bar[XB_XCNT(j)]); sum += c; cnt += (c > 0u) ? 1u : 0u; mine = (j == x) ? c : mine; }
        if (sum == G) break;
        __builtin_amdgcn_s_sleep(1);
        if ((++sp & 255u) == 0u) { if (xb_ld(&bar[XB_TMO])) break; if (sp > XB_SPIN_CAP) { atomicAdd(&bar[XB_TMO], 1u); break; } }
    }
    nloc = mine > 0u ? mine : 1u; nx = cnt > 0u ? cnt : 1u;
}

__device__ __forceinline__ void xcd_barrier(const XcdBarrier& b) {
    asm volatile("s_waitcnt vmcnt(0)" ::: "memory");
    __syncthreads();
    if (threadIdx.x == 0) {
        unsigned* bar = b.bar;
        __builtin_amdgcn_s_waitcnt(0);
        unsigned nloc = b.st[0], nx = b.st[1];
        if (nloc == 0u) { xcd_barrier_complete(bar, b.x, nloc, nx); b.st[0] = nloc; b.st[1] = nx; }
        const unsigned old = xb_add(&bar[XB_XSUB(b.x)], 1u);
        const unsigned gen = old / nloc;
        if (old + 1u == (gen + 1u) * nloc) {
            __builtin_amdgcn_fence(__ATOMIC_RELEASE, "agent");
            asm volatile("s_waitcnt vmcnt(0)" ::: "memory");
            const unsigned og = xb_add(&bar[XB_TOP], 1u);
            const unsigned tg = og / nx;
            if (og + 1u == (tg + 1u) * nx) xb_add(&bar[XB_TOPGEN], 1u);
            else XB_SPIN(xb_ld(&bar[XB_TOPGEN]) == tg, bar);
            __builtin_amdgcn_fence(__ATOMIC_ACQUIRE, "agent");
            xb_add(&bar[XB_XGEN(b.x)], 1u);
            asm volatile("s_waitcnt vmcnt(0)" ::: "memory");
        } else {
            XB_SPIN(xb_ld(&bar[XB_XGEN(b.x)]) == gen, bar);
            __builtin_amdgcn_fence(__ATOMIC_ACQUIRE, "agent");
            asm volatile("s_waitcnt vmcnt(0)" ::: "memory");
        }
    }
    __syncthreads();
}

namespace pg8 {
#define PG8_LAS __attribute__((address_space(3)))
typedef short bf16x8 __attribute__((ext_vector_type(8)));
typedef float f32x4 __attribute__((ext_vector_type(4)));
typedef float f32x2 __attribute__((ext_vector_type(2)));
typedef unsigned u32x4 __attribute__((ext_vector_type(4)));
typedef unsigned u32x2 __attribute__((ext_vector_type(2)));
constexpr int BM = 256, BK = 64, HALF = 128, HTB = HALF * BK * 2, STAGE_BYTES = 8 * HTB, NXCD = 8, WGM = 8;
__host__ __device__ __forceinline__ int lds_byte(int r, int c) { const int st = (r >> 4) * 2 + (c >> 5), rr = r & 15, cc = c & 31, ob = rr * 64 + cc * 2; return st * 1024 + (ob ^ (((ob >> 9) & 1) << 5)); }
__host__ __device__ __forceinline__ void stage_rc(int b, int& R, int& C) { const int st = b / 1024, sb = b % 1024, swz = sb ^ (((sb >> 9) & 1) << 5); R = (st >> 1) * 16 + swz / 64; C = (st & 1) * 32 + (swz % 64) / 2; }
__host__ __device__ __forceinline__ int perm32(int rho) { const int n = rho >> 4, i = rho & 15; return 8 * (i >> 2) + 4 * n + (i & 3); }

struct Unit { int pm, pn, pb, ge, gp0, gcnt, ui; };
struct Gemm { const bf16_t* A; const bf16_t* Bt; const int* rowmap; int K; };

struct TileOrder {
    int nM, nN, nwg, G, c;
    __device__ __forceinline__ void init(int nM_, int nN_, int G_, int c_) { nM = nM_; nN = nN_; nwg = nM * nN; G = G_; c = c_; }
    __device__ __forceinline__ bool map(int i, int& pm, int& pn) const {
        const long L = (long)i * G + c; if (L >= nwg) return false;
        int wgid = (int)L; { const int q = nwg / NXCD, r = nwg % NXCD, xcd = wgid % NXCD, off = wgid / NXCD; wgid = (xcd < r ? xcd * (q + 1) : r * (q + 1) + (xcd - r) * q) + off; }
        const int nig = WGM * nN, gid = wgid / nig, fm = gid * WGM, gsz = (nM - fm) < WGM ? (nM - fm) : WGM;
        pm = fm + ((wgid % nig) % gsz); pn = (wgid % nig) / gsz; return true;
    }
};
struct PlainOrder : TileOrder {
    int pb0;
    __device__ __forceinline__ bool next(int i, Unit& u) const { if (!map(i, u.pm, u.pn)) return false; u.pb = pb0 + u.pn; u.ge = 0; u.gp0 = 0; u.gcnt = 0; u.ui = i; return true; }
};
struct MoeOrder : TileOrder {
    const PG8_LAS int* tile_e; const PG8_LAS int* tile_p0; const unsigned* cnt; int tpe; int pm0;
    __device__ __forceinline__ bool next(int i, Unit& u) const { if (!map(i, u.pm, u.pn)) return false; u.pm += pm0;
        const int e = tile_e[u.pm]; u.pb = e * tpe + u.pn; u.ge = e; u.gp0 = tile_p0[u.pm]; u.gcnt = (int)cnt[e * CNT_STRIDE]; u.ui = i; return true; }
};
struct OneOrder {
    int pm, pn, pb;
    __device__ __forceinline__ bool next(int i, Unit& u) const { if (i != 0) return false; u.pm = pm; u.pn = pn; u.pb = pb; u.ge = 0; u.gp0 = 0; u.gcnt = 0; u.ui = 0; return true; }
};

__device__ __forceinline__ unsigned cvt_pk_bf16(float lo, float hi) { unsigned r; asm volatile("v_cvt_pk_bf16_f32 %0, %1, %2" : "=v"(r) : "v"(lo), "v"(hi)); return r; }
__device__ __forceinline__ f32x2 gelu_pk(f32x2 v) {
    const f32x2 av = __builtin_elementwise_abs(v), d = av * 0.2316418882f + 1.0f;
    f32x2 t; t.x = __builtin_amdgcn_rcpf(d.x); t.y = __builtin_amdgcn_rcpf(d.y);
    f32x2 q = t * 0.5307027145f + (-0.7265760135f); q = q * t + 0.7107068705f; q = q * t + (-0.142248368f); q = q * t + 0.127414796f; q = q * t;
    const f32x2 s = (v * v) * (-0.72134752044f);
    f32x2 e; e.x = __builtin_amdgcn_exp2f(s.x); e.y = __builtin_amdgcn_exp2f(s.y);
    const f32x2 m = v * (q * e), r = v - m;
    f32x2 o; o.x = v.x < 0.f ? m.x : r.x; o.y = v.y < 0.f ? m.y : r.y; return o;
}

struct EpiInProj {
    static constexpr bool PERM = false;
    unsigned char* ws; PG8_LAS unsigned char* ropel; int ctx; int pad;
    __device__ __forceinline__ void operator()(const f32x4 (&acc)[2][2][4][2], const Unit& u, int wr, int wc, int fr, int fq) const {
        const PG8_LAS float* rope = (const PG8_LAS float*)ropel;
        bf16_t* qb = (bf16_t*)(ws + OFF_B); bf16_t* kb = (bf16_t*)(ws + OFF_B + 32 * MiB); bf16_t* vb = (bf16_t*)(ws + OFF_B + 68 * MiB); bf16_t* zb = (bf16_t*)(ws + OFF_A + 64 * MiB);
        const int gc0 = (ctx ? 512 : 0) + u.pn * BM;
#pragma unroll
        for (int ai = 0; ai < 2; ++ai)
#pragma unroll
            for (int m = 0; m < 4; ++m) {
                const int r = u.pm * BM + ai * HALF + wr * 64 + m * 16 + fr;
                size_t krow; int l;
                if (ctx) { krow = (size_t)(r / CTX) * KEYS + L + (r % CTX); l = 0; } else { l = r % L; krow = (size_t)(r / L) * KEYS + l; }
#pragma unroll
                for (int bj = 0; bj < 2; ++bj) {
                    const int gc = gc0 + bj * HALF + wc * 32;
                    const f32x4 a0 = acc[ai][bj][m][0], a1 = acc[ai][bj][m][1];
                    if (gc < 1024) {
                        f32x4 lo = a0, hi = a1;
                        if (!ctx) {
                            const int pos = ((gc >> 5) & 1) ? (l & 63) : (l >> 6);
                            const PG8_LAS float* rp = rope + (pos * 16 + 4 * fq) * 2;
                            const f32x4 c01 = *(const PG8_LAS f32x4*)rp, c23 = *(const PG8_LAS f32x4*)(rp + 4);
                            const float sc = gc < 512 ? 0.125f * 1.4426950408889634f : 1.0f;
                            lo[0] = (a0[0] * c01[0] - a1[0] * c01[1]) * sc; hi[0] = (a1[0] * c01[0] + a0[0] * c01[1]) * sc;
                            lo[1] = (a0[1] * c01[2] - a1[1] * c01[3]) * sc; hi[1] = (a1[1] * c01[2] + a0[1] * c01[3]) * sc;
                            lo[2] = (a0[2] * c23[0] - a1[2] * c23[1]) * sc; hi[2] = (a1[2] * c23[0] + a0[2] * c23[1]) * sc;
                            lo[3] = (a0[3] * c23[2] - a1[3] * c23[3]) * sc; hi[3] = (a1[3] * c23[2] + a0[3] * c23[3]) * sc;
                        }
                        bf16_t* dst;
                        if (gc < 512) dst = qb + (size_t)(gc >> 8) * ((size_t)NTOK * 256) + (size_t)r * 256 + (gc & 255) + 4 * fq;
                        else dst = kb + (size_t)((gc - 512) >> 8) * ((size_t)B * KEYS * 256) + krow * 256 + (gc & 255) + 4 * fq;
                        u32x2 w0, w1; w0.x = cvt_pk_bf16(lo[0], lo[1]); w0.y = cvt_pk_bf16(lo[2], lo[3]); w1.x = cvt_pk_bf16(hi[0], hi[1]); w1.y = cvt_pk_bf16(hi[2], hi[3]);
                        *(u32x2*)dst = w0; *(u32x2*)(dst + 16) = w1;
                    } else if (gc < 1536) {
                        bf16_t* dst = vb + krow * 512 + (gc - 1024) + 4 * fq;
                        u32x2 w0, w1; w0.x = cvt_pk_bf16(a0[0], a0[1]); w0.y = cvt_pk_bf16(a0[2], a0[3]); w1.x = cvt_pk_bf16(a1[0], a1[1]); w1.y = cvt_pk_bf16(a1[2], a1[3]);
                        *(u32x2*)dst = w0; *(u32x2*)(dst + 16) = w1;
                    } else {
                        bf16_t* dst = zb + (size_t)r * 1024 + (gc - 1536) + 4 * fq;
                        const f32x2 g0 = gelu_pk((f32x2){a0[0], a0[1]}), g1 = gelu_pk((f32x2){a0[2], a0[3]}), g2 = gelu_pk((f32x2){a1[0], a1[1]}), g3 = gelu_pk((f32x2){a1[2], a1[3]});
                        u32x2 w0, w1; w0.x = cvt_pk_bf16(g0.x, g0.y); w0.y = cvt_pk_bf16(g1.x, g1.y); w1.x = cvt_pk_bf16(g2.x, g2.y); w1.y = cvt_pk_bf16(g3.x, g3.y);
                        *(u32x2*)dst = w0; *(u32x2*)(dst + 16) = w1;
                    }
                }
            }
    }
};
struct EpiF32 {
    static constexpr bool PERM = false;
    float* O; int ldc; int pad;
    __device__ __forceinline__ void operator()(const f32x4 (&acc)[2][2][4][2], const Unit& u, int wr, int wc, int fr, int fq) const {
#pragma unroll
        for (int ai = 0; ai < 2; ++ai)
#pragma unroll
            for (int m = 0; m < 4; ++m) { float* rowp = O + (size_t)(u.pm * BM + ai * HALF + wr * 64 + m * 16 + fr) * ldc + u.pn * BM + wc * 32 + 4 * fq;
#pragma unroll
                for (int bj = 0; bj < 2; ++bj)
#pragma unroll
                    for (int n = 0; n < 2; ++n) *(f32x4*)(rowp + bj * HALF + 16 * n) = acc[ai][bj][m][n]; }
    }
};
struct EpiGateUp {
    static constexpr bool PERM = true;
    bf16_t* O; unsigned* sdone; int pub_ui; int pub_n;
    __device__ __forceinline__ void operator()(const f32x4 (&acc)[2][2][4][2], const Unit& u, int wr, int wc, int fr, int fq) const {
        store(acc, u, wr, wc, fr, fq);
        if (u.ui == pub_ui) {
            asm volatile("s_waitcnt vmcnt(0)" ::: "memory"); __builtin_amdgcn_s_barrier();
            if (threadIdx.x == 0) { __builtin_amdgcn_fence(__ATOMIC_RELEASE, "agent"); asm volatile("s_waitcnt vmcnt(0)" ::: "memory"); (void)xb_add(sdone, (unsigned)pub_n); }
        }
    }
    __device__ __forceinline__ void store(const f32x4 (&acc)[2][2][4][2], const Unit& u, int wr, int wc, int fr, int fq) const {
#pragma unroll
        for (int ai = 0; ai < 2; ++ai)
#pragma unroll
            for (int m = 0; m < 4; ++m) { bf16_t* dst = O + (size_t)(u.pm * BM + ai * HALF + wr * 64 + m * 16 + fr) * D + u.pn * HALF + wc * 32 + 8 * fq;
                float h[8];
#pragma unroll
                for (int n = 0; n < 2; ++n)
#pragma unroll
                    for (int j = 0; j < 4; ++j) { const float g = acc[ai][0][m][n][j], up = acc[ai][1][m][n][j]; h[4 * n + j] = g * __builtin_amdgcn_rcpf(1.0f + __expf(-g)) * up; }
                u32x4 w; w.x = cvt_pk_bf16(h[0], h[1]); w.y = cvt_pk_bf16(h[2], h[3]); w.z = cvt_pk_bf16(h[4], h[5]); w.w = cvt_pk_bf16(h[6], h[7]);
                *(u32x4*)dst = w; }
    }
};
struct EpiBf16 {
    static constexpr bool PERM = true;
    bf16_t* O; int ldc; int pad;
    __device__ __forceinline__ void operator()(const f32x4 (&acc)[2][2][4][2], const Unit& u, int wr, int wc, int fr, int fq) const {
#pragma unroll
        for (int ai = 0; ai < 2; ++ai)
#pragma unroll
            for (int m = 0; m < 4; ++m) { bf16_t* rowp = O + (size_t)(u.pm * BM + ai * HALF + wr * 64 + m * 16 + fr) * ldc + u.pn * BM + wc * 32 + 8 * fq;
#pragma unroll
                for (int bj = 0; bj < 2; ++bj) { const f32x4 v0 = acc[ai][bj][m][0], v1 = acc[ai][bj][m][1];
                    u32x4 w; w.x = cvt_pk_bf16(v0[0], v0[1]); w.y = cvt_pk_bf16(v0[2], v0[3]); w.z = cvt_pk_bf16(v1[0], v1[1]); w.w = cvt_pk_bf16(v1[2], v1[3]);
                    *(u32x4*)(rowp + bj * HALF) = w; } }
    }
};

template <class Epi, class Sched, bool GATHER>
__device__ __forceinline__ void gemm_phase(PG8_LAS unsigned char* lds, const Gemm g, const Sched& S, const Epi& E) {
    const int tid = opaque_tid(), wid = __builtin_amdgcn_readfirstlane(tid >> 6), lane = tid & 63, wr = wid >> 2, wc = wid & 3, fr = lane & 15, fq = lane >> 4;
    const int K = g.K, nt = K / BK;
    int RA[2]; unsigned colA[2], voffB[2];
#pragma unroll
    for (int i = 0; i < 2; ++i) { int R, C; stage_rc(tid * 16 + i * 8192, R, C); const int Rb = Epi::PERM ? ((R & ~31) + perm32(R & 31)) : R;
        RA[i] = R; colA[i] = (unsigned)C * 2u; voffB[i] = (unsigned)(Rb * K + C) * 2u; }
    const size_t kstep = (size_t)(BK * 2);
    const size_t hstep = (size_t)HALF * K * 2;
    const size_t tstep = 2 * hstep;
    const unsigned ldsw = (unsigned)wid * 1024u;
    const int aoff = lds_byte(wr * 64 + fr, fq * 8), boff = lds_byte(wc * 32 + fr, fq * 8);
#define PG8_AOFF(u, off) do { _Pragma("unroll") for (int _h = 0; _h < 2; ++_h) _Pragma("unroll") for (int _i = 0; _i < 2; ++_i) { \
        int _row = (u).pm * BM + _h * HALF + RA[_i]; if (GATHER) { const int _pos = (u).gp0 + _h * HALF + RA[_i]; _row = _pos < (u).gcnt ? g.rowmap[(u).ge * NTOK + _pos] : 0; } \
        (off)[_h][_i] = (unsigned)_row * (unsigned)(K * 2) + colA[_i]; } } while (0)
#define PG8_SA(b, h) (((b) * 2 + (h)) * HTB)
#define PG8_SB(b, h) ((4 + (b) * 2 + (h)) * HTB)
#define PG8_STAGE(bufoff, gbase, voff) do { _Pragma("unroll") for (int _i = 0; _i < 2; ++_i) \
        __builtin_amdgcn_global_load_lds((const unsigned*)((const char*)(gbase) + (voff)[_i]), (PG8_LAS unsigned*)(lds + (bufoff) + ldsw + _i * 8192), 16, 0, 0); } while (0)
#define PG8_LDA(dst, b, h) do { _Pragma("unroll") for (int m = 0; m < 4; ++m) _Pragma("unroll") for (int k = 0; k < 2; ++k) dst[m][k] = *(const PG8_LAS bf16x8*)(lds + PG8_SA(b, h) + aoff + m * 2048 + k * 1024); } while (0)
#define PG8_LDB(dst, b, h) do { _Pragma("unroll") for (int n = 0; n < 2; ++n) _Pragma("unroll") for (int k = 0; k < 2; ++k) dst[n][k] = *(const PG8_LAS bf16x8*)(lds + PG8_SB(b, h) + boff + n * 2048 + k * 1024); } while (0)
#define PG8_MMA(ai, bj, At, Bt) do { __builtin_amdgcn_s_setprio(1); _Pragma("unroll") for (int m = 0; m < 4; ++m) _Pragma("unroll") for (int n = 0; n < 2; ++n) _Pragma("unroll") for (int k = 0; k < 2; ++k) \
        acc[ai][bj][m][n] = __builtin_amdgcn_mfma_f32_16x16x32_bf16(Bt[n][k], At[m][k], acc[ai][bj][m][n], 0, 0, 0); __builtin_amdgcn_s_setprio(0); } while (0)
#define PG8_WAIT_V(n) asm volatile("s_waitcnt vmcnt(" #n ")" ::: "memory")
#define PG8_WAIT_L(n) asm volatile("s_waitcnt lgkmcnt(" #n ")" ::: "memory")
#define PG8_BAR __builtin_amdgcn_s_barrier()
#define PG8_SCHED __builtin_amdgcn_sched_barrier(0)
    Unit cur, nxt; int ui = 0;
    if (!S.next(0, cur)) return;
    f32x4 acc[2][2][4][2];
#pragma unroll
    for (int a = 0; a < 2; ++a)
#pragma unroll
        for (int b = 0; b < 2; ++b)
#pragma unroll
            for (int m = 0; m < 4; ++m)
#pragma unroll
                for (int n = 0; n < 2; ++n) acc[a][b][m][n] = (f32x4){0.f, 0.f, 0.f, 0.f};
    bf16x8 At[4][2], B0[2][2], B1[2][2];
    const char* Ab = (const char*)g.A;
    unsigned offc[2][2], offn[2][2];
    PG8_AOFF(cur, offc);
    const char* cB = (const char*)g.Bt + (size_t)cur.pb * tstep;
    PG8_STAGE(PG8_SB(0, 0), cB, voffB); PG8_STAGE(PG8_SB(0, 1), cB + hstep, voffB); PG8_STAGE(PG8_SA(0, 0), Ab, offc[0]); PG8_STAGE(PG8_SA(0, 1), Ab, offc[1]);
    if (wr == 1) PG8_BAR;
    PG8_WAIT_V(2); PG8_BAR;
    PG8_STAGE(PG8_SB(1, 0), cB + kstep, voffB); PG8_STAGE(PG8_SA(1, 0), Ab + kstep, offc[0]); PG8_STAGE(PG8_SB(1, 1), cB + hstep + kstep, voffB);
    PG8_WAIT_V(6); PG8_BAR;
    for (;;) {
        const bool has_next = S.next(ui + 1, nxt);
        if (has_next) { PG8_AOFF(nxt, offn); }
        else {
#pragma unroll
            for (int h = 0; h < 2; ++h)
#pragma unroll
                for (int i = 0; i < 2; ++i) offn[h][i] = offc[h][i];
        }
        const char* nB = has_next ? (const char*)g.Bt + (size_t)nxt.pb * tstep : cB;
        for (int t = 0; t < nt; t += 2) {
            const bool last = (t == nt - 2);
            const char* a1 = Ab + (size_t)(t + 1) * kstep;
            const char* a2 = Ab + (last ? (size_t)0 : (size_t)(t + 2) * kstep); const char* b2 = last ? nB : cB + (size_t)(t + 2) * kstep;
            const char* a3 = a2 + kstep; const char* b3 = b2 + kstep;
            unsigned o2[2][2];
#pragma unroll
            for (int h = 0; h < 2; ++h)
#pragma unroll
                for (int i = 0; i < 2; ++i) o2[h][i] = last ? offn[h][i] : offc[h][i];
            PG8_LDB(B0, 0, 0); PG8_LDB(B1, 0, 1); PG8_SCHED; PG8_LDA(At, 0, 0); PG8_STAGE(PG8_SA(1, 1), a1, offc[1]);
            PG8_WAIT_V(8); PG8_WAIT_L(0); PG8_BAR; PG8_MMA(0, 0, At, B0); PG8_MMA(0, 1, At, B1); PG8_BAR; PG8_SCHED;
            PG8_LDA(At, 0, 1); PG8_STAGE(PG8_SB(0, 0), b2, voffB); PG8_STAGE(PG8_SB(0, 1), b2 + hstep, voffB); PG8_STAGE(PG8_SA(0, 0), a2, o2[0]);
            PG8_WAIT_V(8); PG8_WAIT_L(0); PG8_BAR; PG8_MMA(1, 0, At, B0); PG8_MMA(1, 1, At, B1); PG8_BAR; PG8_SCHED;
            PG8_LDB(B0, 1, 0); PG8_LDB(B1, 1, 1); PG8_SCHED; PG8_LDA(At, 1, 0); PG8_STAGE(PG8_SA(0, 1), a2, o2[1]);
            PG8_WAIT_V(8); PG8_WAIT_L(0); PG8_BAR; PG8_MMA(0, 0, At, B0); PG8_MMA(0, 1, At, B1); PG8_BAR; PG8_SCHED;
            PG8_LDA(At, 1, 1); PG8_STAGE(PG8_SB(1, 0), b3, voffB); PG8_STAGE(PG8_SB(1, 1), b3 + hstep, voffB); PG8_STAGE(PG8_SA(1, 0), a3, o2[0]);
            PG8_WAIT_V(8); PG8_WAIT_L(0); PG8_BAR; PG8_MMA(1, 0, At, B0); PG8_MMA(1, 1, At, B1); PG8_BAR; PG8_SCHED;
        }
        if (wr == 0) PG8_BAR;
        E(acc, cur, wr, wc, fr, fq);
        if (!has_next) break;
#pragma unroll
        for (int a = 0; a < 2; ++a)
#pragma unroll
            for (int b = 0; b < 2; ++b)
#pragma unroll
                for (int m = 0; m < 4; ++m)
#pragma unroll
                    for (int n = 0; n < 2; ++n) acc[a][b][m][n] = (f32x4){0.f, 0.f, 0.f, 0.f};
        cur = nxt; cB = nB; ++ui;
#pragma unroll
        for (int h = 0; h < 2; ++h)
#pragma unroll
            for (int i = 0; i < 2; ++i) offc[h][i] = offn[h][i];
        if (wr == 1) PG8_BAR;
    }
    PG8_WAIT_V(0);
    PG8_BAR;
#undef PG8_AOFF
#undef PG8_SA
#undef PG8_SB
#undef PG8_STAGE
#undef PG8_LDA
#undef PG8_LDB
#undef PG8_MMA
#undef PG8_WAIT_V
#undef PG8_WAIT_L
#undef PG8_BAR
#undef PG8_SCHED
}
}


struct Params { const float* in[28]; float* out; unsigned char* ws; };
enum { I_X = 0, I_C, I_CTX, I_CCTX, I_WMOD, I_BMOD, I_WIN, I_LQ1, I_LK1, I_LQ2, I_LK2, I_SUBG, I_SGLNG, I_SGLNB, I_SGW, I_SGB, I_WOUT, I_LN1G, I_LN1B,
       I_RGW, I_RGB, I_REW, I_REB, I_EWG, I_EWU, I_EWD, I_LN2G, I_LN2B };

DEV void phase_prep(const Params& p) {
    const int tidx = opaque_tid();
    float* rope = (float*)(p.ws + OFF_ROPE);
    for (int t = tidx; t < 1024; t += blockDim.x) {
        const int pos = t >> 4, j = t & 15;
        const float inv = powf(10000.0f, -(float)j / 16.0f);
        const float ang = (float)pos * inv;
        rope[2 * t] = cosf(ang); rope[2 * t + 1] = sinf(ang);
    }
    if (tidx < 64) {
        const int l = tidx;
        const float a = wave_sum(p.in[I_LQ1][l] * p.in[I_LK1][l]), b = wave_sum(p.in[I_LQ2][l] * p.in[I_LK2][l]);
        if (l == 0) *(float*)(p.ws + OFF_LAM) = expf(a) - expf(b) + LAM_INIT;
    }
}
DEV void phase_mod(const Params& p, unsigned char* lds) {
    const int tidx = opaque_tid();
    if ((int)blockIdx.x >= 192) return;
    float* sv = (float*)lds; float* red = sv + 17 * 1024;
    const float* c = p.in[I_C]; const float* c_ctx = p.in[I_CCTX]; const float* w_mod = p.in[I_WMOD]; const float* b_mod = p.in[I_BMOD];
    if (blockDim.x == 512) {
        float cv[34];
#pragma unroll
        for (int j = 0; j < 34; ++j) { const int i = tidx + 512 * j; cv[j] = i < 16384 ? c[i] : c_ctx[i - 16384]; }
#pragma unroll
        for (int j = 0; j < 34; ++j) sv[tidx + 512 * j] = silu_f(cv[j]);
    } else
        for (int i = tidx; i < 17 * 1024; i += blockDim.x) { const float v = i < 16384 ? c[i] : c_ctx[i - 16384]; sv[i] = silu_f(v); }
    __syncthreads();
    float* mod = (float*)(p.ws + OFF_MOD);
    const int col = tidx & 31, kg = tidx >> 5, nkg = blockDim.x >> 5, dper = 1024 / nkg;
    for (int u = blockIdx.x; u < 192; u += gridDim.x) {
        const int e = u * 32 + col;
        float acc[17];
#pragma unroll
        for (int r = 0; r < 17; ++r) acc[r] = 0.f;
        for (int d0 = kg * dper; d0 < (kg + 1) * dper; d0 += 16) {
            float w[16];
#pragma unroll
            for (int j = 0; j < 16; ++j) w[j] = w_mod[(size_t)(d0 + j) * 6144 + e];
#pragma unroll
            for (int j = 0; j < 16; ++j)
#pragma unroll
                for (int r = 0; r < 17; ++r) acc[r] += sv[r * 1024 + d0 + j] * w[j];
        }
#pragma unroll
        for (int r = 0; r < 17; ++r) red[(kg * 17 + r) * 32 + col] = acc[r];
        __syncthreads();
        for (int i = tidx; i < 17 * 32; i += blockDim.x) {
            const int r = i >> 5, cc = i & 31; float s = 0.f;
            for (int g = 0; g < nkg; ++g) s += red[(g * 17 + r) * 32 + cc];
            mod[r * 6144 + u * 32 + cc] = s + b_mod[u * 32 + cc];
        }
        __syncthreads();
    }
}
DEV void conv_item(const float* W, int N, bf16_t* WT, int rbase, int rstride, LAS float* scr, int item, int lane) {
    const int nblk = N / 32, kb = item / nblk, nb = item % nblk, k0 = 64 * kb, n0 = 32 * nb;
#pragma unroll 8
    for (int i = 0; i < 32; ++i) { const int kk = 2 * i + (lane >> 5); scr[kk * 33 + (lane & 31)] = W[(size_t)(k0 + kk) * N + n0 + (lane & 31)]; }
    asm volatile("s_waitcnt lgkmcnt(0)" ::: "memory");
    const int c = lane & 7;
    const int r0 = rbase + (n0 >> 7) * rstride + (n0 & 127);
#pragma unroll
    for (int j = 0; j < 4; ++j) { const int n = (lane >> 3) + 8 * j; const LAS float* s = scr + (8 * c) * 33 + n;
        pg8::u32x4 o; o.x = pack2(s[0 * 33], s[1 * 33]); o.y = pack2(s[2 * 33], s[3 * 33]); o.z = pack2(s[4 * 33], s[5 * 33]); o.w = pack2(s[6 * 33], s[7 * 33]);
        *(pg8::u32x4*)(WT + (size_t)(r0 + n) * 1024 + k0 + 8 * c) = o; }
    asm volatile("s_waitcnt lgkmcnt(0)" ::: "memory");
}
DEV void phase_conv(const Params& p, LAS unsigned char* lds) {
    const int tidx = opaque_tid();
    const int tid = opaque_tid(), wave = __builtin_amdgcn_readfirstlane(tid >> 6), lane = tid & 63, nwv = blockDim.x >> 6;
    LAS float* scr = (LAS float*)(lds + wave * 8448);
    unsigned char* ws = p.ws;
    bf16_t* WinT = (bf16_t*)(ws + OFF_WIN); bf16_t* WoutT = (bf16_t*)(ws + OFF_WOUT); bf16_t* SgW = (bf16_t*)(ws + OFF_SGW);
    bf16_t* WguT = (bf16_t*)(ws + OFF_WGU); bf16_t* WdT = (bf16_t*)(ws + OFF_WD);
    constexpr int I_IN = 16 * 80, I_OUT = 16 * 32, I_E = 16 * 32;
    constexpr int TOT = I_IN + I_OUT + 3 * NE * I_E;
    const int gw = blockIdx.x * nwv + wave, NGW = gridDim.x * nwv;
    for (int it = gw; it < TOT; it += NGW) {
        int v = it;
        if (v < I_IN) { conv_item(p.in[I_WIN], 2560, WinT, 0, 128, scr, v, lane); continue; }
        v -= I_IN;
        if (v < I_OUT) { conv_item(p.in[I_WOUT], 1024, WoutT, 0, 128, scr, v, lane); continue; }
        v -= I_OUT;
        const int which = v / (NE * I_E), w = v % (NE * I_E), e = w / I_E, item = w % I_E;
        if (which == 0) conv_item(p.in[I_EWG] + (size_t)e * 1048576, 1024, WguT + (size_t)e * 2048 * 1024, 0, 256, scr, item, lane);
        else if (which == 1) conv_item(p.in[I_EWU] + (size_t)e * 1048576, 1024, WguT + (size_t)e * 2048 * 1024, 128, 256, scr, item, lane);
        else conv_item(p.in[I_EWD] + (size_t)e * 1048576, 1024, WdT + (size_t)e * 1024 * 1024, 0, 128, scr, item, lane);
    }
    const float* sg_w = p.in[I_SGW];
    for (int i = blockIdx.x * blockDim.x + tidx; i < 65536 / 8; i += gridDim.x * blockDim.x) {
        const int g = i >> 11, pr = (i >> 4) & 127, q0 = (i & 15) * 8;
        const float4 v0 = *(const float4*)(sg_w + (size_t)(g * 128 + pr) * 128 + q0), v1 = *(const float4*)(sg_w + (size_t)(g * 128 + pr) * 128 + q0 + 4);
        uint4 o; o.x = pack2(v0.x, v0.y); o.y = pack2(v0.z, v0.w); o.z = pack2(v1.x, v1.y); o.w = pack2(v1.z, v1.w);
        const int ks = q0 >> 4, h2 = (q0 >> 3) & 1, lane = h2 * 32 + (pr & 31);
        *(uint4*)(SgW + ((size_t)(((g * 4 + (pr >> 5)) * 8 + ks) * 64 + lane)) * 8) = o;
    }
}
DEV void unpack8(const uint4& r, float (&v)[8]) {
    v[0] = bf2f((bf16_t)(r.x & 0xffff)); v[1] = bf2f((bf16_t)(r.x >> 16)); v[2] = bf2f((bf16_t)(r.y & 0xffff)); v[3] = bf2f((bf16_t)(r.y >> 16));
    v[4] = bf2f((bf16_t)(r.z & 0xffff)); v[5] = bf2f((bf16_t)(r.z >> 16)); v[6] = bf2f((bf16_t)(r.w & 0xffff)); v[7] = bf2f((bf16_t)(r.w >> 16));
}
DEV void modulate_rows(const float* src, bf16_t* dst, const float* m, int row_lo, int nrows, int wid, int lane, int nw) {
    float sh[2][8], sc[2][8];
#pragma unroll
    for (int i = 0; i < 2; ++i)
#pragma unroll
        for (int j = 0; j < 8; ++j) { sh[i][j] = m[8 * lane + 512 * i + j]; sc[i][j] = 1.0f + m[1024 + 8 * lane + 512 * i + j]; }
    for (int r = wid; r < nrows; r += 2 * nw) {
        float4 a[2][2][2]; bool ok[2];
#pragma unroll
        for (int u = 0; u < 2; ++u) { const int rr = r + u * nw; ok[u] = rr < nrows; const float* s = src + (size_t)(row_lo + (ok[u] ? rr : r)) * D + 8 * lane;
#pragma unroll
            for (int i = 0; i < 2; ++i) { a[u][i][0] = *(const float4*)(s + 512 * i); a[u][i][1] = *(const float4*)(s + 512 * i + 4); } }
#pragma unroll
        for (int u = 0; u < 2; ++u) if (ok[u]) { bf16_t* d = dst + (size_t)(row_lo + r + u * nw) * D + 8 * lane;
#pragma unroll
            for (int i = 0; i < 2; ++i) { const float4 x0 = a[u][i][0], x1 = a[u][i][1]; uint4 o;
                o.x = pack2(x0.x * sc[i][0] + sh[i][0], x0.y * sc[i][1] + sh[i][1]); o.y = pack2(x0.z * sc[i][2] + sh[i][2], x0.w * sc[i][3] + sh[i][3]);
                o.z = pack2(x1.x * sc[i][4] + sh[i][4], x1.y * sc[i][5] + sh[i][5]); o.w = pack2(x1.z * sc[i][6] + sh[i][6], x1.w * sc[i][7] + sh[i][7]);
                *(uint4*)(d + 512 * i) = o; } }
    }
}
DEV void phase_modulate_ctx(const Params& p) {
    const int tidx = opaque_tid(), wid = tidx >> 6, lane = tidx & 63, nw = blockDim.x >> 6;
    const float* mod = (const float*)(p.ws + OFF_MOD); bf16_t* hc = (bf16_t*)(p.ws + OFF_A + 128 * MiB);
    for (int panel = blockIdx.x; panel < NCTX / 16; panel += gridDim.x) modulate_rows(p.in[I_CTX], hc, mod + 16 * 6144, panel * 16, 16, wid, lane, nw);
}
DEV void phase_modulate_x(const Params& p, LAS unsigned char* lds) {
    const int tidx = opaque_tid(), lane = tidx & 63;
    const float* mod = (const float*)(p.ws + OFF_MOD); const float* src = p.in[I_X];
    bf16_t* h = (bf16_t*)(p.ws + OFF_A);
    LAS unsigned* ticket = (LAS unsigned*)(lds + MISC_OFF + 72);
    const int G = (int)gridDim.x, skip = G > 64 ? 64 : 0, nwork = G - skip, widx = (int)blockIdx.x - skip;
    if (widx < 0) return;
    const int quad_lo = (int)(((long)widx * (NTOK / 4)) / nwork), quad_hi = (int)(((long)(widx + 1) * (NTOK / 4)) / nwork);
    int curb = -1;
    float sh[2][8], sc[2][8];
    for (;;) {
        unsigned tk = 0; if (lane == 0) tk = __hip_atomic_fetch_add(ticket, 1u, __ATOMIC_RELAXED, __HIP_MEMORY_SCOPE_WORKGROUP);
        const int t = __builtin_amdgcn_readfirstlane((int)tk);
        if (t >= quad_hi - quad_lo) break;
        const int row = 4 * (quad_lo + t), b = row / L;
        float4 a[4][2][2];
#pragma unroll
        for (int u = 0; u < 4; ++u) { const float* s = src + (size_t)(row + u) * D + 8 * lane;
#pragma unroll
            for (int i = 0; i < 2; ++i) { a[u][i][0] = *(const float4*)(s + 512 * i); a[u][i][1] = *(const float4*)(s + 512 * i + 4); } }
        if (b != curb) { curb = b; const float* m = mod + b * 6144;
#pragma unroll
            for (int i = 0; i < 2; ++i)
#pragma unroll
                for (int j = 0; j < 8; ++j) { sh[i][j] = m[8 * lane + 512 * i + j]; sc[i][j] = 1.0f + m[1024 + 8 * lane + 512 * i + j]; } }
#pragma unroll
        for (int u = 0; u < 4; ++u) { bf16_t* d = h + (size_t)(row + u) * D + 8 * lane;
#pragma unroll
            for (int i = 0; i < 2; ++i) { const float4 x0 = a[u][i][0], x1 = a[u][i][1]; uint4 o;
                o.x = pack2(x0.x * sc[i][0] + sh[i][0], x0.y * sc[i][1] + sh[i][1]); o.y = pack2(x0.z * sc[i][2] + sh[i][2], x0.w * sc[i][3] + sh[i][3]);
                o.z = pack2(x1.x * sc[i][4] + sh[i][4], x1.y * sc[i][5] + sh[i][5]); o.w = pack2(x1.z * sc[i][6] + sh[i][6], x1.w * sc[i][7] + sh[i][7]);
                *(uint4*)(d + 512 * i) = o; } }
    }
}
DEV int moe_early_tiles(int Mt, int G) {
    const int R = (8 * Mt) % G, Rd = (4 * Mt) % G;
    return (R > 0 && Rd > 0 && Rd <= G - R && (Rd & 3) == 0 && Rd <= 4 * 128 && Rd <= 4 * Mt) ? Rd / 4 : 0;
}
DEV void moe_tables(const Params& p, LAS unsigned char* lds) {
    const int tidx = opaque_tid();
    if (tidx < 64) {
        const unsigned* cnt = (const unsigned*)(p.ws + OFF_CTL) + CW_CNT;
        LAS int* tile_e = (LAS int*)(lds + MOE_TE); LAS int* tile_p0 = (LAS int*)(lds + MOE_TP); LAS int* base = (LAS int*)(lds + MOE_BASE);
        const int e = tidx & 31, nt = tidx < 32 ? (int)((cnt[e * CNT_STRIDE] + 255u) >> 8) : 0;
        int incl = nt;
        for (int o = 1; o < 32; o <<= 1) { const int v = __shfl_up(incl, o); if ((tidx & 63) >= o) incl += v; }
        if (tidx < 32) {
            const int t0 = incl - nt;
            base[e] = t0 * 256;
            for (int i = 0; i < nt; ++i) { tile_e[t0 + i] = e; tile_p0[t0 + i] = i * 256; }
            if (tidx == 31) tile_e[MAXT] = incl;
        }
    }
    asm volatile("s_waitcnt lgkmcnt(0)" ::: "memory"); __syncthreads();
}
DEV void phase_final(const Params& p, LAS unsigned char* lds) {
    const int tidx = opaque_tid(), wid = __builtin_amdgcn_readfirstlane(tidx >> 6), lane = tidx & 63, nw = blockDim.x >> 6;
    float* out = p.out; unsigned char* ws = p.ws;
    const float* mod = (const float*)(ws + OFF_MOD); const bf16_t* y2 = (const bf16_t*)(ws + OFF_Y2); const bf16_t* x1b = (const bf16_t*)(ws + OFF_B);
    const int* tok_e = (const int*)(ws + OFF_TOKE); const int* tok_p = (const int*)(ws + OFF_TOKP); const float* tok_w = (const float*)(ws + OFF_TOKW);
    const LAS int* base = (const LAS int*)(lds + MOE_BASE);
    const bf16_t* y2e = (const bf16_t*)(ws + OFF_Y2E); const int early_rows = 256 * moe_early_tiles(((const LAS int*)(lds + MOE_TE))[MAXT], (int)gridDim.x);
    float lg[2][8], lb[2][8];
#pragma unroll
    for (int i = 0; i < 2; ++i)
#pragma unroll
        for (int j = 0; j < 8; ++j) { lg[i][j] = p.in[I_LN2G][8 * lane + 512 * i + j]; lb[i][j] = p.in[I_LN2B][8 * lane + 512 * i + j]; }
    for (int panel = blockIdx.x; panel < NTOK / 128; panel += gridDim.x) {
        const float* m = mod + (panel * 128 / L) * 6144 + 5120;
        float g2[2][8];
#pragma unroll
        for (int i = 0; i < 2; ++i)
#pragma unroll
            for (int j = 0; j < 8; ++j) g2[i][j] = m[8 * lane + 512 * i + j];
        for (int r = wid; r < 128; r += 2 * nw) {
            float v[2][16]; float mu[2], rstd[2];
#pragma unroll
            for (int u = 0; u < 2; ++u) {
                const int row = panel * 128 + r + u * nw;
                const int s0 = base[tok_e[row * 2]] + tok_p[row * 2], s1 = base[tok_e[row * 2 + 1]] + tok_p[row * 2 + 1]; const float w0 = tok_w[row * 2], w1 = tok_w[row * 2 + 1];
                float s = 0.f;
#pragma unroll
                for (int i = 0; i < 2; ++i) {
                    const int c = 8 * lane + 512 * i;
                    float xa[8], ya[8], yb[8];
                    unpack8(*(const uint4*)(x1b + (size_t)row * D + c), xa); unpack8(*(const uint4*)((s0 < early_rows ? y2e : y2) + (size_t)s0 * D + c), ya); unpack8(*(const uint4*)((s1 < early_rows ? y2e : y2) + (size_t)s1 * D + c), yb);
#pragma unroll
                    for (int j = 0; j < 8; ++j) { const float val = ALPHA * xa[j] + g2[i][j] * (w0 * ya[j] + w1 * yb[j]); v[u][8 * i + j] = val; s += val; }
                }
                mu[u] = s;
            }
#pragma unroll
            for (int u = 0; u < 2; ++u) {
                mu[u] = wave_sum(mu[u]) * (1.0f / 1024.0f);
                float q = 0.f;
#pragma unroll
                for (int j = 0; j < 16; ++j) { const float d = v[u][j] - mu[u]; q += d * d; }
                rstd[u] = rsqrtf(wave_sum(q) * (1.0f / 1024.0f) + EPS);
            }
#pragma unroll
            for (int u = 0; u < 2; ++u) {
                float* orow = out + (size_t)(panel * 128 + r + u * nw) * D + 8 * lane;
#pragma unroll
                for (int i = 0; i < 2; ++i) {
                    float4 o0, o1;
                    o0.x = (v[u][8 * i + 0] - mu[u]) * rstd[u] * lg[i][0] + lb[i][0]; o0.y = (v[u][8 * i + 1] - mu[u]) * rstd[u] * lg[i][1] + lb[i][1];
                    o0.z = (v[u][8 * i + 2] - mu[u]) * rstd[u] * lg[i][2] + lb[i][2]; o0.w = (v[u][8 * i + 3] - mu[u]) * rstd[u] * lg[i][3] + lb[i][3];
                    o1.x = (v[u][8 * i + 4] - mu[u]) * rstd[u] * lg[i][4] + lb[i][4]; o1.y = (v[u][8 * i + 5] - mu[u]) * rstd[u] * lg[i][5] + lb[i][5];
                    o1.z = (v[u][8 * i + 6] - mu[u]) * rstd[u] * lg[i][6] + lb[i][6]; o1.w = (v[u][8 * i + 7] - mu[u]) * rstd[u] * lg[i][7] + lb[i][7];
                    *(float4*)(orow + 512 * i) = o0; *(float4*)(orow + 512 * i + 4) = o1;
                }
            }
        }
    }
}

namespace att {
typedef short s16x8 __attribute__((ext_vector_type(8)));
typedef short s16x4 __attribute__((ext_vector_type(4)));
typedef float f32x16 __attribute__((ext_vector_type(16)));
typedef float f32x4 __attribute__((ext_vector_type(4)));
typedef unsigned u32x2 __attribute__((ext_vector_type(2)));
constexpr int KBUF = 16384, VOFF = 49152, VBUF = 16384, NUNITS = B * 4 * (L / 128), NT = KEYS / 64;
constexpr float THR = 60.0f;
typedef float f32x2 __attribute__((ext_vector_type(2)));
typedef __bf16 bf16x2 __attribute__((ext_vector_type(2)));
DEV unsigned cvtpk(float lo, float hi) { const f32x2 v = {lo, hi}; return __builtin_bit_cast(unsigned, __builtin_convertvector(v, bf16x2)); }
DEV s16x8 pack8(const f32x16& v, int o) {
    union { unsigned u[4]; s16x8 s; } x;
    x.u[0] = cvtpk(v[o + 0], v[o + 1]); x.u[1] = cvtpk(v[o + 2], v[o + 3]); x.u[2] = cvtpk(v[o + 4], v[o + 5]); x.u[3] = cvtpk(v[o + 6], v[o + 7]);
    return x.s;
}
template <int OFF> DEV void tr_rd(s16x4& r, unsigned addr) { asm volatile("ds_read_b64_tr_b16 %0, %1 offset:%2" : "=&v"(r) : "v"(addr), "i"(OFF)); }
struct Ctx {
    const bf16_t* k1; const bf16_t* k2; const bf16_t* v;
    unsigned ksrc, vsrc0, vsrc1;
    unsigned kaddr[4]; unsigned vaddr[2][4];
    int wid, map;
};
DEV void stageK(const Ctx& c, LAS unsigned char* lds, int t, int kb) {
    const size_t rk = (size_t)t * 64 * 256;
    __builtin_amdgcn_global_load_lds((const unsigned*)(c.k1 + rk + c.ksrc), (LAS unsigned*)(lds + kb * KBUF + c.wid * 1024), 16, 0, 0);
    __builtin_amdgcn_global_load_lds((const unsigned*)(c.k2 + rk + c.ksrc), (LAS unsigned*)(lds + kb * KBUF + 8192 + c.wid * 1024), 16, 0, 0);
}
DEV void stageV(const Ctx& c, LAS unsigned char* lds, int t, int vb) {
    const size_t rv = (size_t)t * 64 * 512;
    __builtin_amdgcn_global_load_lds((const unsigned*)(c.v + rv + c.vsrc0), (LAS unsigned*)(lds + VOFF + vb * VBUF + c.wid * 1024), 16, 0, 0);
    __builtin_amdgcn_global_load_lds((const unsigned*)(c.v + rv + c.vsrc1), (LAS unsigned*)(lds + VOFF + vb * VBUF + 8192 + c.wid * 1024), 16, 0, 0);
}
DEV void qk(const Ctx& c, LAS unsigned char* lds, unsigned kboff, const s16x8 (&qf)[4], f32x16& S0, f32x16& S1) {
    const LAS unsigned char* kb = lds + kboff;
#pragma unroll
    for (int r = 0; r < 16; ++r) { S0[r] = 0.f; S1[r] = 0.f; }
    s16x8 ka[4], kc[4];
#pragma unroll
    for (int s = 0; s < 4; ++s) { ka[s] = *(const LAS s16x8*)(kb + c.kaddr[s]); kc[s] = *(const LAS s16x8*)(kb + 4096 + c.kaddr[s]); }
#pragma unroll
    for (int s = 0; s < 4; ++s) {
        S0 = __builtin_amdgcn_mfma_f32_32x32x16_bf16(ka[s], qf[s], S0, 0, 0, 0);
        S1 = __builtin_amdgcn_mfma_f32_32x32x16_bf16(kc[s], qf[s], S1, 0, 0, 0);
    }
}
DEV int imax3(int a, int b, int c) { return max(max(a, b), c); }
DEV void softmax_pv(const Ctx& c, unsigned vbase, f32x16& S0, f32x16& S1, f32x16 (&O)[4], float& m, float& l, bool first) {
    int i0 = imax3(__float_as_int(S0[0]), __float_as_int(S1[0]), __float_as_int(S0[1])), i1 = imax3(__float_as_int(S0[4]), __float_as_int(S1[4]), __float_as_int(S0[5]));
    int i2 = imax3(__float_as_int(S0[8]), __float_as_int(S1[8]), __float_as_int(S0[9])), i3 = imax3(__float_as_int(S0[12]), __float_as_int(S1[12]), __float_as_int(S0[13]));
    i0 = imax3(i0, __float_as_int(S1[1]), __float_as_int(S0[2])); i1 = imax3(i1, __float_as_int(S1[5]), __float_as_int(S0[6])); i2 = imax3(i2, __float_as_int(S1[9]), __float_as_int(S0[10])); i3 = imax3(i3, __float_as_int(S1[13]), __float_as_int(S0[14]));
    i0 = imax3(i0, __float_as_int(S1[2]), __float_as_int(S0[3])); i1 = imax3(i1, __float_as_int(S1[6]), __float_as_int(S0[7])); i2 = imax3(i2, __float_as_int(S1[10]), __float_as_int(S0[11])); i3 = imax3(i3, __float_as_int(S1[14]), __float_as_int(S0[15]));
    i0 = imax3(i0, __float_as_int(S1[3]), i1); i2 = imax3(i2, __float_as_int(S1[7]), i3);
    const int im = imax3(i0, i2, max(__float_as_int(S1[11]), __float_as_int(S1[15])));
    const bool simple = !first && !__any((im > __float_as_int(THR)) || (m != 0.f));
    if (!simple) {
        const float mref = first ? 0.f : m;
#pragma unroll
        for (int r = 0; r < 16; ++r) { S0[r] -= mref; S1[r] -= mref; }
        float t0 = fmaxf(fmaxf(S0[0], S1[0]), S0[1]), t1 = fmaxf(fmaxf(S0[4], S1[4]), S0[5]), t2 = fmaxf(fmaxf(S0[8], S1[8]), S0[9]), t3 = fmaxf(fmaxf(S0[12], S1[12]), S0[13]);
        t0 = fmaxf(fmaxf(t0, S1[1]), S0[2]); t1 = fmaxf(fmaxf(t1, S1[5]), S0[6]); t2 = fmaxf(fmaxf(t2, S1[9]), S0[10]); t3 = fmaxf(fmaxf(t3, S1[13]), S0[14]);
        t0 = fmaxf(fmaxf(t0, S1[2]), S0[3]); t1 = fmaxf(fmaxf(t1, S1[6]), S0[7]); t2 = fmaxf(fmaxf(t2, S1[10]), S0[11]); t3 = fmaxf(fmaxf(t3, S1[14]), S0[15]);
        t0 = fmaxf(fmaxf(t0, S1[3]), t1); t2 = fmaxf(fmaxf(t2, S1[7]), t3);
        float tm = fmaxf(fmaxf(t0, t2), fmaxf(S1[11], S1[15]));
        { const auto rr = __builtin_amdgcn_permlane32_swap(__float_as_uint(tm), __float_as_uint(tm), false, false);
          tm = fmaxf(__uint_as_float(rr[0]), __uint_as_float(rr[1])); }
        const float d = first ? ((fabsf(tm) > THR) ? tm : 0.f) : ((tm > THR) ? tm : 0.f);
        if (__any(d != 0.f)) {
            const float al = first ? 1.0f : __builtin_amdgcn_exp2f(-d);
            l *= al;
#pragma unroll
            for (int eb = 0; eb < 4; ++eb)
#pragma unroll
                for (int r = 0; r < 16; ++r) O[eb][r] *= al;
#pragma unroll
            for (int r = 0; r < 16; ++r) { S0[r] -= d; S1[r] -= d; }
        }
        m = mref + d;
    }
#pragma unroll
    for (int r = 0; r < 16; ++r) { S0[r] = __builtin_amdgcn_exp2f(S0[r]); S1[r] = __builtin_amdgcn_exp2f(S1[r]); }
    float ls0 = S0[0], ls1 = S0[8], ls2 = S1[0], ls3 = S1[8];
#pragma unroll
    for (int r = 1; r < 8; ++r) { ls0 += S0[r]; ls1 += S0[r + 8]; ls2 += S1[r]; ls3 += S1[r + 8]; }
    l += (ls0 + ls1) + (ls2 + ls3);
    s16x8 pf[4];
    pf[0] = pack8(S0, 0); pf[1] = pack8(S0, 8); pf[2] = pack8(S1, 0); pf[3] = pack8(S1, 8);
    unsigned va[2][4];
#pragma unroll
    for (int t = 0; t < 2; ++t)
#pragma unroll
        for (int eb = 0; eb < 4; ++eb) va[t][eb] = vbase + c.vaddr[t][eb];
    s16x4 g0[2][4][2], g1[2][4][2];
#pragma unroll
    for (int eb = 0; eb < 4; ++eb) { tr_rd<0>(g0[0][eb][0], va[0][eb]); tr_rd<0>(g0[0][eb][1], va[1][eb]); tr_rd<4096>(g0[1][eb][0], va[0][eb]); tr_rd<4096>(g0[1][eb][1], va[1][eb]); }
    asm volatile("s_waitcnt lgkmcnt(0)"
                 : "+v"(g0[0][0][0]), "+v"(g0[0][0][1]), "+v"(g0[0][1][0]), "+v"(g0[0][1][1]), "+v"(g0[0][2][0]), "+v"(g0[0][2][1]), "+v"(g0[0][3][0]), "+v"(g0[0][3][1]),
                   "+v"(g0[1][0][0]), "+v"(g0[1][0][1]), "+v"(g0[1][1][0]), "+v"(g0[1][1][1]), "+v"(g0[1][2][0]), "+v"(g0[1][2][1]), "+v"(g0[1][3][0]), "+v"(g0[1][3][1]));
#pragma unroll
    for (int eb = 0; eb < 4; ++eb) { tr_rd<8192>(g1[0][eb][0], va[0][eb]); tr_rd<8192>(g1[0][eb][1], va[1][eb]); tr_rd<12288>(g1[1][eb][0], va[0][eb]); tr_rd<12288>(g1[1][eb][1], va[1][eb]); }
#pragma unroll
    for (int k2 = 0; k2 < 2; ++k2)
#pragma unroll
        for (int eb = 0; eb < 4; ++eb) {
            const s16x8 vf = __builtin_shufflevector(g0[k2][eb][0], g0[k2][eb][1], 0, 1, 2, 3, 4, 5, 6, 7);
            O[eb] = __builtin_amdgcn_mfma_f32_32x32x16_bf16(vf, pf[k2], O[eb], 0, 0, 0);
        }
    asm volatile("s_waitcnt lgkmcnt(0)"
                 : "+v"(g1[0][0][0]), "+v"(g1[0][0][1]), "+v"(g1[0][1][0]), "+v"(g1[0][1][1]), "+v"(g1[0][2][0]), "+v"(g1[0][2][1]), "+v"(g1[0][3][0]), "+v"(g1[0][3][1]),
                   "+v"(g1[1][0][0]), "+v"(g1[1][0][1]), "+v"(g1[1][1][0]), "+v"(g1[1][1][1]), "+v"(g1[1][2][0]), "+v"(g1[1][2][1]), "+v"(g1[1][3][0]), "+v"(g1[1][3][1]));
#pragma unroll
    for (int k2 = 0; k2 < 2; ++k2)
#pragma unroll
        for (int eb = 0; eb < 4; ++eb) {
            const s16x8 vf = __builtin_shufflevector(g1[k2][eb][0], g1[k2][eb][1], 0, 1, 2, 3, 4, 5, 6, 7);
            O[eb] = __builtin_amdgcn_mfma_f32_32x32x16_bf16(vf, pf[2 + k2], O[eb], 0, 0, 0);
        }
}
#define ATT_BAR() do { asm volatile("s_waitcnt vmcnt(0) lgkmcnt(0)" ::: "memory"); __builtin_amdgcn_s_barrier(); asm volatile("" ::: "memory"); } while (0)
DEV void attn_phase(const Params& p, LAS unsigned char* lds) {
    const int tid = opaque_tid(), wid = __builtin_amdgcn_readfirstlane(tid >> 6), lane = tid & 63;
    const int map = wid >> 2, rg = wid & 3, h2 = lane >> 5, ql = lane & 31;
    unsigned char* ws = p.ws;
    const bf16_t* qbase = (const bf16_t*)(ws + OFF_B) + (size_t)map * NTOK * 256;
    const bf16_t* k1base = (const bf16_t*)(ws + OFF_B + 32 * MiB); const bf16_t* k2base = k1base + (size_t)B * KEYS * 256;
    const bf16_t* vbase = (const bf16_t*)(ws + OFF_B + 68 * MiB);
    bf16_t* mix = (bf16_t*)(ws + OFF_C);
    const float* subg = p.in[I_SUBG];
    const float lam = *(const float*)(ws + OFF_LAM);
    Ctx c; c.wid = wid; c.map = map;
    { const int key = tid >> 3, ch = (tid & 7) ^ ((key >> 1) & 7); c.ksrc = (unsigned)(key * 256 + ch * 8); }
    { const int s0 = tid, k0 = s0 >> 4, c0 = (s0 & 15) ^ (((k0 & 3) << 2) | ((k0 >> 2) & 3)); c.vsrc0 = (unsigned)(k0 * 512 + c0 * 8);
      const int s1 = tid + 512, k1 = s1 >> 4, c1 = (s1 & 15) ^ (((k1 & 3) << 2) | ((k1 >> 2) & 3)); c.vsrc1 = (unsigned)(k1 * 512 + c1 * 8); }
    { const unsigned xk = (unsigned)(ql >> 1) & 7u;
#pragma unroll
      for (int s = 0; s < 4; ++s) c.kaddr[s] = (unsigned)ql * 128u + ((((unsigned)(2 * s + h2)) ^ xk) << 4);
      const unsigned q_ = (unsigned)(lane & 15) >> 2, p_ = (unsigned)lane & 3u, blk = (unsigned)(lane >> 4) & 1u;
#pragma unroll
      for (int t = 0; t < 2; ++t)
#pragma unroll
          for (int eb = 0; eb < 4; ++eb)
              c.vaddr[t][eb] = 256u * (4u * h2 + 8u * t + q_) + 16u * ((((unsigned)eb ^ q_) << 2) | ((2u * blk + (p_ >> 1)) ^ (unsigned)(h2 + 2 * t))) + 8u * (p_ & 1u);
    }
    const int G = gridDim.x, bid = blockIdx.x;
    for (int i = 0;; ++i) {
        int unit;
        if (G == 256) { if (i >= 4) break; const int j = i * 32 + (bid >> 3); unit = ((bid & 7) * 8 + (j >> 4)) * 16 + (j & 15); }
        else { unit = i * G + bid; if (unit >= NUNITS) break; }
        const int bh = unit >> 4, qblk = unit & 15, b = bh >> 2, h = bh & 3;
        c.k1 = k1base + (size_t)b * KEYS * 256 + h * 64; c.k2 = k2base + (size_t)b * KEYS * 256 + h * 64; c.v = vbase + (size_t)b * KEYS * 512 + h * 128;
        const int row = b * L + qblk * 128 + rg * 32 + ql;
        s16x8 qf[4];
        { const bf16_t* qrow = qbase + (size_t)row * 256 + h * 64;
#pragma unroll
          for (int s = 0; s < 4; ++s) qf[s] = *(const s16x8*)(qrow + (2 * s + h2) * 8); }
        f32x16 O[4];
#pragma unroll
        for (int eb = 0; eb < 4; ++eb)
#pragma unroll
            for (int r = 0; r < 16; ++r) O[eb][r] = 0.f;
        float m = 0.f, l = 0.f;
        const unsigned ldsb = (unsigned)(__UINTPTR_TYPE__)lds, kmap = (unsigned)(map * 8192);
        stageK(c, lds, 0, 0); stageV(c, lds, 0, 0); stageK(c, lds, 1, 1);
        ATT_BAR();
        f32x16 Sa0, Sa1, Sb0, Sb1;
        qk(c, lds, kmap, qf, Sa0, Sa1);
        int k1i = 1, k2i = 2;
        for (int t = 0; t < NT; t += 2) {
            if (t + 2 < NT) stageK(c, lds, t + 2, k2i);
            stageV(c, lds, t + 1, 1);
            qk(c, lds, (unsigned)(k1i * KBUF) + kmap, qf, Sb0, Sb1);
            softmax_pv(c, ldsb + (unsigned)VOFF, Sa0, Sa1, O, m, l, t == 0);
            { const int n = (k2i == 2) ? 0 : k2i + 1; k1i = k2i; k2i = n; }
            ATT_BAR();
            if (t + 3 < NT) stageK(c, lds, t + 3, k2i);
            if (t + 2 < NT) { stageV(c, lds, t + 2, 0); qk(c, lds, (unsigned)(k1i * KBUF) + kmap, qf, Sa0, Sa1); }
            softmax_pv(c, ldsb + (unsigned)(VOFF + VBUF), Sb0, Sb1, O, m, l, false);
            { const int n = (k2i == 2) ? 0 : k2i + 1; k1i = k2i; k2i = n; }
            ATT_BAR();
        }
        float lt; { const auto rr = __builtin_amdgcn_permlane32_swap(__float_as_uint(l), __float_as_uint(l), false, false); lt = __uint_as_float(rr[0]) + __uint_as_float(rr[1]); }
        LAS float* xch = (LAS float*)(lds + rg * 16384);
        if (map == 1) {
            const float sc = -lam / lt;
#pragma unroll
            for (int eb = 0; eb < 4; ++eb)
#pragma unroll
                for (int r = 0; r < 16; ++r) xch[(eb * 32 + (r & 3) + 8 * (r >> 2) + 4 * h2) * 32 + ql] = O[eb][r] * sc;
        }
        asm volatile("s_waitcnt lgkmcnt(0)" ::: "memory"); __builtin_amdgcn_s_barrier(); asm volatile("" ::: "memory");
        if (map == 0) {
            const float sc = 1.0f / lt;
            float ss = 0.f;
#pragma unroll
            for (int eb = 0; eb < 4; ++eb)
#pragma unroll
                for (int r = 0; r < 16; ++r) { const float o = O[eb][r] * sc + xch[(eb * 32 + (r & 3) + 8 * (r >> 2) + 4 * h2) * 32 + ql]; O[eb][r] = o; ss += o * o; }
            ss += __shfl_xor(ss, 32);
            const float rn = rsqrtf(ss * (1.0f / 128.0f) + EPS) * (1.0f - LAM_INIT);
            bf16_t* orow = mix + (size_t)row * 1024 + h * 128;
#pragma unroll
            for (int eb = 0; eb < 4; ++eb)
#pragma unroll
                for (int g4 = 0; g4 < 4; ++g4) {
                    const int e0 = eb * 32 + 8 * g4 + 4 * h2;
                    const f32x4 gg = *(const f32x4*)(subg + e0);
                    u32x2 w; w.x = cvtpk(O[eb][4 * g4 + 0] * rn * gg[0], O[eb][4 * g4 + 1] * rn * gg[1]); w.y = cvtpk(O[eb][4 * g4 + 2] * rn * gg[2], O[eb][4 * g4 + 3] * rn * gg[3]);
                    *(u32x2*)(orow + e0) = w;
                }
        }
        asm volatile("s_waitcnt lgkmcnt(0)" ::: "memory"); __builtin_amdgcn_s_barrier(); asm volatile("" ::: "memory");
    }
    asm volatile("s_waitcnt vmcnt(0) lgkmcnt(0)" ::: "memory"); __builtin_amdgcn_s_barrier(); asm volatile("" ::: "memory");
}
}


namespace sg {
typedef short s16x8 __attribute__((ext_vector_type(8)));
typedef short s16x4 __attribute__((ext_vector_type(4)));
typedef float f32x16 __attribute__((ext_vector_type(16)));
typedef unsigned u32x2 __attribute__((ext_vector_type(2)));
typedef unsigned u32x4 __attribute__((ext_vector_type(4)));
typedef float f32x2 __attribute__((ext_vector_type(2)));
typedef __bf16 bf16x2 __attribute__((ext_vector_type(2)));
DEV unsigned cvtpk(float lo, float hi) { const f32x2 v = {lo, hi}; return __builtin_bit_cast(unsigned, __builtin_convertvector(v, bf16x2)); }
DEV void sg_phase(const Params& p, LAS unsigned char* lds) {
    const int tid = opaque_tid(), wid = __builtin_amdgcn_readfirstlane(tid >> 6), lane = tid & 63, h2 = lane >> 5, ql = lane & 31;
    unsigned char* ws = p.ws;
    const bf16_t* zb = (const bf16_t*)(ws + OFF_A + 64 * MiB); const bf16_t* sgw = (const bf16_t*)(ws + OFF_SGW);
    bf16_t* mix = (bf16_t*)(ws + OFF_C);
    const float* sg_b = p.in[I_SGB];
    float gam[8], bet[8];
#pragma unroll
    for (int j = 0; j < 8; ++j) { gam[j] = p.in[I_SGLNG][lane * 8 + j]; bet[j] = p.in[I_SGLNB][lane * 8 + j]; }
    const unsigned q_ = (unsigned)(lane & 15) >> 2, p_ = (unsigned)lane & 3u, blk = (unsigned)(lane >> 4) & 1u;
    const int cb = wid >> 1, pb0 = (wid & 1) * 2;
    unsigned traddr[2];
#pragma unroll
    for (int t = 0; t < 2; ++t)
        traddr[t] = 256u * (8u * h2 + 4u * t + q_) + 16u * ((((unsigned)cb ^ q_) << 2) | ((2u * blk + (p_ >> 1)) ^ ((2u * h2 + t) & 3u))) + 8u * (p_ & 1u);
    for (int unit = blockIdx.x; unit < NTOK / 128; unit += gridDim.x) {
        const int row0 = unit * 128;
#pragma unroll 4
        for (int rr = 0; rr < 16; ++rr) {
            const int q = wid * 16 + rr;
            const uint4 r = *(const uint4*)(zb + (size_t)(row0 + q) * 1024 + 512 + lane * 8);
            float v[8] = {bf2f((bf16_t)(r.x & 0xffff)), bf2f((bf16_t)(r.x >> 16)), bf2f((bf16_t)(r.y & 0xffff)), bf2f((bf16_t)(r.y >> 16)),
                          bf2f((bf16_t)(r.z & 0xffff)), bf2f((bf16_t)(r.z >> 16)), bf2f((bf16_t)(r.w & 0xffff)), bf2f((bf16_t)(r.w >> 16))};
            float s = 0.f;
#pragma unroll
            for (int j = 0; j < 8; ++j) s += v[j];
            const float mu = wave_sum(s) * (1.0f / 512.0f);
            float qq = 0.f;
#pragma unroll
            for (int j = 0; j < 8; ++j) { v[j] -= mu; qq += v[j] * v[j]; }
            const float rstd = rsqrtf(wave_sum(qq) * (1.0f / 512.0f) + EPS);
            u32x4 w;
            w.x = cvtpk(v[0] * rstd * gam[0] + bet[0], v[1] * rstd * gam[1] + bet[1]); w.y = cvtpk(v[2] * rstd * gam[2] + bet[2], v[3] * rstd * gam[3] + bet[3]);
            w.z = cvtpk(v[4] * rstd * gam[4] + bet[4], v[5] * rstd * gam[5] + bet[5]); w.w = cvtpk(v[6] * rstd * gam[6] + bet[6], v[7] * rstd * gam[7] + bet[7]);
            const unsigned ch = (unsigned)lane & 15u, swz = (((unsigned)q & 3u) << 2) | (((unsigned)q >> 2) & 3u);
            *(LAS u32x4*)(lds + (lane >> 4) * 32768 + 256 * q + 16 * (ch ^ swz)) = w;
        }
        asm volatile("s_waitcnt lgkmcnt(0)" ::: "memory"); __builtin_amdgcn_s_barrier(); asm volatile("" ::: "memory");
#pragma unroll 1
        for (int g = 0; g < 4; ++g) {
            f32x16 acc[2];
#pragma unroll
            for (int j = 0; j < 2; ++j)
#pragma unroll
                for (int r = 0; r < 16; ++r) acc[j][r] = 0.f;
            const LAS unsigned char* tb = lds + g * 32768;
#pragma unroll
            for (int ks = 0; ks < 8; ++ks) {
                const s16x4 a = __builtin_amdgcn_ds_read_tr16_b64_v4i16((LAS s16x4*)(tb + traddr[0] + 4096 * ks));
                const s16x4 b2 = __builtin_amdgcn_ds_read_tr16_b64_v4i16((LAS s16x4*)(tb + traddr[1] + 4096 * ks));
                const s16x8 vf = __builtin_shufflevector(a, b2, 0, 1, 2, 3, 4, 5, 6, 7);
#pragma unroll
                for (int j = 0; j < 2; ++j) {
                    const s16x8 wf = *(const s16x8*)(sgw + (size_t)((((g * 4 + pb0 + j) * 8 + ks) * 64 + lane)) * 8);
                    acc[j] = __builtin_amdgcn_mfma_f32_32x32x16_bf16(vf, wf, acc[j], 0, 0, 0);
                }
            }
#pragma unroll
            for (int j = 0; j < 2; ++j) {
                const int ptok = (pb0 + j) * 32 + ql, row = row0 + ptok;
                const float bias = sg_b[g * 128 + ptok];
#pragma unroll
                for (int r4 = 0; r4 < 4; ++r4) {
                    const int c0 = g * 128 + cb * 32 + 8 * r4 + 4 * h2;
                    const uint2 u = *(const uint2*)(zb + (size_t)row * 1024 + c0);
                    u32x2 w;
                    w.x = cvtpk(bf2f((bf16_t)(u.x & 0xffff)) * (acc[j][4 * r4 + 0] + bias), bf2f((bf16_t)(u.x >> 16)) * (acc[j][4 * r4 + 1] + bias));
                    w.y = cvtpk(bf2f((bf16_t)(u.y & 0xffff)) * (acc[j][4 * r4 + 2] + bias), bf2f((bf16_t)(u.y >> 16)) * (acc[j][4 * r4 + 3] + bias));
                    *(u32x2*)(mix + (size_t)row * 1024 + 512 + c0) = w;
                }
            }
        }
        asm volatile("s_waitcnt lgkmcnt(0)" ::: "memory"); __builtin_amdgcn_s_barrier(); asm volatile("" ::: "memory");
    }
}
}


namespace rt {
typedef short s16x8 __attribute__((ext_vector_type(8)));
typedef float f32x4 __attribute__((ext_vector_type(4)));
typedef unsigned u32x2 __attribute__((ext_vector_type(2)));
typedef unsigned u32x4 __attribute__((ext_vector_type(4)));
constexpr int TROW = 2064;
constexpr int O_THI = 0, O_TLO = 16 * TROW, O_PART = 2 * 16 * TROW, O_LOG = O_PART + 8 * 16 * 48 * 4, O_VEC = O_LOG + 16 * 36 * 4, O_SEL = O_VEC + 5 * 4096;
DEV void ln1_router_phase(const Params& p, LAS unsigned char* lds) {
    const int tid = opaque_tid(), wid = __builtin_amdgcn_readfirstlane(tid >> 6), lane = tid & 63, fr = lane & 15, fq = lane >> 4;
    const float* x = p.in[I_X]; const float* ln_g = p.in[I_LN1G]; const float* ln_b = p.in[I_LN1B];
    const float* wgr = p.in[I_RGW]; const float* bgr = p.in[I_RGB]; const float* wer = p.in[I_REW]; const float* ber = p.in[I_REB];
    unsigned char* ws = p.ws; bf16_t* x1b = (bf16_t*)(ws + OFF_B);
    const float* mod = (const float*)(ws + OFF_MOD); const bf16_t* y = (const bf16_t*)(ws + OFF_A);
    bf16_t* tb = (bf16_t*)(ws + OFF_C);
    int* tok_e = (int*)(ws + OFF_TOKE); int* tok_p = (int*)(ws + OFF_TOKP); float* tok_w = (float*)(ws + OFF_TOKW); int* dmap = (int*)(ws + OFF_DMAP);
    unsigned* cnt = (unsigned*)(ws + OFF_CTL) + CW_CNT;
    s16x8 whi[3][4], wlo[3][4];
#pragma unroll
    for (int nt = 0; nt < 3; ++nt)
#pragma unroll
        for (int s = 0; s < 4; ++s)
#pragma unroll
            for (int j = 0; j < 8; ++j) {
                const int k = 128 * wid + 32 * s + 8 * fq + j, n = 16 * nt + fr;
                const float w = n < 4 ? wgr[k * 4 + n] : (n < 36 ? wer[k * 32 + (n - 4)] : 0.f);
                const bf16_t hi = f2bf(w); const bf16_t lo = f2bf(w - bf2f(hi));
                whi[nt][s][j] = (short)hi; wlo[nt][s][j] = (short)lo;
            }
    LAS int* sel_e = (LAS int*)(lds + O_SEL); LAS float* sel_w = (LAS float*)(lds + O_SEL + 1024); LAS int* sel_r = (LAS int*)(lds + O_SEL + 2048);
    LAS int* hist = (LAS int*)(lds + O_SEL + 3072); LAS int* gbase = (LAS int*)(lds + O_SEL + 3200); LAS float* bias = (LAS float*)(lds + O_SEL + 3328);
    if (tid < 36) bias[tid] = tid < 4 ? bgr[tid] : ber[tid - 4];
    for (int panel = blockIdx.x; panel < NTOK / 128; panel += gridDim.x) {
        const int row0 = panel * 128;
        const float* m = mod + (row0 / L) * 6144;
        float4 xr[2][2][2]; uint4 yr[2][2];
#define RT_LOAD(tile_) do { _Pragma("unroll") for (int rr_ = 0; rr_ < 2; ++rr_) _Pragma("unroll") for (int i_ = 0; i_ < 2; ++i_) { \
            const size_t o_ = (size_t)(row0 + (tile_) * 16 + wid * 2 + rr_) * D + 8 * lane + 512 * i_; \
            xr[rr_][i_][0] = *(const float4*)(x + o_); xr[rr_][i_][1] = *(const float4*)(x + o_ + 4); yr[rr_][i_] = *(const uint4*)(y + o_); } } while (0)
        RT_LOAD(0);
        { LAS float* vec = (LAS float*)(lds + O_VEC);
          for (int c = tid; c < 1024; c += 512) { const float g = ln_g[c], bb = ln_b[c], scl = m[4096 + c], sh = m[3072 + c];
              vec[c] = m[2048 + c]; vec[1024 + c] = g; vec[2048 + c] = bb; vec[3072 + c] = g * (1.f + scl); vec[4096 + c] = bb * (1.f + scl) + sh; } }
        if (tid < 32) hist[tid] = 0;
        asm volatile("s_waitcnt lgkmcnt(0)" ::: "memory"); __builtin_amdgcn_s_barrier(); asm volatile("" ::: "memory");
#pragma unroll 1
        for (int tile = 0; tile < 8; ++tile) {
#pragma unroll
            for (int rr = 0; rr < 2; ++rr) {
                const int lrow = wid * 2 + rr, row = row0 + tile * 16 + lrow;
                const LAS f32x4* vec = (const LAS f32x4*)(lds + O_VEC) + 2 * lane;
                float v[16]; float s = 0.f;
#pragma unroll
                for (int i = 0; i < 2; ++i) {
                    const float4 a0 = xr[rr][i][0], a1 = xr[rr][i][1];
                    float yv[8]; unpack8(yr[rr][i], yv);
                    const f32x4 g0 = vec[128 * i], g1 = vec[128 * i + 1];
                    v[8 * i + 0] = ALPHA * a0.x + g0[0] * yv[0]; v[8 * i + 1] = ALPHA * a0.y + g0[1] * yv[1]; v[8 * i + 2] = ALPHA * a0.z + g0[2] * yv[2]; v[8 * i + 3] = ALPHA * a0.w + g0[3] * yv[3];
                    v[8 * i + 4] = ALPHA * a1.x + g1[0] * yv[4]; v[8 * i + 5] = ALPHA * a1.y + g1[1] * yv[5]; v[8 * i + 6] = ALPHA * a1.z + g1[2] * yv[6]; v[8 * i + 7] = ALPHA * a1.w + g1[3] * yv[7];
#pragma unroll
                    for (int j = 0; j < 8; ++j) s += v[8 * i + j];
                }
                const float mu = wave_sum(s) * (1.0f / 1024.0f);
                float q = 0.f;
#pragma unroll
                for (int j = 0; j < 16; ++j) { v[j] -= mu; q += v[j] * v[j]; }
                const float rstd = rsqrtf(wave_sum(q) * (1.0f / 1024.0f) + EPS);
#pragma unroll
                for (int i = 0; i < 2; ++i) {
                    const int c = 8 * lane + 512 * i;
                    float xo[8], tt[8];
#pragma unroll
                    for (int h4 = 0; h4 < 2; ++h4) {
                        const f32x4 g = vec[256 + 128 * i + h4], bb = vec[512 + 128 * i + h4], g2 = vec[768 + 128 * i + h4], b2 = vec[1024 + 128 * i + h4];
#pragma unroll
                        for (int j = 0; j < 4; ++j) { const float n = v[8 * i + 4 * h4 + j] * rstd; xo[4 * h4 + j] = n * g[j] + bb[j]; tt[4 * h4 + j] = n * g2[j] + b2[j]; }
                    }
                    uint4 xb; xb.x = pack2(xo[0], xo[1]); xb.y = pack2(xo[2], xo[3]); xb.z = pack2(xo[4], xo[5]); xb.w = pack2(xo[6], xo[7]);
                    *(uint4*)(x1b + (size_t)row * D + c) = xb;
                    bf16_t hh[8];
#pragma unroll
                    for (int j = 0; j < 8; ++j) hh[j] = f2bf(tt[j]);
                    u32x4 hi4, lo4;
                    hi4.x = (unsigned)hh[0] | ((unsigned)hh[1] << 16); hi4.y = (unsigned)hh[2] | ((unsigned)hh[3] << 16); hi4.z = (unsigned)hh[4] | ((unsigned)hh[5] << 16); hi4.w = (unsigned)hh[6] | ((unsigned)hh[7] << 16);
                    lo4.x = pack2(tt[0] - bf2f(hh[0]), tt[1] - bf2f(hh[1])); lo4.y = pack2(tt[2] - bf2f(hh[2]), tt[3] - bf2f(hh[3]));
                    lo4.z = pack2(tt[4] - bf2f(hh[4]), tt[5] - bf2f(hh[5])); lo4.w = pack2(tt[6] - bf2f(hh[6]), tt[7] - bf2f(hh[7]));
                    { uint4 tw; tw.x = hi4.x; tw.y = hi4.y; tw.z = hi4.z; tw.w = hi4.w; *(uint4*)(tb + (size_t)row * D + c) = tw; }
                    *(LAS u32x4*)(lds + O_THI + lrow * TROW + c * 2) = hi4;
                    *(LAS u32x4*)(lds + O_TLO + lrow * TROW + c * 2) = lo4;
                }
            }
            if (tile < 7) RT_LOAD(tile + 1);
            asm volatile("s_waitcnt lgkmcnt(0)" ::: "memory"); __builtin_amdgcn_s_barrier(); asm volatile("" ::: "memory");
            f32x4 acc[3];
#pragma unroll
            for (int nt = 0; nt < 3; ++nt) acc[nt] = (f32x4){0.f, 0.f, 0.f, 0.f};
#pragma unroll
            for (int s = 0; s < 4; ++s) {
                const int kb = (128 * wid + 32 * s + 8 * fq) * 2;
                const s16x8 ahi = *(const LAS s16x8*)(lds + O_THI + fr * TROW + kb);
                const s16x8 alo = *(const LAS s16x8*)(lds + O_TLO + fr * TROW + kb);
#pragma unroll
                for (int nt = 0; nt < 3; ++nt) {
                    acc[nt] = __builtin_amdgcn_mfma_f32_16x16x32_bf16(ahi, whi[nt][s], acc[nt], 0, 0, 0);
                    acc[nt] = __builtin_amdgcn_mfma_f32_16x16x32_bf16(ahi, wlo[nt][s], acc[nt], 0, 0, 0);
                    acc[nt] = __builtin_amdgcn_mfma_f32_16x16x32_bf16(alo, whi[nt][s], acc[nt], 0, 0, 0);
                }
            }
            { LAS float* part = (LAS float*)(lds + O_PART) + wid * (16 * 48);
#pragma unroll
              for (int nt = 0; nt < 3; ++nt)
#pragma unroll
                  for (int r = 0; r < 4; ++r) part[(fq * 4 + r) * 48 + 16 * nt + fr] = acc[nt][r]; }
            asm volatile("s_waitcnt lgkmcnt(0)" ::: "memory"); __builtin_amdgcn_s_barrier(); asm volatile("" ::: "memory");
            for (int i = tid; i < 16 * 36; i += 512) {
                const int r = i / 36, o = i - r * 36; const LAS float* part = (const LAS float*)(lds + O_PART) + r * 48 + o;
                float sum = 0.f;
#pragma unroll
                for (int w = 0; w < 8; ++w) sum += part[w * (16 * 48)];
                ((LAS float*)(lds + O_LOG))[i] = sum;
            }
            asm volatile("s_waitcnt lgkmcnt(0)" ::: "memory"); __builtin_amdgcn_s_barrier(); asm volatile("" ::: "memory");
            if (tid < 16) {
                const int lr = tile * 16 + tid; const LAS float* lg = (const LAS float*)(lds + O_LOG) + tid * 36;
                float gl[4]; int gs = 0;
#pragma unroll
                for (int g = 0; g < 4; ++g) gl[g] = lg[g] + bias[g];
                float gmax = gl[0];
#pragma unroll
                for (int g = 1; g < 4; ++g) if (gl[g] > gmax) { gmax = gl[g]; gs = g; }
                float gsum = 0.f;
#pragma unroll
                for (int g = 0; g < 4; ++g) gsum += expf(gl[g] - gmax);
                const float gw = 1.0f / gsum;
                float el[8];
#pragma unroll
                for (int j = 0; j < 8; ++j) el[j] = lg[4 + gs * 8 + j] + bias[4 + gs * 8 + j];
                int i0 = 0; float v0 = el[0];
#pragma unroll
                for (int j = 1; j < 8; ++j) if (el[j] > v0) { v0 = el[j]; i0 = j; }
                int i1 = -1; float v1 = -3.0e38f;
#pragma unroll
                for (int j = 0; j < 8; ++j) if (j != i0 && (i1 < 0 || el[j] > v1)) { v1 = el[j]; i1 = j; }
                const float ex = expf(v1 - v0), w0 = gw / (1.0f + ex), w1 = gw * ex / (1.0f + ex);
                const int e0 = gs * 8 + i0, e1 = gs * 8 + i1;
                const int r0 = __hip_atomic_fetch_add(hist + e0, 1, __ATOMIC_RELAXED, __HIP_MEMORY_SCOPE_WORKGROUP), r1 = __hip_atomic_fetch_add(hist + e1, 1, __ATOMIC_RELAXED, __HIP_MEMORY_SCOPE_WORKGROUP);
                sel_e[2 * lr] = e0; sel_e[2 * lr + 1] = e1; sel_w[2 * lr] = w0; sel_w[2 * lr + 1] = w1; sel_r[2 * lr] = r0; sel_r[2 * lr + 1] = r1;
            }
        }
#undef RT_LOAD
        asm volatile("s_waitcnt lgkmcnt(0)" ::: "memory"); __builtin_amdgcn_s_barrier(); asm volatile("" ::: "memory");
        if (tid < 32) { const int h = hist[tid]; gbase[tid] = h > 0 ? (int)atomicAdd(&cnt[tid * CNT_STRIDE], (unsigned)h) : 0; }
        asm volatile("s_waitcnt vmcnt(0) lgkmcnt(0)" ::: "memory"); __builtin_amdgcn_s_barrier(); asm volatile("" ::: "memory");
        if (tid < 256) {
            const int e = sel_e[tid], pz = gbase[e] + sel_r[tid];
            tok_e[row0 * 2 + tid] = e; tok_p[row0 * 2 + tid] = pz; tok_w[row0 * 2 + tid] = sel_w[tid]; dmap[e * NTOK + pz] = row0 + (tid >> 1);
        }
        asm volatile("s_waitcnt lgkmcnt(0)" ::: "memory"); __builtin_amdgcn_s_barrier(); asm volatile("" ::: "memory");
    }
}
}

__global__ void __launch_bounds__(512, 2) mega_fwd(Params p) {
    extern __shared__ __attribute__((aligned(16))) unsigned char lds[];
    unsigned char* ws = p.ws;
    if (threadIdx.x < 4) ((volatile LAS unsigned*)((LAS unsigned char*)lds + MISC_OFF))[threadIdx.x] = 0u;
    if (threadIdx.x == 4) ((volatile LAS unsigned*)((LAS unsigned char*)lds + MISC_OFF))[18] = 0u;
    __syncthreads();
    const XcdBarrier bar = xcd_barrier_post((unsigned*)(ws + OFF_CTL) + CW_BAR, (volatile LAS unsigned*)((LAS unsigned char*)lds + MISC_OFF));
    PG8_LAS unsigned char* ring = (PG8_LAS unsigned char*)lds;
    const int G = gridDim.x, bid = blockIdx.x;

    if (bid == G - 1) phase_prep(p);
    phase_mod(p, lds);
    phase_conv(p, (LAS unsigned char*)lds);
    xcd_barrier(bar);
    phase_modulate_ctx(p);
    { asm volatile("s_waitcnt vmcnt(0)" ::: "memory"); __syncthreads();
      unsigned* hcc = (unsigned*)(ws + OFF_CTL) + CW_HC;
      if (threadIdx.x == 0) {
          __builtin_amdgcn_fence(__ATOMIC_RELEASE, "agent"); asm volatile("s_waitcnt vmcnt(0)" ::: "memory");
          for (int panel = bid; panel < NCTX / 16; panel += G) (void)xb_add(hcc + (panel * 16) / CTX, 1u);
      }
      pg8::PlainOrder S; S.init(NCTX / 256, 4, G, bid); S.pb0 = 2;
      int pm, pn;
      if (S.map(0, pm, pn)) {
          if (threadIdx.x == 0) {
              for (int i = 0; S.map(i, pm, pn); ++i) { unsigned spins = 0; while (xb_ld(hcc + pm) < (unsigned)(CTX / 16) && ++spins < (1u << 22)) __builtin_amdgcn_s_sleep(4); }
              __builtin_amdgcn_fence(__ATOMIC_ACQUIRE, "agent"); asm volatile("s_waitcnt vmcnt(0)" ::: "memory");
          }
          __syncthreads();
          pg8::Gemm g{(const bf16_t*)(ws + OFF_A + 128 * MiB), (const bf16_t*)(ws + OFF_WIN), nullptr, D};
          pg8::EpiInProj E{ws, ring + ROPE_LDS, 1, 0}; pg8::gemm_phase<pg8::EpiInProj, pg8::PlainOrder, false>(ring, g, S, E);
      } }
    phase_modulate_x(p, (LAS unsigned char*)lds);
    xcd_barrier(bar);
    { const int tx = opaque_tid(); const float* rg = (const float*)(ws + OFF_ROPE);
      for (int i = tx; i < 2048; i += 512) ((LAS float*)((LAS unsigned char*)lds + ROPE_LDS))[i] = rg[i];
      asm volatile("s_waitcnt vmcnt(0) lgkmcnt(0)" ::: "memory"); __syncthreads(); }
    { pg8::Gemm g{(const bf16_t*)(ws + OFF_A), (const bf16_t*)(ws + OFF_WIN), nullptr, D}; pg8::PlainOrder S; S.init(NTOK / 256, INC / 256, G, bid); S.pb0 = 0;
      pg8::EpiInProj E{ws, ring + ROPE_LDS, 0, 0}; pg8::gemm_phase<pg8::EpiInProj, pg8::PlainOrder, false>(ring, g, S, E); }
    xcd_barrier(bar);
    sg::sg_phase(p, (LAS unsigned char*)lds);
    att::attn_phase(p, (LAS unsigned char*)lds);
    xcd_barrier(bar);
    { pg8::Gemm g{(const bf16_t*)(ws + OFF_C), (const bf16_t*)(ws + OFF_WOUT), nullptr, D}; pg8::PlainOrder S; S.init(NTOK / 256, D / 256, G, bid); S.pb0 = 0;
      pg8::EpiBf16 E{(bf16_t*)(ws + OFF_A), D, 0}; pg8::gemm_phase<pg8::EpiBf16, pg8::PlainOrder, false>(ring, g, S, E); }
    xcd_barrier(bar);
    rt::ln1_router_phase(p, (LAS unsigned char*)lds);
    xcd_barrier(bar);
    moe_tables(p, (LAS unsigned char*)lds);
    const PG8_LAS int* tile_e = (const PG8_LAS int*)(ring + MOE_TE); const PG8_LAS int* tile_p0 = (const PG8_LAS int*)(ring + MOE_TP);
    const unsigned* ecnt = (const unsigned*)(ws + OFF_CTL) + CW_CNT;
    const int Mt = tile_e[MAXT], ns = moe_early_tiles(Mt, G);
    unsigned* sdone = (unsigned*)(ws + OFF_CTL) + CW_SDONE;
    { pg8::Gemm g{(const bf16_t*)(ws + OFF_C), (const bf16_t*)(ws + OFF_WGU), (const int*)(ws + OFF_DMAP), D};
      pg8::MoeOrder S; S.init(Mt, 8, G, bid); S.tile_e = tile_e; S.tile_p0 = tile_p0; S.cnt = ecnt; S.tpe = 8; S.pm0 = 0;
      int pub_ui = -1, pub_n = 0;
      if (ns > 0) { pg8::Unit u; for (int i = 0; S.next(i, u); ++i) if (u.pm < ns) { pub_ui = i; ++pub_n; } }
      pg8::EpiGateUp E{(bf16_t*)(ws + OFF_A), sdone, pub_ui, pub_n}; pg8::gemm_phase<pg8::EpiGateUp, pg8::MoeOrder, true>(ring, g, S, E);
      const int j = bid - (8 * Mt) % G;
      if (ns > 0 && j >= 0 && j < 4 * ns) {
          if (threadIdx.x == 0) { unsigned spins = 0; while (xb_ld(sdone) < (unsigned)(8 * ns) && ++spins < (1u << 22)) __builtin_amdgcn_s_sleep(4);
              __builtin_amdgcn_fence(__ATOMIC_ACQUIRE, "agent"); asm volatile("s_waitcnt vmcnt(0)" ::: "memory"); }
          __syncthreads();
          pg8::Gemm g2{(const bf16_t*)(ws + OFF_A), (const bf16_t*)(ws + OFF_WD), nullptr, D};
          pg8::OneOrder S1{j >> 2, j & 3, tile_e[j >> 2] * 4 + (j & 3)};
          pg8::EpiBf16 E2{(bf16_t*)(ws + OFF_Y2E), D, 0}; pg8::gemm_phase<pg8::EpiBf16, pg8::OneOrder, false>(ring, g2, S1, E2);
      } }
    xcd_barrier(bar);
    { pg8::Gemm g{(const bf16_t*)(ws + OFF_A), (const bf16_t*)(ws + OFF_WD), nullptr, D};
      pg8::MoeOrder S; S.init(Mt - ns, 4, G, bid); S.tile_e = tile_e; S.tile_p0 = tile_p0; S.cnt = ecnt; S.tpe = 4; S.pm0 = ns;
      pg8::EpiBf16 E{(bf16_t*)(ws + OFF_Y2), D, 0}; pg8::gemm_phase<pg8::EpiBf16, pg8::MoeOrder, false>(ring, g, S, E); }
    xcd_barrier(bar);
    phase_final(p, (LAS unsigned char*)lds);
}

extern "C" void kernel_launch(void* const* d_in, const int* in_sizes, int n_in, void* d_out, int out_size, void* d_ws, size_t ws_size, hipStream_t stream) {
    (void)in_sizes; (void)out_size;
    static int grid = 0;
    if (grid == 0) {
        if (n_in != 28 || ws_size < WS_END) { fprintf(stderr, "kernel_launch: expected 28 inputs and >= %zu bytes of workspace (got %d, %zu)\n", (size_t)WS_END, n_in, ws_size); grid = -1; return; }
        int dev = 0, cus = 0, per_cu = 0;
        if (hipGetDevice(&dev) != hipSuccess || hipDeviceGetAttribute(&cus, hipDeviceAttributeMultiprocessorCount, dev) != hipSuccess) { grid = -1; return; }
        if (hipFuncSetAttribute((const void*)mega_fwd, hipFuncAttributeMaxDynamicSharedMemorySize, LDS_BYTES) != hipSuccess) { fprintf(stderr, "kernel_launch: hipFuncSetAttribute failed\n"); grid = -1; return; }
        if (hipOccupancyMaxActiveBlocksPerMultiprocessor(&per_cu, (const void*)mega_fwd, 512, LDS_BYTES) != hipSuccess || per_cu < 1) { fprintf(stderr, "kernel_launch: occupancy query says %d\n", per_cu); per_cu = 1; }
        (void)hipGetLastError();
        grid = cus;
    }
    if (grid < 0) return;
    if (hipMemsetAsync((unsigned char*)d_ws + OFF_CTL, 0, 65536, stream) != hipSuccess) return;
    Params p{};
    for (int i = 0; i < 28; ++i) p.in[i] = (const float*)d_in[i];
    p.out = (float*)d_out; p.ws = (unsigned char*)d_ws;
    hipLaunchKernelGGL(mega_fwd, dim3(grid), dim3(512), LDS_BYTES, stream, p);
}
```

```cpp
#include <hip/hip_runtime.h>
#include <cstdint>
#include <cstdio>

typedef unsigned short bf16_t;
#define DEV __device__ __forceinline__
#define LAS __attribute__((address_space(3)))

namespace cfg {
constexpr int B = 16, L = 2048, D = 1024, NTOK = B * L, CTX = 256, NCTX = B * CTX, KEYS = L + CTX;
constexpr int INC = 2560, NE = 32, PMAX = 73728, MAXT = 288;
constexpr float EPS = 1e-5f, ALPHA = 1.189207115002721f, LAM_INIT = 0.2f;
constexpr size_t MiB = 1048576;
constexpr size_t OFF_CTL = 0;
constexpr size_t OFF_MOD = 65536;
constexpr size_t OFF_ROPE = OFF_MOD + 17 * 6144 * 4;
constexpr size_t OFF_LAM = OFF_ROPE + 8192;
constexpr size_t OFF_TOKE = OFF_LAM + 256;
constexpr size_t OFF_TOKP = OFF_TOKE + 262144;
constexpr size_t OFF_TOKW = OFF_TOKP + 262144;
constexpr size_t OFF_TOKS = OFF_TOKW + 262144;
constexpr size_t OFF_SLOTTOK = OFF_TOKS + 262144;
constexpr size_t OFF_TILEE = OFF_SLOTTOK + PMAX * 4;
constexpr size_t OFF_WIN = 2 * MiB;
constexpr size_t OFF_WOUT = 7 * MiB;
constexpr size_t OFF_SGW = 9 * MiB;
constexpr size_t OFF_WGU = 10 * MiB;
constexpr size_t OFF_C = 138 * MiB;
constexpr size_t OFF_Y2 = OFF_WGU;
constexpr size_t OFF_WD = 202 * MiB;
constexpr size_t OFF_A = 266 * MiB;
constexpr size_t OFF_B = 410 * MiB;
constexpr size_t OFF_DMAP = OFF_B + 64 * MiB;
constexpr size_t OFF_Y2E = OFF_B + 68 * MiB;
constexpr size_t WS_END = 554 * MiB;
constexpr int CW_BAR = 0;
constexpr int CW_CNT = 8192, CNT_STRIDE = 32;
constexpr int CW_HC = 4736;
constexpr int CW_SDONE = 4800;
constexpr int LDS_BYTES = 147456, MISC_OFF = 143360, ROPE_LDS = 131072;
constexpr int MOE_LDS = MISC_OFF + 128;
constexpr int MOE_TE = MOE_LDS, MOE_TP = MOE_LDS + 1280, MOE_BASE = MOE_LDS + 2560;
}
using namespace cfg;

DEV bf16_t f2bf(float f) { unsigned u = __float_as_uint(f); u += 0x7fffu + ((u >> 16) & 1u); return (bf16_t)(u >> 16); }
DEV float bf2f(bf16_t h) { return __uint_as_float(((unsigned)h) << 16); }
DEV unsigned pack2(float lo, float hi) { return (unsigned)f2bf(lo) | ((unsigned)f2bf(hi) << 16); }
DEV float wave_sum(float v) { for (int o = 32; o; o >>= 1) v += __shfl_xor(v, o); return v; }
DEV float wave_max(float v) { for (int o = 32; o; o >>= 1) v = fmaxf(v, __shfl_xor(v, o)); return v; }
DEV float silu_f(float x) { return x / (1.0f + __expf(-x)); }
DEV int opaque_tid() { int t = threadIdx.x; asm volatile("" : "+v"(t)); return t; }

#define XB_TMO      128
#define XB_XCNT(j)  (256  + 64 * (j))
#define XB_XSUB(j)  (1280 + 64 * (j))
#define XB_XGEN(j)  (2304 + 64 * (j))
#define XB_TOP      3328
#define XB_TOPGEN   3392
#define XCD_BAR_WORDS 3456
#define XB_SPIN_CAP (1u << 18)

__device__ __forceinline__ unsigned xb_ld(unsigned* p)              { return __hip_atomic_load(p, __ATOMIC_RELAXED, __HIP_MEMORY_SCOPE_AGENT); }
__device__ __forceinline__ unsigned xb_add(unsigned* p, unsigned v) { return __hip_atomic_fetch_add(p, v, __ATOMIC_RELAXED, __HIP_MEMORY_SCOPE_AGENT); }
__device__ __forceinline__ unsigned xb_xcc_id() { return (unsigned)__builtin_amdgcn_s_getreg((3 << 11) | 20) & 0xFu; }
#define XB_SPIN(cond, bar) do { unsigned _sp = 0; while (cond) { __builtin_amdgcn_s_sleep(1); \
    if ((++_sp & 255u) == 0u) { if (xb_ld(&(bar)[XB_TMO])) break; if (_sp > XB_SPIN_CAP) { atomicAdd(&(bar)[XB_TMO], 1u); break; } } } } while (0)

struct XcdBarrier {
    unsigned* bar; unsigned x;
    volatile LAS unsigned* st;
};

__device__ __forceinline__ XcdBarrier xcd_barrier_post(unsigned* bar, volatile LAS unsigned* st) {
    XcdBarrier b; b.bar = bar; b.x = xb_xcc_id(); b.st = st;
    if (threadIdx.x == 0) (void)xb_add(&bar[XB_XCNT(b.x)], 1u);
    return b;
}
__device__ __forceinline__ void xcd_barrier_complete(unsigned* bar, unsigned x, unsigned& nloc, unsigned& nx) {
    const unsigned G = gridDim.x * gridDim.y * gridDim.z;
    unsigned sum, cnt, mine, sp = 0u;
    for (;;) {
        sum = 0u; cnt = 0u; mine = 0u;
#pragma unroll
        for (unsigned j = 0; j < 16; ++j) { const unsigned c = xb_ld(&bar[XB_XCNT(j)]); sum += c; cnt += (c > 0u) ? 1u : 0u; mine = (j == x) ? c : mine; }
        if (sum == G) break;
        __builtin_amdgcn_s_sleep(1);
        if ((++sp & 255u) == 0u) { if (xb_ld(&bar[XB_TMO])) break; if (sp > XB_SPIN_CAP) { atomicAdd(&bar[XB_TMO], 1u); break; } }
    }
    nloc = mine > 0u ? mine : 1u; nx = cnt > 0u ? cnt : 1u;
}

__device__ __forceinline__ void xcd_barrier(const XcdBarrier& b) {
    asm volatile("s_waitcnt vmcnt(0)" ::: "memory");
    __syncthreads();
    if (threadIdx.x == 0) {
        unsigned* bar = b.bar;
        __builtin_amdgcn_s_waitcnt(0);
        unsigned nloc = b.st[0], nx = b.st[1];
        if (nloc == 0u) { xcd_barrier_complete(bar, b.x, nloc, nx); b.st[0] = nloc; b.st[1] = nx; }
        const unsigned old = xb_add(&bar[XB_XSUB(b.x)], 1u);
        const unsigned gen = old / nloc;
        if (old + 1u == (gen + 1u) * nloc) {
            __builtin_amdgcn_fence(__ATOMIC_RELEASE, "agent");
            asm volatile("s_waitcnt vmcnt(0)" ::: "memory");
            const unsigned og = xb_add(&bar[XB_TOP], 1u);
            const unsigned tg = og / nx;
            if (og + 1u == (tg + 1u) * nx) xb_add(&bar[XB_TOPGEN], 1u);
            else XB_SPIN(xb_ld(&bar[XB_TOPGEN]) == tg, bar);
            __builtin_amdgcn_fence(__ATOMIC_ACQUIRE, "agent");
            xb_add(&bar[XB_XGEN(b.x)], 1u);
            asm volatile("s_waitcnt vmcnt(0)" ::: "memory");
        } else {
            XB_SPIN(xb_ld(&bar[XB_XGEN(b.x)]) == gen, bar);
            __builtin_amdgcn_fence(__ATOMIC_ACQUIRE, "agent");
            asm volatile("s_waitcnt vmcnt(0)" ::: "memory");
        }
    }
    __syncthreads();
}

namespace pg8 {
#define PG8_LAS __attribute__((address_space(3)))
typedef short bf16x8 __attribute__((ext_vector_type(8)));
typedef float f32x4 __attribute__((ext_vector_type(4)));
typedef float f32x2 __attribute__((ext_vector_type(2)));
typedef unsigned u32x4 __attribute__((ext_vector_type(4)));
typedef unsigned u32x2 __attribute__((ext_vector_type(2)));
constexpr int BM = 256, BK = 64, HALF = 128, HTB = HALF * BK * 2, STAGE_BYTES = 8 * HTB, NXCD = 8, WGM = 8;
__host__ __device__ __forceinline__ int lds_byte(int r, int c) { const int st = (r >> 4) * 2 + (c >> 5), rr = r & 15, cc = c & 31, ob = rr * 64 + cc * 2; return st * 1024 + (ob ^ (((ob >> 9) & 1) << 5)); }
__host__ __device__ __forceinline__ void stage_rc(int b, int& R, int& C) { const int st = b / 1024, sb = b % 1024, swz = sb ^ (((sb >> 9) & 1) << 5); R = (st >> 1) * 16 + swz / 64; C = (st & 1) * 32 + (swz % 64) / 2; }
__host__ __device__ __forceinline__ int perm32(int rho) { const int n = rho >> 4, i = rho & 15; return 8 * (i >> 2) + 4 * n + (i & 3); }

struct Unit { int pm, pn, pb, ge, gp0, gcnt, ui; };
struct Gemm { const bf16_t* A; const bf16_t* Bt; const int* rowmap; int K; };

struct TileOrder {
    int nM, nN, nwg, G, c;
    __device__ __forceinline__ void init(int nM_, int nN_, int G_, int c_) { nM = nM_; nN = nN_; nwg = nM * nN; G = G_; c = c_; }
    __device__ __forceinline__ bool map(int i, int& pm, int& pn) const {
        const long L = (long)i * G + c; if (L >= nwg) return false;
        int wgid = (int)L; { const int q = nwg / NXCD, r = nwg % NXCD, xcd = wgid % NXCD, off = wgid / NXCD; wgid = (xcd < r ? xcd * (q + 1) : r * (q + 1) + (xcd - r) * q) + off; }
        const int nig = WGM * nN, gid = wgid / nig, fm = gid * WGM, gsz = (nM - fm) < WGM ? (nM - fm) : WGM;
        pm = fm + ((wgid % nig) % gsz); pn = (wgid % nig) / gsz; return true;
    }
};
struct PlainOrder : TileOrder {
    int pb0;
    __device__ __forceinline__ bool next(int i, Unit& u) const { if (!map(i, u.pm, u.pn)) return false; u.pb = pb0 + u.pn; u.ge = 0; u.gp0 = 0; u.gcnt = 0; u.ui = i; return true; }
};
struct MoeOrder : TileOrder {
    const PG8_LAS int* tile_e; const PG8_LAS int* tile_p0; const unsigned* cnt; int tpe; int pm0;
    __device__ __forceinline__ bool next(int i, Unit& u) const { if (!map(i, u.pm, u.pn)) return false; u.pm += pm0;
        const int e = tile_e[u.pm]; u.pb = e * tpe + u.pn; u.ge = e; u.gp0 = tile_p0[u.pm]; u.gcnt = (int)cnt[e * CNT_STRIDE]; u.ui = i; return true; }
};
struct OneOrder {
    int pm, pn, pb;
    __device__ __forceinline__ bool next(int i, Unit& u) const { if (i != 0) return false; u.pm = pm; u.pn = pn; u.pb = pb; u.ge = 0; u.gp0 = 0; u.gcnt = 0; u.ui = 0; return true; }
};

__device__ __forceinline__ unsigned cvt_pk_bf16(float lo, float hi) { unsigned r; asm volatile("v_cvt_pk_bf16_f32 %0, %1, %2" : "=v"(r) : "v"(lo), "v"(hi)); return r; }
__device__ __forceinline__ f32x2 gelu_pk(f32x2 v) {
    const f32x2 av = __builtin_elementwise_abs(v), d = av * 0.2316418882f + 1.0f;
    f32x2 t; t.x = __builtin_amdgcn_rcpf(d.x); t.y = __builtin_amdgcn_rcpf(d.y);
    f32x2 q = t * 0.5307027145f + (-0.7265760135f); q = q * t + 0.7107068705f; q = q * t + (-0.142248368f); q = q * t + 0.127414796f; q = q * t;
    const f32x2 s = (v * v) * (-0.72134752044f);
    f32x2 e; e.x = __builtin_amdgcn_exp2f(s.x); e.y = __builtin_amdgcn_exp2f(s.y);
    const f32x2 m = v * (q * e), r = v - m;
    f32x2 o; o.x = v.x < 0.f ? m.x : r.x; o.y = v.y < 0.f ? m.y : r.y; return o;
}

struct EpiInProj {
    static constexpr bool PERM = false;
    unsigned char* ws; PG8_LAS unsigned char* ropel; int ctx; int pad;
    __device__ __forceinline__ void operator()(const f32x4 (&acc)[2][2][4][2], const Unit& u, int wr, int wc, int fr, int fq) const {
        const PG8_LAS float* rope = (const PG8_LAS float*)ropel;
        bf16_t* qb = (bf16_t*)(ws + OFF_B); bf16_t* kb = (bf16_t*)(ws + OFF_B + 32 * MiB); bf16_t* vb = (bf16_t*)(ws + OFF_B + 68 * MiB); bf16_t* zb = (bf16_t*)(ws + OFF_A + 64 * MiB);
        const int gc0 = (ctx ? 512 : 0) + u.pn * BM;
#pragma unroll
        for (int ai = 0; ai < 2; ++ai)
#pragma unroll
            for (int m = 0; m < 4; ++m) {
                const int r = u.pm * BM + ai * HALF + wr * 64 + m * 16 + fr;
                size_t krow; int l;
                if (ctx) { krow = (size_t)(r / CTX) * KEYS + L + (r % CTX); l = 0; } else { l = r % L; krow = (size_t)(r / L) * KEYS + l; }
#pragma unroll
                for (int bj = 0; bj < 2; ++bj) {
                    const int gc = gc0 + bj * HALF + wc * 32;
                    const f32x4 a0 = acc[ai][bj][m][0], a1 = acc[ai][bj][m][1];
                    if (gc < 1024) {
                        f32x4 lo = a0, hi = a1;
                        if (!ctx) {
                            const int pos = ((gc >> 5) & 1) ? (l & 63) : (l >> 6);
                            const PG8_LAS float* rp = rope + (pos * 16 + 4 * fq) * 2;
                            const f32x4 c01 = *(const PG8_LAS f32x4*)rp, c23 = *(const PG8_LAS f32x4*)(rp + 4);
                            const float sc = gc < 512 ? 0.125f * 1.4426950408889634f : 1.0f;
                            lo[0] = (a0[0] * c01[0] - a1[0] * c01[1]) * sc; hi[0] = (a1[0] * c01[0] + a0[0] * c01[1]) * sc;
                            lo[1] = (a0[1] * c01[2] - a1[1] * c01[3]) * sc; hi[1] = (a1[1] * c01[2] + a0[1] * c01[3]) * sc;
                            lo[2] = (a0[2] * c23[0] - a1[2] * c23[1]) * sc; hi[2] = (a1[2] * c23[0] + a0[2] * c23[1]) * sc;
                            lo[3] = (a0[3] * c23[2] - a1[3] * c23[3]) * sc; hi[3] = (a1[3] * c23[2] + a0[3] * c23[3]) * sc;
                        }
                        bf16_t* dst;
                        if (gc < 512) dst = qb + (size_t)(gc >> 8) * ((size_t)NTOK * 256) + (size_t)r * 256 + (gc & 255) + 4 * fq;
                        else dst = kb + (size_t)((gc - 512) >> 8) * ((size_t)B * KEYS * 256) + krow * 256 + (gc & 255) + 4 * fq;
                        u32x2 w0, w1; w0.x = cvt_pk_bf16(lo[0], lo[1]); w0.y = cvt_pk_bf16(lo[2], lo[3]); w1.x = cvt_pk_bf16(hi[0], hi[1]); w1.y = cvt_pk_bf16(hi[2], hi[3]);
                        *(u32x2*)dst = w0; *(u32x2*)(dst + 16) = w1;
                    } else if (gc < 1536) {
                        bf16_t* dst = vb + krow * 512 + (gc - 1024) + 4 * fq;
                        u32x2 w0, w1; w0.x = cvt_pk_bf16(a0[0], a0[1]); w0.y = cvt_pk_bf16(a0[2], a0[3]); w1.x = cvt_pk_bf16(a1[0], a1[1]); w1.y = cvt_pk_bf16(a1[2], a1[3]);
                        *(u32x2*)dst = w0; *(u32x2*)(dst + 16) = w1;
                    } else {
                        bf16_t* dst = zb + (size_t)r * 1024 + (gc - 1536) + 4 * fq;
                        const f32x2 g0 = gelu_pk((f32x2){a0[0], a0[1]}), g1 = gelu_pk((f32x2){a0[2], a0[3]}), g2 = gelu_pk((f32x2){a1[0], a1[1]}), g3 = gelu_pk((f32x2){a1[2], a1[3]});
                        u32x2 w0, w1; w0.x = cvt_pk_bf16(g0.x, g0.y); w0.y = cvt_pk_bf16(g1.x, g1.y); w1.x = cvt_pk_bf16(g2.x, g2.y); w1.y = cvt_pk_bf16(g3.x, g3.y);
                        *(u32x2*)dst = w0; *(u32x2*)(dst + 16) = w1;
                    }
                }
            }
    }
};
struct EpiF32 {
    static constexpr bool PERM = false;
    float* O; int ldc; int pad;
    __device__ __forceinline__ void operator()(const f32x4 (&acc)[2][2][4][2], const Unit& u, int wr, int wc, int fr, int fq) const {
#pragma unroll
        for (int ai = 0; ai < 2; ++ai)
#pragma unroll
            for (int m = 0; m < 4; ++m) { float* rowp = O + (size_t)(u.pm * BM + ai * HALF + wr * 64 + m * 16 + fr) * ldc + u.pn * BM + wc * 32 + 4 * fq;
#pragma unroll
                for (int bj = 0; bj < 2; ++bj)
#pragma unroll
                    for (int n = 0; n < 2; ++n) *(f32x4*)(rowp + bj * HALF + 16 * n) = acc[ai][bj][m][n]; }
    }
};
struct EpiGateUp {
    static constexpr bool PERM = true;
    bf16_t* O; unsigned* sdone; int pub_ui; int pub_n;
    __device__ __forceinline__ void operator()(const f32x4 (&acc)[2][2][4][2], const Unit& u, int wr, int wc, int fr, int fq) const {
        store(acc, u, wr, wc, fr, fq);
        if (u.ui == pub_ui) {
            asm volatile("s_waitcnt vmcnt(0)" ::: "memory"); __builtin_amdgcn_s_barrier();
            if (threadIdx.x == 0) { __builtin_amdgcn_fence(__ATOMIC_RELEASE, "agent"); asm volatile("s_waitcnt vmcnt(0)" ::: "memory"); (void)xb_add(sdone, (unsigned)pub_n); }
        }
    }
    __device__ __forceinline__ void store(const f32x4 (&acc)[2][2][4][2], const Unit& u, int wr, int wc, int fr, int fq) const {
#pragma unroll
        for (int ai = 0; ai < 2; ++ai)
#pragma unroll
            for (int m = 0; m < 4; ++m) { bf16_t* dst = O + (size_t)(u.pm * BM + ai * HALF + wr * 64 + m * 16 + fr) * D + u.pn * HALF + wc * 32 + 8 * fq;
                float h[8];
#pragma unroll
                for (int n = 0; n < 2; ++n)
#pragma unroll
                    for (int j = 0; j < 4; ++j) { const float g = acc[ai][0][m][n][j], up = acc[ai][1][m][n][j]; h[4 * n + j] = g * __builtin_amdgcn_rcpf(1.0f + __expf(-g)) * up; }
                u32x4 w; w.x = cvt_pk_bf16(h[0], h[1]); w.y = cvt_pk_bf16(h[2], h[3]); w.z = cvt_pk_bf16(h[4], h[5]); w.w = cvt_pk_bf16(h[6], h[7]);
                *(u32x4*)dst = w; }
    }
};
struct EpiBf16 {
    static constexpr bool PERM = true;
    bf16_t* O; int ldc; int pad;
    __device__ __forceinline__ void operator()(const f32x4 (&acc)[2][2][4][2], const Unit& u, int wr, int wc, int fr, int fq) const {
#pragma unroll
        for (int ai = 0; ai < 2; ++ai)
#pragma unroll
            for (int m = 0; m < 4; ++m) { bf16_t* rowp = O + (size_t)(u.pm * BM + ai * HALF + wr * 64 + m * 16 + fr) * ldc + u.pn * BM + wc * 32 + 8 * fq;
#pragma unroll
                for (int bj = 0; bj < 2; ++bj) { const f32x4 v0 = acc[ai][bj][m][0], v1 = acc[ai][bj][m][1];
                    u32x4 w; w.x = cvt_pk_bf16(v0[0], v0[1]); w.y = cvt_pk_bf16(v0[2], v0[3]); w.z = cvt_pk_bf16(v1[0], v1[1]); w.w = cvt_pk_bf16(v1[2], v1[3]);
                    *(u32x4*)(rowp + bj * HALF) = w; } }
    }
};

template <class Epi, class Sched, bool GATHER>
__device__ __forceinline__ void gemm_phase(PG8_LAS unsigned char* lds, const Gemm g, const Sched& S, const Epi& E) {
    const int tid = opaque_tid(), wid = __builtin_amdgcn_readfirstlane(tid >> 6), lane = tid & 63, wr = wid >> 2, wc = wid & 3, fr = lane & 15, fq = lane >> 4;
    const int K = g.K, nt = K / BK;
    int RA[2]; unsigned colA[2], voffB[2];
#pragma unroll
    for (int i = 0; i < 2; ++i) { int R, C; stage_rc(tid * 16 + i * 8192, R, C); const int Rb = Epi::PERM ? ((R & ~31) + perm32(R & 31)) : R;
        RA[i] = R; colA[i] = (unsigned)C * 2u; voffB[i] = (unsigned)(Rb * K + C) * 2u; }
    const size_t kstep = (size_t)(BK * 2);
    const size_t hstep = (size_t)HALF * K * 2;
    const size_t tstep = 2 * hstep;
    const unsigned ldsw = (unsigned)wid * 1024u;
    const int aoff = lds_byte(wr * 64 + fr, fq * 8), boff = lds_byte(wc * 32 + fr, fq * 8);
#define PG8_AOFF(u, off) do { _Pragma("unroll") for (int _h = 0; _h < 2; ++_h) _Pragma("unroll") for (int _i = 0; _i < 2; ++_i) { \
        int _row = (u).pm * BM + _h * HALF + RA[_i]; if (GATHER) { const int _pos = (u).gp0 + _h * HALF + RA[_i]; _row = _pos < (u).gcnt ? g.rowmap[(u).ge * NTOK + _pos] : 0; } \
        (off)[_h][_i] = (unsigned)_row * (unsigned)(K * 2) + colA[_i]; } } while (0)
#define PG8_SA(b, h) (((b) * 2 + (h)) * HTB)
#define PG8_SB(b, h) ((4 + (b) * 2 + (h)) * HTB)
#define PG8_STAGE(bufoff, gbase, voff) do { _Pragma("unroll") for (int _i = 0; _i < 2; ++_i) \
        __builtin_amdgcn_global_load_lds((const unsigned*)((const char*)(gbase) + (voff)[_i]), (PG8_LAS unsigned*)(lds + (bufoff) + ldsw + _i * 8192), 16, 0, 0); } while (0)
#define PG8_LDA(dst, b, h) do { _Pragma("unroll") for (int m = 0; m < 4; ++m) _Pragma("unroll") for (int k = 0; k < 2; ++k) dst[m][k] = *(const PG8_LAS bf16x8*)(lds + PG8_SA(b, h) + aoff + m * 2048 + k * 1024); } while (0)
#define PG8_LDB(dst, b, h) do { _Pragma("unroll") for (int n = 0; n < 2; ++n) _Pragma("unroll") for (int k = 0; k < 2; ++k) dst[n][k] = *(const PG8_LAS bf16x8*)(lds + PG8_SB(b, h) + boff + n * 2048 + k * 1024); } while (0)
#define PG8_MMA(ai, bj, At, Bt) do { __builtin_amdgcn_s_setprio(1); _Pragma("unroll") for (int m = 0; m < 4; ++m) _Pragma("unroll") for (int n = 0; n < 2; ++n) _Pragma("unroll") for (int k = 0; k < 2; ++k) \
        acc[ai][bj][m][n] = __builtin_amdgcn_mfma_f32_16x16x32_bf16(Bt[n][k], At[m][k], acc[ai][bj][m][n], 0, 0, 0); __builtin_amdgcn_s_setprio(0); } while (0)
#define PG8_WAIT_V(n) asm volatile("s_waitcnt vmcnt(" #n ")" ::: "memory")
#define PG8_WAIT_L(n) asm volatile("s_waitcnt lgkmcnt(" #n ")" ::: "memory")
#define PG8_BAR __builtin_amdgcn_s_barrier()
#define PG8_SCHED __builtin_amdgcn_sched_barrier(0)
    Unit cur, nxt; int ui = 0;
    if (!S.next(0, cur)) return;
    f32x4 acc[2][2][4][2];
#pragma unroll
    for (int a = 0; a < 2; ++a)
#pragma unroll
        for (int b = 0; b < 2; ++b)
#pragma unroll
            for (int m = 0; m < 4; ++m)
#pragma unroll
                for (int n = 0; n < 2; ++n) acc[a][b][m][n] = (f32x4){0.f, 0.f, 0.f, 0.f};
    bf16x8 At[4][2], B0[2][2], B1[2][2];
    const char* Ab = (const char*)g.A;
    unsigned offc[2][2], offn[2][2];
    PG8_AOFF(cur, offc);
    const char* cB = (const char*)g.Bt + (size_t)cur.pb * tstep;
    PG8_STAGE(PG8_SB(0, 0), cB, voffB); PG8_STAGE(PG8_SB(0, 1), cB + hstep, voffB); PG8_STAGE(PG8_SA(0, 0), Ab, offc[0]); PG8_STAGE(PG8_SA(0, 1), Ab, offc[1]);
    if (wr == 1) PG8_BAR;
    PG8_WAIT_V(2); PG8_BAR;
    PG8_STAGE(PG8_SB(1, 0), cB + kstep, voffB); PG8_STAGE(PG8_SA(1, 0), Ab + kstep, offc[0]); PG8_STAGE(PG8_SB(1, 1), cB + hstep + kstep, voffB);
    PG8_WAIT_V(6); PG8_BAR;
    for (;;) {
        const bool has_next = S.next(ui + 1, nxt);
        if (has_next) { PG8_AOFF(nxt, offn); }
        else {
#pragma unroll
            for (int h = 0; h < 2; ++h)
#pragma unroll
                for (int i = 0; i < 2; ++i) offn[h][i] = offc[h][i];
        }
        const char* nB = has_next ? (const char*)g.Bt + (size_t)nxt.pb * tstep : cB;
        for (int t = 0; t < nt; t += 2) {
            const bool last = (t == nt - 2);
            const char* a1 = Ab + (size_t)(t + 1) * kstep;
            const char* a2 = Ab + (last ? (size_t)0 : (size_t)(t + 2) * kstep); const char* b2 = last ? nB : cB + (size_t)(t + 2) * kstep;
            const char* a3 = a2 + kstep; const char* b3 = b2 + kstep;
            unsigned o2[2][2];
#pragma unroll
            for (int h = 0; h < 2; ++h)
#pragma unroll
                for (int i = 0; i < 2; ++i) o2[h][i] = last ? offn[h][i] : offc[h][i];
            PG8_LDB(B0, 0, 0); PG8_LDB(B1, 0, 1); PG8_SCHED; PG8_LDA(At, 0, 0); PG8_STAGE(PG8_SA(1, 1), a1, offc[1]);
            PG8_WAIT_V(8); PG8_WAIT_L(0); PG8_BAR; PG8_MMA(0, 0, At, B0); PG8_MMA(0, 1, At, B1); PG8_BAR; PG8_SCHED;
            PG8_LDA(At, 0, 1); PG8_STAGE(PG8_SB(0, 0), b2, voffB); PG8_STAGE(PG8_SB(0, 1), b2 + hstep, voffB); PG8_STAGE(PG8_SA(0, 0), a2, o2[0]);
            PG8_WAIT_V(8); PG8_WAIT_L(0); PG8_BAR; PG8_MMA(1, 0, At, B0); PG8_MMA(1, 1, At, B1); PG8_BAR; PG8_SCHED;
            PG8_LDB(B0, 1, 0); PG8_LDB(B1, 1, 1); PG8_SCHED; PG8_LDA(At, 1, 0); PG8_STAGE(PG8_SA(0, 1), a2, o2[1]);
            PG8_WAIT_V(8); PG8_WAIT_L(0); PG8_BAR; PG8_MMA(0, 0, At, B0); PG8_MMA(0, 1, At, B1); PG8_BAR; PG8_SCHED;
            PG8_LDA(At, 1, 1); PG8_STAGE(PG8_SB(1, 0), b3, voffB); PG8_STAGE(PG8_SB(1, 1), b3 + hstep, voffB); PG8_STAGE(PG8_SA(1, 0), a3, o2[0]);
            PG8_WAIT_V(8); PG8_WAIT_L(0); PG8_BAR; PG8_MMA(1, 0, At, B0); PG8_MMA(1, 1, At, B1); PG8_BAR; PG8_SCHED;
        }
        if (wr == 0) PG8_BAR;
        E(acc, cur, wr, wc, fr, fq);
        if (!has_next) break;
#pragma unroll
        for (int a = 0; a < 2; ++a)
#pragma unroll
            for (int b = 0; b < 2; ++b)
#pragma unroll
                for (int m = 0; m < 4; ++m)
#pragma unroll
                    for (int n = 0; n < 2; ++n) acc[a][b][m][n] = (f32x4){0.f, 0.f, 0.f, 0.f};
        cur = nxt; cB = nB; ++ui;
#pragma unroll
        for (int h = 0; h < 2; ++h)
#pragma unroll
            for (int i = 0; i < 2; ++i) offc[h][i] = offn[h][i];
        if (wr == 1) PG8_BAR;
    }
    PG8_WAIT_V(0);
    PG8_BAR;
#undef PG8_AOFF
#undef PG8_SA
#undef PG8_SB
#undef PG8_STAGE
#undef PG8_LDA
#undef PG8_LDB
#undef PG8_MMA
#undef PG8_WAIT_V
#undef PG8_WAIT_L
#undef PG8_BAR
#undef PG8_SCHED
}
}


struct Params { const float* in[28]; float* out; unsigned char* ws; };
enum { I_X = 0, I_C, I_CTX, I_CCTX, I_WMOD, I_BMOD, I_WIN, I_LQ1, I_LK1, I_LQ2, I_LK2, I_SUBG, I_SGLNG, I_SGLNB, I_SGW, I_SGB, I_WOUT, I_LN1G, I_LN1B,
       I_RGW, I_RGB, I_REW, I_REB, I_EWG, I_EWU, I_EWD, I_LN2G, I_LN2B };

DEV void phase_prep(const Params& p) {
    const int tidx = opaque_tid();
    float* rope = (float*)(p.ws + OFF_ROPE);
    for (int t = tidx; t < 1024; t += blockDim.x) {
        const int pos = t >> 4, j = t & 15;
        const float inv = powf(10000.0f, -(float)j / 16.0f);
        const float ang = (float)pos * inv;
        rope[2 * t] = cosf(ang); rope[2 * t + 1] = sinf(ang);
    }
    if (tidx < 64) {
        const int l = tidx;
        const float a = wave_sum(p.in[I_LQ1][l] * p.in[I_LK1][l]), b = wave_sum(p.in[I_LQ2][l] * p.in[I_LK2][l]);
        if (l == 0) *(float*)(p.ws + OFF_LAM) = expf(a) - expf(b) + LAM_INIT;
    }
}
DEV void phase_mod(const Params& p, unsigned char* lds) {
    const int tidx = opaque_tid();
    if ((int)blockIdx.x >= 192) return;
    float* sv = (float*)lds; float* red = sv + 17 * 1024;
    const float* c = p.in[I_C]; const float* c_ctx = p.in[I_CCTX]; const float* w_mod = p.in[I_WMOD]; const float* b_mod = p.in[I_BMOD];
    if (blockDim.x == 512) {
        float cv[34];
#pragma unroll
        for (int j = 0; j < 34; ++j) { const int i = tidx + 512 * j; cv[j] = i < 16384 ? c[i] : c_ctx[i - 16384]; }
#pragma unroll
        for (int j = 0; j < 34; ++j) sv[tidx + 512 * j] = silu_f(cv[j]);
    } else
        for (int i = tidx; i < 17 * 1024; i += blockDim.x) { const float v = i < 16384 ? c[i] : c_ctx[i - 16384]; sv[i] = silu_f(v); }
    __syncthreads();
    float* mod = (float*)(p.ws + OFF_MOD);
    const int col = tidx & 31, kg = tidx >> 5, nkg = blockDim.x >> 5, dper = 1024 / nkg;
    for (int u = blockIdx.x; u < 192; u += gridDim.x) {
        const int e = u * 32 + col;
        float acc[17];
#pragma unroll
        for (int r = 0; r < 17; ++r) acc[r] = 0.f;
        for (int d0 = kg * dper; d0 < (kg + 1) * dper; d0 += 16) {
            float w[16];
#pragma unroll
            for (int j = 0; j < 16; ++j) w[j] = w_mod[(size_t)(d0 + j) * 6144 + e];
#pragma unroll
            for (int j = 0; j < 16; ++j)
#pragma unroll
                for (int r = 0; r < 17; ++r) acc[r] += sv[r * 1024 + d0 + j] * w[j];
        }
#pragma unroll
        for (int r = 0; r < 17; ++r) red[(kg * 17 + r) * 32 + col] = acc[r];
        __syncthreads();
        for (int i = tidx; i < 17 * 32; i += blockDim.x) {
            const int r = i >> 5, cc = i & 31; float s = 0.f;
            for (int g = 0; g < nkg; ++g) s += red[(g * 17 + r) * 32 + cc];
            mod[r * 6144 + u * 32 + cc] = s + b_mod[u * 32 + cc];
        }
        __syncthreads();
    }
}
DEV void conv_item(const float* W, int N, bf16_t* WT, int rbase, int rstride, LAS float* scr, int item, int lane) {
    const int nblk = N / 32, kb = item / nblk, nb = item % nblk, k0 = 64 * kb, n0 = 32 * nb;
#pragma unroll 8
    for (int i = 0; i < 32; ++i) { const int kk = 2 * i + (lane >> 5); scr[kk * 33 + (lane & 31)] = W[(size_t)(k0 + kk) * N + n0 + (lane & 31)]; }
    asm volatile("s_waitcnt lgkmcnt(0)" ::: "memory");
    const int c = lane & 7;
    const int r0 = rbase + (n0 >> 7) * rstride + (n0 & 127);
#pragma unroll
    for (int j = 0; j < 4; ++j) { const int n = (lane >> 3) + 8 * j; const LAS float* s = scr + (8 * c) * 33 + n;
        pg8::u32x4 o; o.x = pack2(s[0 * 33], s[1 * 33]); o.y = pack2(s[2 * 33], s[3 * 33]); o.z = pack2(s[4 * 33], s[5 * 33]); o.w = pack2(s[6 * 33], s[7 * 33]);
        *(pg8::u32x4*)(WT + (size_t)(r0 + n) * 1024 + k0 + 8 * c) = o; }
    asm volatile("s_waitcnt lgkmcnt(0)" ::: "memory");
}
DEV void phase_conv(const Params& p, LAS unsigned char* lds) {
    const int tidx = opaque_tid();
    const int tid = opaque_tid(), wave = __builtin_amdgcn_readfirstlane(tid >> 6), lane = tid & 63, nwv = blockDim.x >> 6;
    LAS float* scr = (LAS float*)(lds + wave * 8448);
    unsigned char* ws = p.ws;
    bf16_t* WinT = (bf16_t*)(ws + OFF_WIN); bf16_t* WoutT = (bf16_t*)(ws + OFF_WOUT); bf16_t* SgW = (bf16_t*)(ws + OFF_SGW);
    bf16_t* WguT = (bf16_t*)(ws + OFF_WGU); bf16_t* WdT = (bf16_t*)(ws + OFF_WD);
    constexpr int I_IN = 16 * 80, I_OUT = 16 * 32, I_E = 16 * 32;
    constexpr int TOT = I_IN + I_OUT + 3 * NE * I_E;
    const int gw = blockIdx.x * nwv + wave, NGW = gridDim.x * nwv;
    for (int it = gw; it < TOT; it += NGW) {
        int v = it;
        if (v < I_IN) { conv_item(p.in[I_WIN], 2560, WinT, 0, 128, scr, v, lane); continue; }
        v -= I_IN;
        if (v < I_OUT) { conv_item(p.in[I_WOUT], 1024, WoutT, 0, 128, scr, v, lane); continue; }
        v -= I_OUT;
        const int which = v / (NE * I_E), w = v % (NE * I_E), e = w / I_E, item = w % I_E;
        if (which == 0) conv_item(p.in[I_EWG] + (size_t)e * 1048576, 1024, WguT + (size_t)e * 2048 * 1024, 0, 256, scr, item, lane);
        else if (which == 1) conv_item(p.in[I_EWU] + (size_t)e * 1048576, 1024, WguT + (size_t)e * 2048 * 1024, 128, 256, scr, item, lane);
        else conv_item(p.in[I_EWD] + (size_t)e * 1048576, 1024, WdT + (size_t)e * 1024 * 1024, 0, 128, scr, item, lane);
    }
    const float* sg_w = p.in[I_SGW];
    for (int i = blockIdx.x * blockDim.x + tidx; i < 65536 / 8; i += gridDim.x * blockDim.x) {
        const int g = i >> 11, pr = (i >> 4) & 127, q0 = (i & 15) * 8;
        const float4 v0 = *(const float4*)(sg_w + (size_t)(g * 128 + pr) * 128 + q0), v1 = *(const float4*)(sg_w + (size_t)(g * 128 + pr) * 128 + q0 + 4);
        uint4 o; o.x = pack2(v0.x, v0.y); o.y = pack2(v0.z, v0.w); o.z = pack2(v1.x, v1.y); o.w = pack2(v1.z, v1.w);
        const int ks = q0 >> 4, h2 = (q0 >> 3) & 1, lane = h2 * 32 + (pr & 31);
        *(uint4*)(SgW + ((size_t)(((g * 4 + (pr >> 5)) * 8 + ks) * 64 + lane)) * 8) = o;
    }
}
DEV void unpack8(const uint4& r, float (&v)[8]) {
    v[0] = bf2f((bf16_t)(r.x & 0xffff)); v[1] = bf2f((bf16_t)(r.x >> 16)); v[2] = bf2f((bf16_t)(r.y & 0xffff)); v[3] = bf2f((bf16_t)(r.y >> 16));
    v[4] = bf2f((bf16_t)(r.z & 0xffff)); v[5] = bf2f((bf16_t)(r.z >> 16)); v[6] = bf2f((bf16_t)(r.w & 0xffff)); v[7] = bf2f((bf16_t)(r.w >> 16));
}
DEV void modulate_rows(const float* src, bf16_t* dst, const float* m, int row_lo, int nrows, int wid, int lane, int nw) {
    float sh[2][8], sc[2][8];
#pragma unroll
    for (int i = 0; i < 2; ++i)
#pragma unroll
        for (int j = 0; j < 8; ++j) { sh[i][j] = m[8 * lane + 512 * i + j]; sc[i][j] = 1.0f + m[1024 + 8 * lane + 512 * i + j]; }
    for (int r = wid; r < nrows; r += 2 * nw) {
        float4 a[2][2][2]; bool ok[2];
#pragma unroll
        for (int u = 0; u < 2; ++u) { const int rr = r + u * nw; ok[u] = rr < nrows; const float* s = src + (size_t)(row_lo + (ok[u] ? rr : r)) * D + 8 * lane;
#pragma unroll
            for (int i = 0; i < 2; ++i) { a[u][i][0] = *(const float4*)(s + 512 * i); a[u][i][1] = *(const float4*)(s + 512 * i + 4); } }
#pragma unroll
        for (int u = 0; u < 2; ++u) if (ok[u]) { bf16_t* d = dst + (size_t)(row_lo + r + u * nw) * D + 8 * lane;
#pragma unroll
            for (int i = 0; i < 2; ++i) { const float4 x0 = a[u][i][0], x1 = a[u][i][1]; uint4 o;
                o.x = pack2(x0.x * sc[i][0] + sh[i][0], x0.y * sc[i][1] + sh[i][1]); o.y = pack2(x0.z * sc[i][2] + sh[i][2], x0.w * sc[i][3] + sh[i][3]);
                o.z = pack2(x1.x * sc[i][4] + sh[i][4], x1.y * sc[i][5] + sh[i][5]); o.w = pack2(x1.z * sc[i][6] + sh[i][6], x1.w * sc[i][7] + sh[i][7]);
                *(uint4*)(d + 512 * i) = o; } }
    }
}
DEV void phase_modulate_ctx(const Params& p) {
    const int tidx = opaque_tid(), wid = tidx >> 6, lane = tidx & 63, nw = blockDim.x >> 6;
    const float* mod = (const float*)(p.ws + OFF_MOD); bf16_t* hc = (bf16_t*)(p.ws + OFF_A + 128 * MiB);
    for (int panel = blockIdx.x; panel < NCTX / 16; panel += gridDim.x) modulate_rows(p.in[I_CTX], hc, mod + 16 * 6144, panel * 16, 16, wid, lane, nw);
}
DEV void phase_modulate_x(const Params& p, LAS unsigned char* lds) {
    const int tidx = opaque_tid(), lane = tidx & 63;
    const float* mod = (const float*)(p.ws + OFF_MOD); const float* src = p.in[I_X];
    bf16_t* h = (bf16_t*)(p.ws + OFF_A);
    LAS unsigned* ticket = (LAS unsigned*)(lds + MISC_OFF + 72);
    const int G = (int)gridDim.x, skip = G > 64 ? 64 : 0, nwork = G - skip, widx = (int)blockIdx.x - skip;
    if (widx < 0) return;
    const int quad_lo = (int)(((long)widx * (NTOK / 4)) / nwork), quad_hi = (int)(((long)(widx + 1) * (NTOK / 4)) / nwork);
    int curb = -1;
    float sh[2][8], sc[2][8];
    for (;;) {
        unsigned tk = 0; if (lane == 0) tk = __hip_atomic_fetch_add(ticket, 1u, __ATOMIC_RELAXED, __HIP_MEMORY_SCOPE_WORKGROUP);
        const int t = __builtin_amdgcn_readfirstlane((int)tk);
        if (t >= quad_hi - quad_lo) break;
        const int row = 4 * (quad_lo + t), b = row / L;
        float4 a[4][2][2];
#pragma unroll
        for (int u = 0; u < 4; ++u) { const float* s = src + (size_t)(row + u) * D + 8 * lane;
#pragma unroll
            for (int i = 0; i < 2; ++i) { a[u][i][0] = *(const float4*)(s + 512 * i); a[u][i][1] = *(const float4*)(s + 512 * i + 4); } }
        if (b != curb) { curb = b; const float* m = mod + b * 6144;
#pragma unroll
            for (int i = 0; i < 2; ++i)
#pragma unroll
                for (int j = 0; j < 8; ++j) { sh[i][j] = m[8 * lane + 512 * i + j]; sc[i][j] = 1.0f + m[1024 + 8 * lane + 512 * i + j]; } }
#pragma unroll
        for (int u = 0; u < 4; ++u) { bf16_t* d = h + (size_t)(row + u) * D + 8 * lane;
#pragma unroll
            for (int i = 0; i < 2; ++i) { const float4 x0 = a[u][i][0], x1 = a[u][i][1]; uint4 o;
                o.x = pack2(x0.x * sc[i][0] + sh[i][0], x0.y * sc[i][1] + sh[i][1]); o.y = pack2(x0.z * sc[i][2] + sh[i][2], x0.w * sc[i][3] + sh[i][3]);
                o.z = pack2(x1.x * sc[i][4] + sh[i][4], x1.y * sc[i][5] + sh[i][5]); o.w = pack2(x1.z * sc[i][6] + sh[i][6], x1.w * sc[i][7] + sh[i][7]);
                *(uint4*)(d + 512 * i) = o; } }
    }
}
DEV int moe_early_tiles(int Mt, int G) {
    const int R = (8 * Mt) % G, Rd = (4 * Mt) % G;
    return (R > 0 && Rd > 0 && Rd <= G - R && (Rd & 3) == 0 && Rd <= 4 * 128 && Rd <= 4 * Mt) ? Rd / 4 : 0;
}
DEV void moe_tables(const Params& p, LAS unsigned char* lds) {
    const int tidx = opaque_tid();
    if (tidx < 64) {
        const unsigned* cnt = (const unsigned*)(p.ws + OFF_CTL) + CW_CNT;
        LAS int* tile_e = (LAS int*)(lds + MOE_TE); LAS int* tile_p0 = (LAS int*)(lds + MOE_TP); LAS int* base = (LAS int*)(lds + MOE_BASE);
        const int e = tidx & 31, nt = tidx < 32 ? (int)((cnt[e * CNT_STRIDE] + 255u) >> 8) : 0;
        int incl = nt;
        for (int o = 1; o < 32; o <<= 1) { const int v = __shfl_up(incl, o); if ((tidx & 63) >= o) incl += v; }
        if (tidx < 32) {
            const int t0 = incl - nt;
            base[e] = t0 * 256;
            for (int i = 0; i < nt; ++i) { tile_e[t0 + i] = e; tile_p0[t0 + i] = i * 256; }
            if (tidx == 31) tile_e[MAXT] = incl;
        }
    }
    asm volatile("s_waitcnt lgkmcnt(0)" ::: "memory"); __syncthreads();
}
DEV void phase_final(const Params& p, LAS unsigned char* lds) {
    const int tidx = opaque_tid(), wid = __builtin_amdgcn_readfirstlane(tidx >> 6), lane = tidx & 63, nw = blockDim.x >> 6;
    float* out = p.out; unsigned char* ws = p.ws;
    const float* mod = (const float*)(ws + OFF_MOD); const bf16_t* y2 = (const bf16_t*)(ws + OFF_Y2); const bf16_t* x1b = (const bf16_t*)(ws + OFF_B);
    const int* tok_e = (const int*)(ws + OFF_TOKE); const int* tok_p = (const int*)(ws + OFF_TOKP); const float* tok_w = (const float*)(ws + OFF_TOKW);
    const LAS int* base = (const LAS int*)(lds + MOE_BASE);
    const bf16_t* y2e = (const bf16_t*)(ws + OFF_Y2E); const int early_rows = 256 * moe_early_tiles(((const LAS int*)(lds + MOE_TE))[MAXT], (int)gridDim.x);
    float lg[2][8], lb[2][8];
#pragma unroll
    for (int i = 0; i < 2; ++i)
#pragma unroll
        for (int j = 0; j < 8; ++j) { lg[i][j] = p.in[I_LN2G][8 * lane + 512 * i + j]; lb[i][j] = p.in[I_LN2B][8 * lane + 512 * i + j]; }
    for (int panel = blockIdx.x; panel < NTOK / 128; panel += gridDim.x) {
        const float* m = mod + (panel * 128 / L) * 6144 + 5120;
        float g2[2][8];
#pragma unroll
        for (int i = 0; i < 2; ++i)
#pragma unroll
            for (int j = 0; j < 8; ++j) g2[i][j] = m[8 * lane + 512 * i + j];
        for (int r = wid; r < 128; r += 2 * nw) {
            float v[2][16]; float mu[2], rstd[2];
#pragma unroll
            for (int u = 0; u < 2; ++u) {
                const int row = panel * 128 + r + u * nw;
                const int s0 = base[tok_e[row * 2]] + tok_p[row * 2], s1 = base[tok_e[row * 2 + 1]] + tok_p[row * 2 + 1]; const float w0 = tok_w[row * 2], w1 = tok_w[row * 2 + 1];
                float s = 0.f;
#pragma unroll
                for (int i = 0; i < 2; ++i) {
                    const int c = 8 * lane + 512 * i;
                    float xa[8], ya[8], yb[8];
                    unpack8(*(const uint4*)(x1b + (size_t)row * D + c), xa); unpack8(*(const uint4*)((s0 < early_rows ? y2e : y2) + (size_t)s0 * D + c), ya); unpack8(*(const uint4*)((s1 < early_rows ? y2e : y2) + (size_t)s1 * D + c), yb);
#pragma unroll
                    for (int j = 0; j < 8; ++j) { const float val = ALPHA * xa[j] + g2[i][j] * (w0 * ya[j] + w1 * yb[j]); v[u][8 * i + j] = val; s += val; }
                }
                mu[u] = s;
            }
#pragma unroll
            for (int u = 0; u < 2; ++u) {
                mu[u] = wave_sum(mu[u]) * (1.0f / 1024.0f);
                float q = 0.f;
#pragma unroll
                for (int j = 0; j < 16; ++j) { const float d = v[u][j] - mu[u]; q += d * d; }
                rstd[u] = rsqrtf(wave_sum(q) * (1.0f / 1024.0f) + EPS);
            }
#pragma unroll
            for (int u = 0; u < 2; ++u) {
                float* orow = out + (size_t)(panel * 128 + r + u * nw) * D + 8 * lane;
#pragma unroll
                for (int i = 0; i < 2; ++i) {
                    float4 o0, o1;
                    o0.x = (v[u][8 * i + 0] - mu[u]) * rstd[u] * lg[i][0] + lb[i][0]; o0.y = (v[u][8 * i + 1] - mu[u]) * rstd[u] * lg[i][1] + lb[i][1];
                    o0.z = (v[u][8 * i + 2] - mu[u]) * rstd[u] * lg[i][2] + lb[i][2]; o0.w = (v[u][8 * i + 3] - mu[u]) * rstd[u] * lg[i][3] + lb[i][3];
                    o1.x = (v[u][8 * i + 4] - mu[u]) * rstd[u] * lg[i][4] + lb[i][4]; o1.y = (v[u][8 * i + 5] - mu[u]) * rstd[u] * lg[i][5] + lb[i][5];
                    o1.z = (v[u][8 * i + 6] - mu[u]) * rstd[u] * lg[i][6] + lb[i][6]; o1.w = (v[u][8 * i + 7] - mu[u]) * rstd[u] * lg[i][7] + lb[i][7];
                    *(float4*)(orow + 512 * i) = o0; *(float4*)(orow + 512 * i + 4) = o1;
                }
            }
        }
    }
}

namespace att {
typedef short s16x8 __attribute__((ext_vector_type(8)));
typedef short s16x4 __attribute__((ext_vector_type(4)));
typedef float f32x16 __attribute__((ext_vector_type(16)));
typedef float f32x4 __attribute__((ext_vector_type(4)));
typedef unsigned u32x2 __attribute__((ext_vector_type(2)));
constexpr int KBUF = 16384, VOFF = 49152, VBUF = 16384, NUNITS = B * 4 * (L / 128), NT = KEYS / 64;
constexpr float THR = 60.0f;
typedef float f32x2 __attribute__((ext_vector_type(2)));
typedef __bf16 bf16x2 __attribute__((ext_vector_type(2)));
DEV unsigned cvtpk(float lo, float hi) { const f32x2 v = {lo, hi}; return __builtin_bit_cast(unsigned, __builtin_convertvector(v, bf16x2)); }
DEV s16x8 pack8(const f32x16& v, int o) {
    union { unsigned u[4]; s16x8 s; } x;
    x.u[0] = cvtpk(v[o + 0], v[o + 1]); x.u[1] = cvtpk(v[o + 2], v[o + 3]); x.u[2] = cvtpk(v[o + 4], v[o + 5]); x.u[3] = cvtpk(v[o + 6], v[o + 7]);
    return x.s;
}
template <int OFF> DEV void tr_rd(s16x4& r, unsigned addr) { asm volatile("ds_read_b64_tr_b16 %0, %1 offset:%2" : "=&v"(r) : "v"(addr), "i"(OFF)); }
struct Ctx {
    const bf16_t* k1; const bf16_t* k2; const bf16_t* v;
    unsigned ksrc, vsrc0, vsrc1;
    unsigned kaddr[4]; unsigned vaddr[2][4];
    int wid, map;
};
DEV void stageK(const Ctx& c, LAS unsigned char* lds, int t, int kb) {
    const size_t rk = (size_t)t * 64 * 256;
    __builtin_amdgcn_global_load_lds((const unsigned*)(c.k1 + rk + c.ksrc), (LAS unsigned*)(lds + kb * KBUF + c.wid * 1024), 16, 0, 0);
    __builtin_amdgcn_global_load_lds((const unsigned*)(c.k2 + rk + c.ksrc), (LAS unsigned*)(lds + kb * KBUF + 8192 + c.wid * 1024), 16, 0, 0);
}
DEV void stageV(const Ctx& c, LAS unsigned char* lds, int t, int vb) {
    const size_t rv = (size_t)t * 64 * 512;
    __builtin_amdgcn_global_load_lds((const unsigned*)(c.v + rv + c.vsrc0), (LAS unsigned*)(lds + VOFF + vb * VBUF + c.wid * 1024), 16, 0, 0);
    __builtin_amdgcn_global_load_lds((const unsigned*)(c.v + rv + c.vsrc1), (LAS unsigned*)(lds + VOFF + vb * VBUF + 8192 + c.wid * 1024), 16, 0, 0);
}
DEV void qk(const Ctx& c, LAS unsigned char* lds, unsigned kboff, const s16x8 (&qf)[4], f32x16& S0, f32x16& S1) {
    const LAS unsigned char* kb = lds + kboff;
#pragma unroll
    for (int r = 0; r < 16; ++r) { S0[r] = 0.f; S1[r] = 0.f; }
    s16x8 ka[4], kc[4];
#pragma unroll
    for (int s = 0; s < 4; ++s) { ka[s] = *(const LAS s16x8*)(kb + c.kaddr[s]); kc[s] = *(const LAS s16x8*)(kb + 4096 + c.kaddr[s]); }
#pragma unroll
    for (int s = 0; s < 4; ++s) {
        S0 = __builtin_amdgcn_mfma_f32_32x32x16_bf16(ka[s], qf[s], S0, 0, 0, 0);
        S1 = __builtin_amdgcn_mfma_f32_32x32x16_bf16(kc[s], qf[s], S1, 0, 0, 0);
    }
}
DEV int imax3(int a, int b, int c) { return max(max(a, b), c); }
DEV void softmax_pv(const Ctx& c, unsigned vbase, f32x16& S0, f32x16& S1, f32x16 (&O)[4], float& m, float& l, bool first) {
    int i0 = imax3(__float_as_int(S0[0]), __float_as_int(S1[0]), __float_as_int(S0[1])), i1 = imax3(__float_as_int(S0[4]), __float_as_int(S1[4]), __float_as_int(S0[5]));
    int i2 = imax3(__float_as_int(S0[8]), __float_as_int(S1[8]), __float_as_int(S0[9])), i3 = imax3(__float_as_int(S0[12]), __float_as_int(S1[12]), __float_as_int(S0[13]));
    i0 = imax3(i0, __float_as_int(S1[1]), __float_as_int(S0[2])); i1 = imax3(i1, __float_as_int(S1[5]), __float_as_int(S0[6])); i2 = imax3(i2, __float_as_int(S1[9]), __float_as_int(S0[10])); i3 = imax3(i3, __float_as_int(S1[13]), __float_as_int(S0[14]));
    i0 = imax3(i0, __float_as_int(S1[2]), __float_as_int(S0[3])); i1 = imax3(i1, __float_as_int(S1[6]), __float_as_int(S0[7])); i2 = imax3(i2, __float_as_int(S1[10]), __float_as_int(S0[11])); i3 = imax3(i3, __float_as_int(S1[14]), __float_as_int(S0[15]));
    i0 = imax3(i0, __float_as_int(S1[3]), i1); i2 = imax3(i2, __float_as_int(S1[7]), i3);
    const int im = imax3(i0, i2, max(__float_as_int(S1[11]), __float_as_int(S1[15])));
    const bool simple = !first && !__any((im > __float_as_int(THR)) || (m != 0.f));
    if (!simple) {
        const float mref = first ? 0.f : m;
#pragma unroll
        for (int r = 0; r < 16; ++r) { S0[r] -= mref; S1[r] -= mref; }
        float t0 = fmaxf(fmaxf(S0[0], S1[0]), S0[1]), t1 = fmaxf(fmaxf(S0[4], S1[4]), S0[5]), t2 = fmaxf(fmaxf(S0[8], S1[8]), S0[9]), t3 = fmaxf(fmaxf(S0[12], S1[12]), S0[13]);
        t0 = fmaxf(fmaxf(t0, S1[1]), S0[2]); t1 = fmaxf(fmaxf(t1, S1[5]), S0[6]); t2 = fmaxf(fmaxf(t2, S1[9]), S0[10]); t3 = fmaxf(fmaxf(t3, S1[13]), S0[14]);
        t0 = fmaxf(fmaxf(t0, S1[2]), S0[3]); t1 = fmaxf(fmaxf(t1, S1[6]), S0[7]); t2 = fmaxf(fmaxf(t2, S1[10]), S0[11]); t3 = fmaxf(fmaxf(t3, S1[14]), S0[15]);
        t0 = fmaxf(fmaxf(t0, S1[3]), t1); t2 = fmaxf(fmaxf(t2, S1[7]), t3);
        float tm = fmaxf(fmaxf(t0, t2), fmaxf(S1[11], S1[15]));
        { const auto rr = __builtin_amdgcn_permlane32_swap(__float_as_uint(tm), __float_as_uint(tm), false, false);
          tm = fmaxf(__uint_as_float(rr[0]), __uint_as_float(rr[1])); }
        const float d = first ? ((fabsf(tm) > THR) ? tm : 0.f) : ((tm > THR) ? tm : 0.f);
        if (__any(d != 0.f)) {
            const float al = first ? 1.0f : __builtin_amdgcn_exp2f(-d);
            l *= al;
#pragma unroll
            for (int eb = 0; eb < 4; ++eb)
#pragma unroll
                for (int r = 0; r < 16; ++r) O[eb][r] *= al;
#pragma unroll
            for (int r = 0; r < 16; ++r) { S0[r] -= d; S1[r] -= d; }
        }
        m = mref + d;
    }
#pragma unroll
    for (int r = 0; r < 16; ++r) { S0[r] = __builtin_amdgcn_exp2f(S0[r]); S1[r] = __builtin_amdgcn_exp2f(S1[r]); }
    float ls0 = S0[0], ls1 = S0[8], ls2 = S1[0], ls3 = S1[8];
#pragma unroll
    for (int r = 1; r < 8; ++r) { ls0 += S0[r]; ls1 += S0[r + 8]; ls2 += S1[r]; ls3 += S1[r + 8]; }
    l += (ls0 + ls1) + (ls2 + ls3);
    s16x8 pf[4];
    pf[0] = pack8(S0, 0); pf[1] = pack8(S0, 8); pf[2] = pack8(S1, 0); pf[3] = pack8(S1, 8);
    unsigned va[2][4];
#pragma unroll
    for (int t = 0; t < 2; ++t)
#pragma unroll
        for (int eb = 0; eb < 4; ++eb) va[t][eb] = vbase + c.vaddr[t][eb];
    s16x4 g0[2][4][2], g1[2][4][2];
#pragma unroll
    for (int eb = 0; eb < 4; ++eb) { tr_rd<0>(g0[0][eb][0], va[0][eb]); tr_rd<0>(g0[0][eb][1], va[1][eb]); tr_rd<4096>(g0[1][eb][0], va[0][eb]); tr_rd<4096>(g0[1][eb][1], va[1][eb]); }
    asm volatile("s_waitcnt lgkmcnt(0)"
                 : "+v"(g0[0][0][0]), "+v"(g0[0][0][1]), "+v"(g0[0][1][0]), "+v"(g0[0][1][1]), "+v"(g0[0][2][0]), "+v"(g0[0][2][1]), "+v"(g0[0][3][0]), "+v"(g0[0][3][1]),
                   "+v"(g0[1][0][0]), "+v"(g0[1][0][1]), "+v"(g0[1][1][0]), "+v"(g0[1][1][1]), "+v"(g0[1][2][0]), "+v"(g0[1][2][1]), "+v"(g0[1][3][0]), "+v"(g0[1][3][1]));
#pragma unroll
    for (int eb = 0; eb < 4; ++eb) { tr_rd<8192>(g1[0][eb][0], va[0][eb]); tr_rd<8192>(g1[0][eb][1], va[1][eb]); tr_rd<12288>(g1[1][eb][0], va[0][eb]); tr_rd<12288>(g1[1][eb][1], va[1][eb]); }
#pragma unroll
    for (int k2 = 0; k2 < 2; ++k2)
#pragma unroll
        for (int eb = 0; eb < 4; ++eb) {
            const s16x8 vf = __builtin_shufflevector(g0[k2][eb][0], g0[k2][eb][1], 0, 1, 2, 3, 4, 5, 6, 7);
            O[eb] = __builtin_amdgcn_mfma_f32_32x32x16_bf16(vf, pf[k2], O[eb], 0, 0, 0);
        }
    asm volatile("s_waitcnt lgkmcnt(0)"
                 : "+v"(g1[0][0][0]), "+v"(g1[0][0][1]), "+v"(g1[0][1][0]), "+v"(g1[0][1][1]), "+v"(g1[0][2][0]), "+v"(g1[0][2][1]), "+v"(g1[0][3][0]), "+v"(g1[0][3][1]),
                   "+v"(g1[1][0][0]), "+v"(g1[1][0][1]), "+v"(g1[1][1][0]), "+v"(g1[1][1][1]), "+v"(g1[1][2][0]), "+v"(g1[1][2][1]), "+v"(g1[1][3][0]), "+v"(g1[1][3][1]));
#pragma unroll
    for (int k2 = 0; k2 < 2; ++k2)
#pragma unroll
        for (int eb = 0; eb < 4; ++eb) {
            const s16x8 vf = __builtin_shufflevector(g1[k2][eb][0], g1[k2][eb][1], 0, 1, 2, 3, 4, 5, 6, 7);
            O[eb] = __builtin_amdgcn_mfma_f32_32x32x16_bf16(vf, pf[2 + k2], O[eb], 0, 0, 0);
        }
}
#define ATT_BAR() do { asm volatile("s_waitcnt vmcnt(0) lgkmcnt(0)" ::: "memory"); __builtin_amdgcn_s_barrier(); asm volatile("" ::: "memory"); } while (0)
DEV void attn_phase(const Params& p, LAS unsigned char* lds) {
    const int tid = opaque_tid(), wid = __builtin_amdgcn_readfirstlane(tid >> 6), lane = tid & 63;
    const int map = wid >> 2, rg = wid & 3, h2 = lane >> 5, ql = lane & 31;
    unsigned char* ws = p.ws;
    const bf16_t* qbase = (const bf16_t*)(ws + OFF_B) + (size_t)map * NTOK * 256;
    const bf16_t* k1base = (const bf16_t*)(ws + OFF_B + 32 * MiB); const bf16_t* k2base = k1base + (size_t)B * KEYS * 256;
    const bf16_t* vbase = (const bf16_t*)(ws + OFF_B + 68 * MiB);
    bf16_t* mix = (bf16_t*)(ws + OFF_C);
    const float* subg = p.in[I_SUBG];
    const float lam = *(const float*)(ws + OFF_LAM);
    Ctx c; c.wid = wid; c.map = map;
    { const int key = tid >> 3, ch = (tid & 7) ^ ((key >> 1) & 7); c.ksrc = (unsigned)(key * 256 + ch * 8); }
    { const int s0 = tid, k0 = s0 >> 4, c0 = (s0 & 15) ^ (((k0 & 3) << 2) | ((k0 >> 2) & 3)); c.vsrc0 = (unsigned)(k0 * 512 + c0 * 8);
      const int s1 = tid + 512, k1 = s1 >> 4, c1 = (s1 & 15) ^ (((k1 & 3) << 2) | ((k1 >> 2) & 3)); c.vsrc1 = (unsigned)(k1 * 512 + c1 * 8); }
    { const unsigned xk = (unsigned)(ql >> 1) & 7u;
#pragma unroll
      for (int s = 0; s < 4; ++s) c.kaddr[s] = (unsigned)ql * 128u + ((((unsigned)(2 * s + h2)) ^ xk) << 4);
      const unsigned q_ = (unsigned)(lane & 15) >> 2, p_ = (unsigned)lane & 3u, blk = (unsigned)(lane >> 4) & 1u;
#pragma unroll
      for (int t = 0; t < 2; ++t)
#pragma unroll
          for (int eb = 0; eb < 4; ++eb)
              c.vaddr[t][eb] = 256u * (4u * h2 + 8u * t + q_) + 16u * ((((unsigned)eb ^ q_) << 2) | ((2u * blk + (p_ >> 1)) ^ (unsigned)(h2 + 2 * t))) + 8u * (p_ & 1u);
    }
    const int G = gridDim.x, bid = blockIdx.x;
    auto unit_of = [&](int i) -> int {
        if (G == 256) { if (i >= 4) return -1; const int j = i * 32 + (bid >> 3); return ((bid & 7) * 8 + (j >> 4)) * 16 + (j & 15); }
        const int u = i * G + bid; return u < NUNITS ? u : -1; };
#define ATT_STAGE0(unit_) do { const int bh_ = (unit_) >> 4, b_ = bh_ >> 2, h_ = bh_ & 3; \
        c.k1 = k1base + (size_t)b_ * KEYS * 256 + h_ * 64; c.k2 = k2base + (size_t)b_ * KEYS * 256 + h_ * 64; c.v = vbase + (size_t)b_ * KEYS * 512 + h_ * 128; \
        stageK(c, lds, 0, 0); stageV(c, lds, 0, 0); stageK(c, lds, 1, 1); } while (0)
    int unit = unit_of(0);
    if (unit >= 0) ATT_STAGE0(unit);
    for (int i = 0; unit >= 0; ++i) {
        const int bh = unit >> 4, qblk = unit & 15, b = bh >> 2, h = bh & 3;
        const int row = b * L + qblk * 128 + rg * 32 + ql;
        s16x8 qf[4];
        { const bf16_t* qrow = qbase + (size_t)row * 256 + h * 64;
#pragma unroll
          for (int s = 0; s < 4; ++s) qf[s] = *(const s16x8*)(qrow + (2 * s + h2) * 8); }
        f32x16 O[4];
#pragma unroll
        for (int eb = 0; eb < 4; ++eb)
#pragma unroll
            for (int r = 0; r < 16; ++r) O[eb][r] = 0.f;
        float m = 0.f, l = 0.f;
        const unsigned ldsb = (unsigned)(__UINTPTR_TYPE__)lds, kmap = (unsigned)(map * 8192);
        ATT_BAR();
        f32x16 Sa0, Sa1, Sb0, Sb1;
        qk(c, lds, kmap, qf, Sa0, Sa1);
        int k1i = 1, k2i = 2;
        for (int t = 0; t < NT; t += 2) {
            if (t + 2 < NT) stageK(c, lds, t + 2, k2i);
            stageV(c, lds, t + 1, 1);
            qk(c, lds, (unsigned)(k1i * KBUF) + kmap, qf, Sb0, Sb1);
            softmax_pv(c, ldsb + (unsigned)VOFF, Sa0, Sa1, O, m, l, t == 0);
            { const int n = (k2i == 2) ? 0 : k2i + 1; k1i = k2i; k2i = n; }
            ATT_BAR();
            if (t + 3 < NT) stageK(c, lds, t + 3, k2i);
            if (t + 2 < NT) { stageV(c, lds, t + 2, 0); qk(c, lds, (unsigned)(k1i * KBUF) + kmap, qf, Sa0, Sa1); }
            softmax_pv(c, ldsb + (unsigned)(VOFF + VBUF), Sb0, Sb1, O, m, l, false);
            { const int n = (k2i == 2) ? 0 : k2i + 1; k1i = k2i; k2i = n; }
            ATT_BAR();
        }
        unit = unit_of(i + 1);
        if (unit >= 0) ATT_STAGE0(unit);
        float lt; { const auto rr = __builtin_amdgcn_permlane32_swap(__float_as_uint(l), __float_as_uint(l), false, false); lt = __uint_as_float(rr[0]) + __uint_as_float(rr[1]); }
        LAS float* xch = (LAS float*)(lds + (rg == 0 ? 65536 : 65536 + rg * 16384));
        if (map == 1) {
            const float sc = -lam / lt;
#pragma unroll
            for (int eb = 0; eb < 4; ++eb)
#pragma unroll
                for (int r = 0; r < 16; ++r) xch[(eb * 32 + (r & 3) + 8 * (r >> 2) + 4 * h2) * 32 + ql] = O[eb][r] * sc;
        }
        asm volatile("s_waitcnt lgkmcnt(0)" ::: "memory"); __builtin_amdgcn_s_barrier(); asm volatile("" ::: "memory");
        if (map == 0) {
            const float sc = 1.0f / lt;
            float ss = 0.f;
#pragma unroll
            for (int eb = 0; eb < 4; ++eb)
#pragma unroll
                for (int r = 0; r < 16; ++r) { const float o = O[eb][r] * sc + xch[(eb * 32 + (r & 3) + 8 * (r >> 2) + 4 * h2) * 32 + ql]; O[eb][r] = o; ss += o * o; }
            ss += __shfl_xor(ss, 32);
            const float rn = rsqrtf(ss * (1.0f / 128.0f) + EPS) * (1.0f - LAM_INIT);
            bf16_t* orow = mix + (size_t)row * 1024 + h * 128;
#pragma unroll
            for (int eb = 0; eb < 4; ++eb)
#pragma unroll
                for (int g4 = 0; g4 < 4; ++g4) {
                    const int e0 = eb * 32 + 8 * g4 + 4 * h2;
                    const f32x4 gg = *(const f32x4*)(subg + e0);
                    u32x2 w; w.x = cvtpk(O[eb][4 * g4 + 0] * rn * gg[0], O[eb][4 * g4 + 1] * rn * gg[1]); w.y = cvtpk(O[eb][4 * g4 + 2] * rn * gg[2], O[eb][4 * g4 + 3] * rn * gg[3]);
                    *(u32x2*)(orow + e0) = w;
                }
        }
        asm volatile("s_waitcnt lgkmcnt(0)" ::: "memory"); __builtin_amdgcn_s_barrier(); asm volatile("" ::: "memory");
    }
#undef ATT_STAGE0
    asm volatile("s_waitcnt vmcnt(0) lgkmcnt(0)" ::: "memory"); __builtin_amdgcn_s_barrier(); asm volatile("" ::: "memory");
}
}


namespace sg {
typedef short s16x8 __attribute__((ext_vector_type(8)));
typedef short s16x4 __attribute__((ext_vector_type(4)));
typedef float f32x16 __attribute__((ext_vector_type(16)));
typedef unsigned u32x2 __attribute__((ext_vector_type(2)));
typedef unsigned u32x4 __attribute__((ext_vector_type(4)));
typedef float f32x2 __attribute__((ext_vector_type(2)));
typedef __bf16 bf16x2 __attribute__((ext_vector_type(2)));
DEV unsigned cvtpk(float lo, float hi) { const f32x2 v = {lo, hi}; return __builtin_bit_cast(unsigned, __builtin_convertvector(v, bf16x2)); }
DEV void sg_phase(const Params& p, LAS unsigned char* lds) {
    const int tid = opaque_tid(), wid = __builtin_amdgcn_readfirstlane(tid >> 6), lane = tid & 63, h2 = lane >> 5, ql = lane & 31;
    unsigned char* ws = p.ws;
    const bf16_t* zb = (const bf16_t*)(ws + OFF_A + 64 * MiB); const bf16_t* sgw = (const bf16_t*)(ws + OFF_SGW);
    bf16_t* mix = (bf16_t*)(ws + OFF_C);
    const float* sg_b = p.in[I_SGB];
    float gam[8], bet[8];
#pragma unroll
    for (int j = 0; j < 8; ++j) { gam[j] = p.in[I_SGLNG][lane * 8 + j]; bet[j] = p.in[I_SGLNB][lane * 8 + j]; }
    const unsigned q_ = (unsigned)(lane & 15) >> 2, p_ = (unsigned)lane & 3u, blk = (unsigned)(lane >> 4) & 1u;
    const int cb = wid >> 1, pb0 = (wid & 1) * 2;
    unsigned traddr[2];
#pragma unroll
    for (int t = 0; t < 2; ++t)
        traddr[t] = 256u * (8u * h2 + 4u * t + q_) + 16u * ((((unsigned)cb ^ q_) << 2) | ((2u * blk + (p_ >> 1)) ^ ((2u * h2 + t) & 3u))) + 8u * (p_ & 1u);
    for (int unit = blockIdx.x; unit < NTOK / 128; unit += gridDim.x) {
        const int row0 = unit * 128;
#pragma unroll 4
        for (int rr = 0; rr < 16; ++rr) {
            const int q = wid * 16 + rr;
            const uint4 r = *(const uint4*)(zb + (size_t)(row0 + q) * 1024 + 512 + lane * 8);
            float v[8] = {bf2f((bf16_t)(r.x & 0xffff)), bf2f((bf16_t)(r.x >> 16)), bf2f((bf16_t)(r.y & 0xffff)), bf2f((bf16_t)(r.y >> 16)),
                          bf2f((bf16_t)(r.z & 0xffff)), bf2f((bf16_t)(r.z >> 16)), bf2f((bf16_t)(r.w & 0xffff)), bf2f((bf16_t)(r.w >> 16))};
            float s = 0.f;
#pragma unroll
            for (int j = 0; j < 8; ++j) s += v[j];
            const float mu = wave_sum(s) * (1.0f / 512.0f);
            float qq = 0.f;
#pragma unroll
            for (int j = 0; j < 8; ++j) { v[j] -= mu; qq += v[j] * v[j]; }
            const float rstd = rsqrtf(wave_sum(qq) * (1.0f / 512.0f) + EPS);
            u32x4 w;
            w.x = cvtpk(v[0] * rstd * gam[0] + bet[0], v[1] * rstd * gam[1] + bet[1]); w.y = cvtpk(v[2] * rstd * gam[2] + bet[2], v[3] * rstd * gam[3] + bet[3]);
            w.z = cvtpk(v[4] * rstd * gam[4] + bet[4], v[5] * rstd * gam[5] + bet[5]); w.w = cvtpk(v[6] * rstd * gam[6] + bet[6], v[7] * rstd * gam[7] + bet[7]);
            const unsigned ch = (unsigned)lane & 15u, swz = (((unsigned)q & 3u) << 2) | (((unsigned)q >> 2) & 3u);
            *(LAS u32x4*)(lds + (lane >> 4) * 32768 + 256 * q + 16 * (ch ^ swz)) = w;
        }
        asm volatile("s_waitcnt lgkmcnt(0)" ::: "memory"); __builtin_amdgcn_s_barrier(); asm volatile("" ::: "memory");
#pragma unroll 1
        for (int g = 0; g < 4; ++g) {
            f32x16 acc[2];
#pragma unroll
            for (int j = 0; j < 2; ++j)
#pragma unroll
                for (int r = 0; r < 16; ++r) acc[j][r] = 0.f;
            const LAS unsigned char* tb = lds + g * 32768;
#pragma unroll
            for (int ks = 0; ks < 8; ++ks) {
                const s16x4 a = __builtin_amdgcn_ds_read_tr16_b64_v4i16((LAS s16x4*)(tb + traddr[0] + 4096 * ks));
                const s16x4 b2 = __builtin_amdgcn_ds_read_tr16_b64_v4i16((LAS s16x4*)(tb + traddr[1] + 4096 * ks));
                const s16x8 vf = __builtin_shufflevector(a, b2, 0, 1, 2, 3, 4, 5, 6, 7);
#pragma unroll
                for (int j = 0; j < 2; ++j) {
                    const s16x8 wf = *(const s16x8*)(sgw + (size_t)((((g * 4 + pb0 + j) * 8 + ks) * 64 + lane)) * 8);
                    acc[j] = __builtin_amdgcn_mfma_f32_32x32x16_bf16(vf, wf, acc[j], 0, 0, 0);
                }
            }
#pragma unroll
            for (int j = 0; j < 2; ++j) {
                const int ptok = (pb0 + j) * 32 + ql, row = row0 + ptok;
                const float bias = sg_b[g * 128 + ptok];
#pragma unroll
                for (int r4 = 0; r4 < 4; ++r4) {
                    const int c0 = g * 128 + cb * 32 + 8 * r4 + 4 * h2;
                    const uint2 u = *(const uint2*)(zb + (size_t)row * 1024 + c0);
                    u32x2 w;
                    w.x = cvtpk(bf2f((bf16_t)(u.x & 0xffff)) * (acc[j][4 * r4 + 0] + bias), bf2f((bf16_t)(u.x >> 16)) * (acc[j][4 * r4 + 1] + bias));
                    w.y = cvtpk(bf2f((bf16_t)(u.y & 0xffff)) * (acc[j][4 * r4 + 2] + bias), bf2f((bf16_t)(u.y >> 16)) * (acc[j][4 * r4 + 3] + bias));
                    *(u32x2*)(mix + (size_t)row * 1024 + 512 + c0) = w;
                }
            }
        }
        asm volatile("s_waitcnt lgkmcnt(0)" ::: "memory"); __builtin_amdgcn_s_barrier(); asm volatile("" ::: "memory");
    }
}
}


namespace rt {
typedef short s16x8 __attribute__((ext_vector_type(8)));
typedef float f32x4 __attribute__((ext_vector_type(4)));
typedef unsigned u32x2 __attribute__((ext_vector_type(2)));
typedef unsigned u32x4 __attribute__((ext_vector_type(4)));
constexpr int TROW = 2064;
constexpr int O_THI = 0, O_TLO = 16 * TROW, O_PART = 2 * 16 * TROW, O_LOG = O_PART + 8 * 16 * 48 * 4, O_VEC = O_LOG + 16 * 36 * 4, O_SEL = O_VEC + 5 * 4096;
DEV void ln1_router_phase(const Params& p, LAS unsigned char* lds) {
    const int tid = opaque_tid(), wid = __builtin_amdgcn_readfirstlane(tid >> 6), lane = tid & 63, fr = lane & 15, fq = lane >> 4;
    const float* x = p.in[I_X]; const float* ln_g = p.in[I_LN1G]; const float* ln_b = p.in[I_LN1B];
    const float* wgr = p.in[I_RGW]; const float* bgr = p.in[I_RGB]; const float* wer = p.in[I_REW]; const float* ber = p.in[I_REB];
    unsigned char* ws = p.ws; bf16_t* x1b = (bf16_t*)(ws + OFF_B);
    const float* mod = (const float*)(ws + OFF_MOD); const bf16_t* y = (const bf16_t*)(ws + OFF_A);
    bf16_t* tb = (bf16_t*)(ws + OFF_C);
    int* tok_e = (int*)(ws + OFF_TOKE); int* tok_p = (int*)(ws + OFF_TOKP); float* tok_w = (float*)(ws + OFF_TOKW); int* dmap = (int*)(ws + OFF_DMAP);
    unsigned* cnt = (unsigned*)(ws + OFF_CTL) + CW_CNT;
    s16x8 whi[3][4], wlo[3][4];
#pragma unroll
    for (int nt = 0; nt < 3; ++nt)
#pragma unroll
        for (int s = 0; s < 4; ++s)
#pragma unroll
            for (int j = 0; j < 8; ++j) {
                const int k = 128 * wid + 32 * s + 8 * fq + j, n = 16 * nt + fr;
                const float w = n < 4 ? wgr[k * 4 + n] : (n < 36 ? wer[k * 32 + (n - 4)] : 0.f);
                const bf16_t hi = f2bf(w); const bf16_t lo = f2bf(w - bf2f(hi));
                whi[nt][s][j] = (short)hi; wlo[nt][s][j] = (short)lo;
            }
    LAS int* sel_e = (LAS int*)(lds + O_SEL); LAS float* sel_w = (LAS float*)(lds + O_SEL + 1024); LAS int* sel_r = (LAS int*)(lds + O_SEL + 2048);
    LAS int* hist = (LAS int*)(lds + O_SEL + 3072); LAS int* gbase = (LAS int*)(lds + O_SEL + 3200); LAS float* bias = (LAS float*)(lds + O_SEL + 3328);
    if (tid < 36) bias[tid] = tid < 4 ? bgr[tid] : ber[tid - 4];
    for (int panel = blockIdx.x; panel < NTOK / 128; panel += gridDim.x) {
        const int row0 = panel * 128;
        const float* m = mod + (row0 / L) * 6144;
        float4 xr[2][2][2]; uint4 yr[2][2];
#define RT_LOAD(tile_) do { _Pragma("unroll") for (int rr_ = 0; rr_ < 2; ++rr_) _Pragma("unroll") for (int i_ = 0; i_ < 2; ++i_) { \
            const size_t o_ = (size_t)(row0 + (tile_) * 16 + wid * 2 + rr_) * D + 8 * lane + 512 * i_; \
            xr[rr_][i_][0] = *(const float4*)(x + o_); xr[rr_][i_][1] = *(const float4*)(x + o_ + 4); yr[rr_][i_] = *(const uint4*)(y + o_); } } while (0)
        RT_LOAD(0);
        { LAS float* vec = (LAS float*)(lds + O_VEC);
          for (int c = tid; c < 1024; c += 512) { const float g = ln_g[c], bb = ln_b[c], scl = m[4096 + c], sh = m[3072 + c];
              vec[c] = m[2048 + c]; vec[1024 + c] = g; vec[2048 + c] = bb; vec[3072 + c] = g * (1.f + scl); vec[4096 + c] = bb * (1.f + scl) + sh; } }
        if (tid < 32) hist[tid] = 0;
        asm volatile("s_waitcnt lgkmcnt(0)" ::: "memory"); __builtin_amdgcn_s_barrier(); asm volatile("" ::: "memory");
#pragma unroll 1
        for (int tile = 0; tile < 8; ++tile) {
#pragma unroll
            for (int rr = 0; rr < 2; ++rr) {
                const int lrow = wid * 2 + rr, row = row0 + tile * 16 + lrow;
                const LAS f32x4* vec = (const LAS f32x4*)(lds + O_VEC) + 2 * lane;
                float v[16]; float s = 0.f;
#pragma unroll
                for (int i = 0; i < 2; ++i) {
                    const float4 a0 = xr[rr][i][0], a1 = xr[rr][i][1];
                    float yv[8]; unpack8(yr[rr][i], yv);
                    const f32x4 g0 = vec[128 * i], g1 = vec[128 * i + 1];
                    v[8 * i + 0] = ALPHA * a0.x + g0[0] * yv[0]; v[8 * i + 1] = ALPHA * a0.y + g0[1] * yv[1]; v[8 * i + 2] = ALPHA * a0.z + g0[2] * yv[2]; v[8 * i + 3] = ALPHA * a0.w + g0[3] * yv[3];
                    v[8 * i + 4] = ALPHA * a1.x + g1[0] * yv[4]; v[8 * i + 5] = ALPHA * a1.y + g1[1] * yv[5]; v[8 * i + 6] = ALPHA * a1.z + g1[2] * yv[6]; v[8 * i + 7] = ALPHA * a1.w + g1[3] * yv[7];
#pragma unroll
                    for (int j = 0; j < 8; ++j) s += v[8 * i + j];
                }
                const float mu = wave_sum(s) * (1.0f / 1024.0f);
                float q = 0.f;
#pragma unroll
                for (int j = 0; j < 16; ++j) { v[j] -= mu; q += v[j] * v[j]; }
                const float rstd = rsqrtf(wave_sum(q) * (1.0f / 1024.0f) + EPS);
#pragma unroll
                for (int i = 0; i < 2; ++i) {
                    const int c = 8 * lane + 512 * i;
                    float xo[8], tt[8];
#pragma unroll
                    for (int h4 = 0; h4 < 2; ++h4) {
                        const f32x4 g = vec[256 + 128 * i + h4], bb = vec[512 + 128 * i + h4], g2 = vec[768 + 128 * i + h4], b2 = vec[1024 + 128 * i + h4];
#pragma unroll
                        for (int j = 0; j < 4; ++j) { const float n = v[8 * i + 4 * h4 + j] * rstd; xo[4 * h4 + j] = n * g[j] + bb[j]; tt[4 * h4 + j] = n * g2[j] + b2[j]; }
                    }
                    uint4 xb; xb.x = pack2(xo[0], xo[1]); xb.y = pack2(xo[2], xo[3]); xb.z = pack2(xo[4], xo[5]); xb.w = pack2(xo[6], xo[7]);
                    *(uint4*)(x1b + (size_t)row * D + c) = xb;
                    bf16_t hh[8];
#pragma unroll
                    for (int j = 0; j < 8; ++j) hh[j] = f2bf(tt[j]);
                    u32x4 hi4, lo4;
                    hi4.x = (unsigned)hh[0] | ((unsigned)hh[1] << 16); hi4.y = (unsigned)hh[2] | ((unsigned)hh[3] << 16); hi4.z = (unsigned)hh[4] | ((unsigned)hh[5] << 16); hi4.w = (unsigned)hh[6] | ((unsigned)hh[7] << 16);
                    lo4.x = pack2(tt[0] - bf2f(hh[0]), tt[1] - bf2f(hh[1])); lo4.y = pack2(tt[2] - bf2f(hh[2]), tt[3] - bf2f(hh[3]));
                    lo4.z = pack2(tt[4] - bf2f(hh[4]), tt[5] - bf2f(hh[5])); lo4.w = pack2(tt[6] - bf2f(hh[6]), tt[7] - bf2f(hh[7]));
                    { uint4 tw; tw.x = hi4.x; tw.y = hi4.y; tw.z = hi4.z; tw.w = hi4.w; *(uint4*)(tb + (size_t)row * D + c) = tw; }
                    *(LAS u32x4*)(lds + O_THI + lrow * TROW + c * 2) = hi4;
                    *(LAS u32x4*)(lds + O_TLO + lrow * TROW + c * 2) = lo4;
                }
            }
            if (tile < 7) RT_LOAD(tile + 1);
            asm volatile("s_waitcnt lgkmcnt(0)" ::: "memory"); __builtin_amdgcn_s_barrier(); asm volatile("" ::: "memory");
            f32x4 acc[3];
#pragma unroll
            for (int nt = 0; nt < 3; ++nt) acc[nt] = (f32x4){0.f, 0.f, 0.f, 0.f};
#pragma unroll
            for (int s = 0; s < 4; ++s) {
                const int kb = (128 * wid + 32 * s + 8 * fq) * 2;
                const s16x8 ahi = *(const LAS s16x8*)(lds + O_THI + fr * TROW + kb);
                const s16x8 alo = *(const LAS s16x8*)(lds + O_TLO + fr * TROW + kb);
#pragma unroll
                for (int nt = 0; nt < 3; ++nt) {
                    acc[nt] = __builtin_amdgcn_mfma_f32_16x16x32_bf16(ahi, whi[nt][s], acc[nt], 0, 0, 0);
                    acc[nt] = __builtin_amdgcn_mfma_f32_16x16x32_bf16(ahi, wlo[nt][s], acc[nt], 0, 0, 0);
                    acc[nt] = __builtin_amdgcn_mfma_f32_16x16x32_bf16(alo, whi[nt][s], acc[nt], 0, 0, 0);
                }
            }
            { LAS float* part = (LAS float*)(lds + O_PART) + wid * (16 * 48);
#pragma unroll
              for (int nt = 0; nt < 3; ++nt)
#pragma unroll
                  for (int r = 0; r < 4; ++r) part[(fq * 4 + r) * 48 + 16 * nt + fr] = acc[nt][r]; }
            asm volatile("s_waitcnt lgkmcnt(0)" ::: "memory"); __builtin_amdgcn_s_barrier(); asm volatile("" ::: "memory");
            for (int i = tid; i < 16 * 36; i += 512) {
                const int r = i / 36, o = i - r * 36; const LAS float* part = (const LAS float*)(lds + O_PART) + r * 48 + o;
                float sum = 0.f;
#pragma unroll
                for (int w = 0; w < 8; ++w) sum += part[w * (16 * 48)];
                ((LAS float*)(lds + O_LOG))[i] = sum;
            }
            asm volatile("s_waitcnt lgkmcnt(0)" ::: "memory"); __builtin_amdgcn_s_barrier(); asm volatile("" ::: "memory");
            if (tid < 16) {
                const int lr = tile * 16 + tid; const LAS float* lg = (const LAS float*)(lds + O_LOG) + tid * 36;
                float gl[4]; int gs = 0;
#pragma unroll
                for (int g = 0; g < 4; ++g) gl[g] = lg[g] + bias[g];
                float gmax = gl[0];
#pragma unroll
                for (int g = 1; g < 4; ++g) if (gl[g] > gmax) { gmax = gl[g]; gs = g; }
                float gsum = 0.f;
#pragma unroll
                for (int g = 0; g < 4; ++g) gsum += expf(gl[g] - gmax);
                const float gw = 1.0f / gsum;
                float el[8];
#pragma unroll
                for (int j = 0; j < 8; ++j) el[j] = lg[4 + gs * 8 + j] + bias[4 + gs * 8 + j];
                int i0 = 0; float v0 = el[0];
#pragma unroll
                for (int j = 1; j < 8; ++j) if (el[j] > v0) { v0 = el[j]; i0 = j; }
                int i1 = -1; float v1 = -3.0e38f;
#pragma unroll
                for (int j = 0; j < 8; ++j) if (j != i0 && (i1 < 0 || el[j] > v1)) { v1 = el[j]; i1 = j; }
                const float ex = expf(v1 - v0), w0 = gw / (1.0f + ex), w1 = gw * ex / (1.0f + ex);
                const int e0 = gs * 8 + i0, e1 = gs * 8 + i1;
                const int r0 = __hip_atomic_fetch_add(hist + e0, 1, __ATOMIC_RELAXED, __HIP_MEMORY_SCOPE_WORKGROUP), r1 = __hip_atomic_fetch_add(hist + e1, 1, __ATOMIC_RELAXED, __HIP_MEMORY_SCOPE_WORKGROUP);
                sel_e[2 * lr] = e0; sel_e[2 * lr + 1] = e1; sel_w[2 * lr] = w0; sel_w[2 * lr + 1] = w1; sel_r[2 * lr] = r0; sel_r[2 * lr + 1] = r1;
            }
        }
#undef RT_LOAD
        asm volatile("s_waitcnt lgkmcnt(0)" ::: "memory"); __builtin_amdgcn_s_barrier(); asm volatile("" ::: "memory");
        if (tid < 32) { const int h = hist[tid]; gbase[tid] = h > 0 ? (int)atomicAdd(&cnt[tid * CNT_STRIDE], (unsigned)h) : 0; }
        asm volatile("s_waitcnt vmcnt(0) lgkmcnt(0)" ::: "memory"); __builtin_amdgcn_s_barrier(); asm volatile("" ::: "memory");
        if (tid < 256) {
            const int e = sel_e[tid], pz = gbase[e] + sel_r[tid];
            tok_e[row0 * 2 + tid] = e; tok_p[row0 * 2 + tid] = pz; tok_w[row0 * 2 + tid] = sel_w[tid]; dmap[e * NTOK + pz] = row0 + (tid >> 1);
        }
        asm volatile("s_waitcnt lgkmcnt(0)" ::: "memory"); __builtin_amdgcn_s_barrier(); asm volatile("" ::: "memory");
    }
}
}

__global__ void __launch_bounds__(512, 2) mega_fwd(Params p) {
    extern __shared__ __attribute__((aligned(16))) unsigned char lds[];
    unsigned char* ws = p.ws;
    if (threadIdx.x < 4) ((volatile LAS unsigned*)((LAS unsigned char*)lds + MISC_OFF))[threadIdx.x] = 0u;
    if (threadIdx.x == 4) ((volatile LAS unsigned*)((LAS unsigned char*)lds + MISC_OFF))[18] = 0u;
    __syncthreads();
    const XcdBarrier bar = xcd_barrier_post((unsigned*)(ws + OFF_CTL) + CW_BAR, (volatile LAS unsigned*)((LAS unsigned char*)lds + MISC_OFF));
    PG8_LAS unsigned char* ring = (PG8_LAS unsigned char*)lds;
    const int G = gridDim.x, bid = blockIdx.x;

    if (bid == G - 1) phase_prep(p);
    phase_mod(p, lds);
    phase_conv(p, (LAS unsigned char*)lds);
    xcd_barrier(bar);
    phase_modulate_ctx(p);
    { asm volatile("s_waitcnt vmcnt(0)" ::: "memory"); __syncthreads();
      unsigned* hcc = (unsigned*)(ws + OFF_CTL) + CW_HC;
      if (threadIdx.x == 0) {
          __builtin_amdgcn_fence(__ATOMIC_RELEASE, "agent"); asm volatile("s_waitcnt vmcnt(0)" ::: "memory");
          for (int panel = bid; panel < NCTX / 16; panel += G) (void)xb_add(hcc + (panel * 16) / CTX, 1u);
      }
      pg8::PlainOrder S; S.init(NCTX / 256, 4, G, bid); S.pb0 = 2;
      int pm, pn;
      if (S.map(0, pm, pn)) {
          if (threadIdx.x == 0) {
              for (int i = 0; S.map(i, pm, pn); ++i) { unsigned spins = 0; while (xb_ld(hcc + pm) < (unsigned)(CTX / 16) && ++spins < (1u << 22)) __builtin_amdgcn_s_sleep(4); }
              __builtin_amdgcn_fence(__ATOMIC_ACQUIRE, "agent"); asm volatile("s_waitcnt vmcnt(0)" ::: "memory");
          }
          __syncthreads();
          pg8::Gemm g{(const bf16_t*)(ws + OFF_A + 128 * MiB), (const bf16_t*)(ws + OFF_WIN), nullptr, D};
          pg8::EpiInProj E{ws, ring + ROPE_LDS, 1, 0}; pg8::gemm_phase<pg8::EpiInProj, pg8::PlainOrder, false>(ring, g, S, E);
      } }
    phase_modulate_x(p, (LAS unsigned char*)lds);
    xcd_barrier(bar);
    { const int tx = opaque_tid(); const float* rg = (const float*)(ws + OFF_ROPE);
      for (int i = tx; i < 2048; i += 512) ((LAS float*)((LAS unsigned char*)lds + ROPE_LDS))[i] = rg[i];
      asm volatile("s_waitcnt vmcnt(0) lgkmcnt(0)" ::: "memory"); __syncthreads(); }
    { pg8::Gemm g{(const bf16_t*)(ws + OFF_A), (const bf16_t*)(ws + OFF_WIN), nullptr, D}; pg8::PlainOrder S; S.init(NTOK / 256, INC / 256, G, bid); S.pb0 = 0;
      pg8::EpiInProj E{ws, ring + ROPE_LDS, 0, 0}; pg8::gemm_phase<pg8::EpiInProj, pg8::PlainOrder, false>(ring, g, S, E); }
    xcd_barrier(bar);
    sg::sg_phase(p, (LAS unsigned char*)lds);
    att::attn_phase(p, (LAS unsigned char*)lds);
    xcd_barrier(bar);
    { pg8::Gemm g{(const bf16_t*)(ws + OFF_C), (const bf16_t*)(ws + OFF_WOUT), nullptr, D}; pg8::PlainOrder S; S.init(NTOK / 256, D / 256, G, bid); S.pb0 = 0;
      pg8::EpiBf16 E{(bf16_t*)(ws + OFF_A), D, 0}; pg8::gemm_phase<pg8::EpiBf16, pg8::PlainOrder, false>(ring, g, S, E); }
    xcd_barrier(bar);
    rt::ln1_router_phase(p, (LAS unsigned char*)lds);
    xcd_barrier(bar);
    moe_tables(p, (LAS unsigned char*)lds);
    const PG8_LAS int* tile_e = (const PG8_LAS int*)(ring + MOE_TE); const PG8_LAS int* tile_p0 = (const PG8_LAS int*)(ring + MOE_TP);
    const unsigned* ecnt = (const unsigned*)(ws + OFF_CTL) + CW_CNT;
    const int Mt = tile_e[MAXT], ns = moe_early_tiles(Mt, G);
    unsigned* sdone = (unsigned*)(ws + OFF_CTL) + CW_SDONE;
    { pg8::Gemm g{(const bf16_t*)(ws + OFF_C), (const bf16_t*)(ws + OFF_WGU), (const int*)(ws + OFF_DMAP), D};
      pg8::MoeOrder S; S.init(Mt, 8, G, bid); S.tile_e = tile_e; S.tile_p0 = tile_p0; S.cnt = ecnt; S.tpe = 8; S.pm0 = 0;
      int pub_ui = -1, pub_n = 0;
      if (ns > 0) { pg8::Unit u; for (int i = 0; S.next(i, u); ++i) if (u.pm < ns) { pub_ui = i; ++pub_n; } }
      pg8::EpiGateUp E{(bf16_t*)(ws + OFF_A), sdone, pub_ui, pub_n}; pg8::gemm_phase<pg8::EpiGateUp, pg8::MoeOrder, true>(ring, g, S, E);
      const int j = bid - (8 * Mt) % G;
      if (ns > 0 && j >= 0 && j < 4 * ns) {
          if (threadIdx.x == 0) { unsigned spins = 0; while (xb_ld(sdone) < (unsigned)(8 * ns) && ++spins < (1u << 22)) __builtin_amdgcn_s_sleep(4);
              __builtin_amdgcn_fence(__ATOMIC_ACQUIRE, "agent"); asm volatile("s_waitcnt vmcnt(0)" ::: "memory"); }
          __syncthreads();
          pg8::Gemm g2{(const bf16_t*)(ws + OFF_A), (const bf16_t*)(ws + OFF_WD), nullptr, D};
          pg8::OneOrder S1{j >> 2, j & 3, tile_e[j >> 2] * 4 + (j & 3)};
          pg8::EpiBf16 E2{(bf16_t*)(ws + OFF_Y2E), D, 0}; pg8::gemm_phase<pg8::EpiBf16, pg8::OneOrder, false>(ring, g2, S1, E2);
      } }
    xcd_barrier(bar);
    { pg8::Gemm g{(const bf16_t*)(ws + OFF_A), (const bf16_t*)(ws + OFF_WD), nullptr, D};
      pg8::MoeOrder S; S.init(Mt - ns, 4, G, bid); S.tile_e = tile_e; S.tile_p0 = tile_p0; S.cnt = ecnt; S.tpe = 4; S.pm0 = ns;
      pg8::EpiBf16 E{(bf16_t*)(ws + OFF_Y2), D, 0}; pg8::gemm_phase<pg8::EpiBf16, pg8::MoeOrder, false>(ring, g, S, E); }
    xcd_barrier(bar);
    phase_final(p, (LAS unsigned char*)lds);
}

extern "C" void kernel_launch(void* const* d_in, const int* in_sizes, int n_in, void* d_out, int out_size, void* d_ws, size_t ws_size, hipStream_t stream) {
    (void)in_sizes; (void)out_size;
    static int grid = 0;
    if (grid == 0) {
        if (n_in != 28 || ws_size < WS_END) { fprintf(stderr, "kernel_launch: expected 28 inputs and >= %zu bytes of workspace (got %d, %zu)\n", (size_t)WS_END, n_in, ws_size); grid = -1; return; }
        int dev = 0, cus = 0, per_cu = 0;
        if (hipGetDevice(&dev) != hipSuccess || hipDeviceGetAttribute(&cus, hipDeviceAttributeMultiprocessorCount, dev) != hipSuccess) { grid = -1; return; }
        if (hipFuncSetAttribute((const void*)mega_fwd, hipFuncAttributeMaxDynamicSharedMemorySize, LDS_BYTES) != hipSuccess) { fprintf(stderr, "kernel_launch: hipFuncSetAttribute failed\n"); grid = -1; return; }
        if (hipOccupancyMaxActiveBlocksPerMultiprocessor(&per_cu, (const void*)mega_fwd, 512, LDS_BYTES) != hipSuccess || per_cu < 1) { fprintf(stderr, "kernel_launch: occupancy query says %d\n", per_cu); per_cu = 1; }
        (void)hipGetLastError();
        grid = cus;
    }
    if (grid < 0) return;
    if (hipMemsetAsync((unsigned char*)d_ws + OFF_CTL, 0, 65536, stream) != hipSuccess) return;
    Params p{};
    for (int i = 0; i < 28; ++i) p.in[i] = (const float*)d_in[i];
    p.out = (float*)d_out; p.ws = (unsigned char*)d_ws;
    hipLaunchKernelGGL(mega_fwd, dim3(grid), dim3(512), LDS_BYTES, stream, p);
}
```

```cpp
#include <hip/hip_runtime.h>
#include <cstdint>
#include <cstdio>

typedef unsigned short bf16_t;
#define DEV __device__ __forceinline__
#define LAS __attribute__((address_space(3)))

namespace cfg {
constexpr int B = 16, L = 2048, D = 1024, NTOK = B * L, CTX = 256, NCTX = B * CTX, KEYS = L + CTX;
constexpr int INC = 2560, NE = 32, PMAX = 73728, MAXT = 288;
constexpr float EPS = 1e-5f, ALPHA = 1.189207115002721f, LAM_INIT = 0.2f;
constexpr size_t MiB = 1048576;
constexpr size_t OFF_CTL = 0;
constexpr size_t OFF_MOD = 65536;
constexpr size_t OFF_ROPE = OFF_MOD + 17 * 6144 * 4;
constexpr size_t OFF_LAM = OFF_ROPE + 8192;
constexpr size_t OFF_TOKE = OFF_LAM + 256;
constexpr size_t OFF_TOKP = OFF_TOKE + 262144;
constexpr size_t OFF_TOKW = OFF_TOKP + 262144;
constexpr size_t OFF_TOKS = OFF_TOKW + 262144;
constexpr size_t OFF_SLOTTOK = OFF_TOKS + 262144;
constexpr size_t OFF_TILEE = OFF_SLOTTOK + PMAX * 4;
constexpr size_t OFF_WIN = 2 * MiB;
constexpr size_t OFF_WOUT = 7 * MiB;
constexpr size_t OFF_SGW = 9 * MiB;
constexpr size_t OFF_RTW = 9 * MiB + 256 * 1024;
constexpr size_t OFF_WGU = 10 * MiB;
constexpr size_t OFF_C = 138 * MiB;
constexpr size_t OFF_Y2 = OFF_WGU;
constexpr size_t OFF_WD = 202 * MiB;
constexpr size_t OFF_A = 266 * MiB;
constexpr size_t OFF_B = 410 * MiB;
constexpr size_t OFF_DMAP = OFF_B + 64 * MiB;
constexpr size_t OFF_Y2E = OFF_B + 68 * MiB;
constexpr size_t WS_END = 554 * MiB;
constexpr int CW_BAR = 0;
constexpr int CW_CNT = 8192, CNT_STRIDE = 32;
constexpr int CW_HC = 4736;
constexpr int CW_SDONE = 4800;
constexpr int LDS_BYTES = 147456, MISC_OFF = 143360, ROPE_LDS = 131072;
#define GU_WGM 32
#define DN_WGM 16
#define IN_WGM 8
#define OUT_WGM 8
constexpr int MOE_LDS = MISC_OFF + 128;
constexpr int MOE_TE = MOE_LDS, MOE_TP = MOE_LDS + 1280, MOE_BASE = MOE_LDS + 2560;
}
using namespace cfg;

DEV bf16_t f2bf(float f) { unsigned u = __float_as_uint(f); u += 0x7fffu + ((u >> 16) & 1u); return (bf16_t)(u >> 16); }
DEV float bf2f(bf16_t h) { return __uint_as_float(((unsigned)h) << 16); }
DEV unsigned pack2(float lo, float hi) { return (unsigned)f2bf(lo) | ((unsigned)f2bf(hi) << 16); }
DEV float wave_sum(float v) { for (int o = 32; o; o >>= 1) v += __shfl_xor(v, o); return v; }
DEV float wave_max(float v) { for (int o = 32; o; o >>= 1) v = fmaxf(v, __shfl_xor(v, o)); return v; }
DEV float silu_f(float x) { return x / (1.0f + __expf(-x)); }
typedef unsigned u32x4nt __attribute__((ext_vector_type(4)));
typedef float f32x4nt __attribute__((ext_vector_type(4)));
DEV float4 ld_nt4(const float* p) { const f32x4nt v = __builtin_nontemporal_load((const f32x4nt*)p); return make_float4(v.x, v.y, v.z, v.w); }
DEV float ld_nt(const float* p) { return __builtin_nontemporal_load(p); }
DEV void st_nt16(void* p, u32x4nt v) { __builtin_nontemporal_store(v, (u32x4nt*)p); }
DEV uint4 ld_nt16(const void* p) { const u32x4nt v = __builtin_nontemporal_load((const u32x4nt*)p); uint4 r; r.x = v.x; r.y = v.y; r.z = v.z; r.w = v.w; return r; }
template <bool NT> DEV void ld_own8(const float* p, int lane, float4& a0, float4& a1) {
    const float* q = p + 8 * (lane & 31) + 4 * (lane >> 5);
    f32x4nt A, B;
    if (NT) { A = __builtin_nontemporal_load((const f32x4nt*)q); B = __builtin_nontemporal_load((const f32x4nt*)(q + 256)); }
    else { A = *(const f32x4nt*)q; B = *(const f32x4nt*)(q + 256); }
    const auto s0 = __builtin_amdgcn_permlane32_swap(__float_as_uint(A.x), __float_as_uint(B.x), false, false);
    const auto s1 = __builtin_amdgcn_permlane32_swap(__float_as_uint(A.y), __float_as_uint(B.y), false, false);
    const auto s2 = __builtin_amdgcn_permlane32_swap(__float_as_uint(A.z), __float_as_uint(B.z), false, false);
    const auto s3 = __builtin_amdgcn_permlane32_swap(__float_as_uint(A.w), __float_as_uint(B.w), false, false);
    a0 = make_float4(__uint_as_float(s0[0]), __uint_as_float(s1[0]), __uint_as_float(s2[0]), __uint_as_float(s3[0]));
    a1 = make_float4(__uint_as_float(s0[1]), __uint_as_float(s1[1]), __uint_as_float(s2[1]), __uint_as_float(s3[1]));
}
DEV int opaque_tid() { int t = threadIdx.x; asm volatile("" : "+v"(t)); return t; }

#define XB_TMO      128
#define XB_XCNT(j)  (256  + 64 * (j))
#define XB_XSUB(j)  (1280 + 64 * (j))
#define XB_XGEN(j)  (2304 + 64 * (j))
#define XB_TOP      3328
#define XB_TOPGEN   3392
#define XCD_BAR_WORDS 3456
#define XB_SPIN_CAP (1u << 18)

__device__ __forceinline__ unsigned xb_ld(unsigned* p)              { return __hip_atomic_load(p, __ATOMIC_RELAXED, __HIP_MEMORY_SCOPE_AGENT); }
__device__ __forceinline__ unsigned xb_add(unsigned* p, unsigned v) { return __hip_atomic_fetch_add(p, v, __ATOMIC_RELAXED, __HIP_MEMORY_SCOPE_AGENT); }
__device__ __forceinline__ unsigned xb_xcc_id() { return (unsigned)__builtin_amdgcn_s_getreg((3 << 11) | 20) & 0xFu; }
#define XB_SPIN(cond, bar) do { unsigned _sp = 0; while (cond) { __builtin_amdgcn_s_sleep(1); \
    if ((++_sp & 255u) == 0u) { if (xb_ld(&(bar)[XB_TMO])) break; if (_sp > XB_SPIN_CAP) { atomicAdd(&(bar)[XB_TMO], 1u); break; } } } } while (0)

struct XcdBarrier {
    unsigned* bar; unsigned x;
    volatile LAS unsigned* st;
};

__device__ __forceinline__ XcdBarrier xcd_barrier_post(unsigned* bar, volatile LAS unsigned* st) {
    XcdBarrier b; b.bar = bar; b.x = xb_xcc_id(); b.st = st;
    if (threadIdx.x == 0) (void)xb_add(&bar[XB_XCNT(b.x)], 1u);
    return b;
}
__device__ __forceinline__ void xcd_barrier_complete(unsigned* bar, unsigned x, unsigned& nloc, unsigned& nx) {
    const unsigned G = gridDim.x * gridDim.y * gridDim.z;
    unsigned sum, cnt, mine, sp = 0u;
    for (;;) {
        sum = 0u; cnt = 0u; mine = 0u;
#pragma unroll
        for (unsigned j = 0; j < 16; ++j) { const unsigned c = xb_ld(&bar[XB_XCNT(j)]); sum += c; cnt += (c > 0u) ? 1u : 0u; mine = (j == x) ? c : mine; }
        if (sum == G) break;
        __builtin_amdgcn_s_sleep(1);
        if ((++sp & 255u) == 0u) { if (xb_ld(&bar[XB_TMO])) break; if (sp > XB_SPIN_CAP) { atomicAdd(&bar[XB_TMO], 1u); break; } }
    }
    nloc = mine > 0u ? mine : 1u; nx = cnt > 0u ? cnt : 1u;
}

__device__ __forceinline__ void xcd_barrier(const XcdBarrier& b) {
    asm volatile("s_waitcnt vmcnt(0)" ::: "memory");
    __syncthreads();
    if (threadIdx.x == 0) {
        unsigned* bar = b.bar;
        __builtin_amdgcn_s_waitcnt(0);
        unsigned nloc = b.st[0], nx = b.st[1];
        if (nloc == 0u) { xcd_barrier_complete(bar, b.x, nloc, nx); b.st[0] = nloc; b.st[1] = nx; }
        const unsigned old = xb_add(&bar[XB_XSUB(b.x)], 1u);
        const unsigned gen = old / nloc;
        if (old + 1u == (gen + 1u) * nloc) {
            __builtin_amdgcn_fence(__ATOMIC_RELEASE, "agent");
            asm volatile("s_waitcnt vmcnt(0)" ::: "memory");
            const unsigned og = xb_add(&bar[XB_TOP], 1u);
            const unsigned tg = og / nx;
            if (og + 1u == (tg + 1u) * nx) xb_add(&bar[XB_TOPGEN], 1u);
            else XB_SPIN(xb_ld(&bar[XB_TOPGEN]) == tg, bar);
            __builtin_amdgcn_fence(__ATOMIC_ACQUIRE, "agent");
            xb_add(&bar[XB_XGEN(b.x)], 1u);
            asm volatile("s_waitcnt vmcnt(0)" ::: "memory");
        } else {
            XB_SPIN(xb_ld(&bar[XB_XGEN(b.x)]) == gen, bar);
            __builtin_amdgcn_fence(__ATOMIC_ACQUIRE, "agent");
            asm volatile("s_waitcnt vmcnt(0)" ::: "memory");
        }
    }
    __syncthreads();
}

namespace pg8 {
#define PG8_LAS __attribute__((address_space(3)))
typedef short bf16x8 __attribute__((ext_vector_type(8)));
typedef float f32x4 __attribute__((ext_vector_type(4)));
typedef float f32x2 __attribute__((ext_vector_type(2)));
typedef unsigned u32x4 __attribute__((ext_vector_type(4)));
typedef unsigned u32x2 __attribute__((ext_vector_type(2)));
constexpr int BM = 256, BK = 64, HALF = 128, HTB = HALF * BK * 2, STAGE_BYTES = 8 * HTB, NXCD = 8, WGM = 8;
__host__ __device__ __forceinline__ int lds_byte(int r, int c) { const int st = (r >> 4) * 2 + (c >> 5), rr = r & 15, cc = c & 31, ob = rr * 64 + cc * 2; return st * 1024 + (ob ^ (((ob >> 9) & 1) << 5)); }
__host__ __device__ __forceinline__ void stage_rc(int b, int& R, int& C) { const int st = b / 1024, sb = b % 1024, swz = sb ^ (((sb >> 9) & 1) << 5); R = (st >> 1) * 16 + swz / 64; C = (st & 1) * 32 + (swz % 64) / 2; }
__host__ __device__ __forceinline__ int perm32(int rho) { const int n = rho >> 4, i = rho & 15; return 8 * (i >> 2) + 4 * n + (i & 3); }

struct Unit { int pm, pn, pb, ge, gp0, gcnt, ui; };
struct Gemm { const bf16_t* A; const bf16_t* Bt; const int* rowmap; int K; };

struct TileOrder {
    int nM, nN, nwg, G, c, wgm;
    __device__ __forceinline__ void init(int nM_, int nN_, int G_, int c_, int wgm_ = WGM) { nM = nM_; nN = nN_; nwg = nM * nN; G = G_; c = c_; wgm = wgm_; }
    __device__ __forceinline__ bool map(int i, int& pm, int& pn) const {
        const long L = (long)i * G + c; if (L >= nwg) return false;
        int wgid = (int)L; { const int q = nwg / NXCD, r = nwg % NXCD, xcd = wgid % NXCD, off = wgid / NXCD; wgid = (xcd < r ? xcd * (q + 1) : r * (q + 1) + (xcd - r) * q) + off; }
        const int nig = wgm * nN, gid = wgid / nig, fm = gid * wgm, gsz = (nM - fm) < wgm ? (nM - fm) : wgm;
        pm = fm + ((wgid % nig) % gsz); pn = (wgid % nig) / gsz; return true;
    }
};
struct PlainOrder : TileOrder {
    int pb0;
    __device__ __forceinline__ bool next(int i, Unit& u) const { if (!map(i, u.pm, u.pn)) return false; u.pb = pb0 + u.pn; u.ge = 0; u.gp0 = 0; u.gcnt = 0; u.ui = i; return true; }
};
struct MoeOrder : TileOrder {
    const PG8_LAS int* tile_e; const PG8_LAS int* tile_p0; const unsigned* cnt; int tpe; int pm0;
    __device__ __forceinline__ bool next(int i, Unit& u) const { if (!map(i, u.pm, u.pn)) return false; u.pm += pm0;
        const int e = tile_e[u.pm]; u.pb = e * tpe + u.pn; u.ge = e; u.gp0 = tile_p0[u.pm]; u.gcnt = (int)cnt[e * CNT_STRIDE]; u.ui = i; return true; }
};
struct OneOrder {
    int pm, pn, pb;
    __device__ __forceinline__ bool next(int i, Unit& u) const { if (i != 0) return false; u.pm = pm; u.pn = pn; u.pb = pb; u.ge = 0; u.gp0 = 0; u.gcnt = 0; u.ui = 0; return true; }
};

__device__ __forceinline__ unsigned cvt_pk_bf16(float lo, float hi) { unsigned r; asm volatile("v_cvt_pk_bf16_f32 %0, %1, %2" : "=v"(r) : "v"(lo), "v"(hi)); return r; }
__device__ __forceinline__ f32x2 gelu_pk(f32x2 v) {
    const f32x2 av = __builtin_elementwise_abs(v), d = av * 0.2316418882f + 1.0f;
    f32x2 t; t.x = __builtin_amdgcn_rcpf(d.x); t.y = __builtin_amdgcn_rcpf(d.y);
    f32x2 q = t * 0.5307027145f + (-0.7265760135f); q = q * t + 0.7107068705f; q = q * t + (-0.142248368f); q = q * t + 0.127414796f; q = q * t;
    const f32x2 s = (v * v) * (-0.72134752044f);
    f32x2 e; e.x = __builtin_amdgcn_exp2f(s.x); e.y = __builtin_amdgcn_exp2f(s.y);
    const f32x2 m = v * (q * e), r = v - m;
    f32x2 o; o.x = v.x < 0.f ? m.x : r.x; o.y = v.y < 0.f ? m.y : r.y; return o;
}

typedef __bf16 bf16x2v __attribute__((ext_vector_type(2)));
__device__ __forceinline__ unsigned cvt_pk_vis(float lo, float hi) { const f32x2 v = {lo, hi}; return __builtin_bit_cast(unsigned, __builtin_convertvector(v, bf16x2v)); }
__device__ __forceinline__ void store_pair16(bf16_t* dst, u32x2 w0, u32x2 w1, int fq) {
    const auto rx = __builtin_amdgcn_permlane16_swap(w0.x, w1.x, false, false);
    const auto ry = __builtin_amdgcn_permlane16_swap(w0.y, w1.y, false, false);
    u32x4 o; o.x = rx[0]; o.y = ry[0]; o.z = rx[1]; o.w = ry[1];
    *(u32x4*)(dst + ((fq & 1) ? 12 : 0)) = o;
}
struct EpiInProj {
    static constexpr bool PERM = false;
    unsigned char* ws; PG8_LAS unsigned char* ropel; int ctx; int pad;
    __device__ __forceinline__ void operator()(const f32x4 (&acc)[2][2][4][2], const Unit& u, int wr, int wc, int fr, int fq) const {
        const PG8_LAS float* rope = (const PG8_LAS float*)ropel;
        bf16_t* qb = (bf16_t*)(ws + OFF_B); bf16_t* kb = (bf16_t*)(ws + OFF_B + 32 * MiB); bf16_t* vb = (bf16_t*)(ws + OFF_B + 68 * MiB); bf16_t* zb = (bf16_t*)(ws + OFF_A + 64 * MiB);
        const int gc0 = (ctx ? 512 : 0) + u.pn * BM;
#pragma unroll
        for (int ai = 0; ai < 2; ++ai)
#pragma unroll
            for (int m = 0; m < 4; ++m) {
                const int r = u.pm * BM + ai * HALF + wr * 64 + m * 16 + fr;
                size_t krow; int l;
                if (ctx) { krow = (size_t)(r / CTX) * KEYS + L + (r % CTX); l = 0; } else { l = r % L; krow = (size_t)(r / L) * KEYS + l; }
#pragma unroll
                for (int bj = 0; bj < 2; ++bj) {
                    const int gc = gc0 + bj * HALF + wc * 32;
                    const f32x4 a0 = acc[ai][bj][m][0], a1 = acc[ai][bj][m][1];
                    if (gc < 1024) {
                        f32x4 lo = a0, hi = a1;
                        if (!ctx) {
                            const int pos = ((gc >> 5) & 1) ? (l & 63) : (l >> 6);
                            const PG8_LAS float* rp = rope + (pos * 16 + 4 * fq) * 2;
                            const f32x4 c01 = *(const PG8_LAS f32x4*)rp, c23 = *(const PG8_LAS f32x4*)(rp + 4);
                            const float sc = gc < 512 ? 0.125f * 1.4426950408889634f : 1.0f;
                            lo[0] = (a0[0] * c01[0] - a1[0] * c01[1]) * sc; hi[0] = (a1[0] * c01[0] + a0[0] * c01[1]) * sc;
                            lo[1] = (a0[1] * c01[2] - a1[1] * c01[3]) * sc; hi[1] = (a1[1] * c01[2] + a0[1] * c01[3]) * sc;
                            lo[2] = (a0[2] * c23[0] - a1[2] * c23[1]) * sc; hi[2] = (a1[2] * c23[0] + a0[2] * c23[1]) * sc;
                            lo[3] = (a0[3] * c23[2] - a1[3] * c23[3]) * sc; hi[3] = (a1[3] * c23[2] + a0[3] * c23[3]) * sc;
                        }
                        bf16_t* dst;
                        if (gc < 512) dst = qb + (size_t)(gc >> 8) * ((size_t)NTOK * 256) + (size_t)r * 256 + (gc & 255) + 4 * fq;
                        else dst = kb + (size_t)((gc - 512) >> 8) * ((size_t)B * KEYS * 256) + krow * 256 + (gc & 255) + 4 * fq;
                        u32x2 w0, w1; w0.x = cvt_pk_vis(lo[0], lo[1]); w0.y = cvt_pk_vis(lo[2], lo[3]); w1.x = cvt_pk_vis(hi[0], hi[1]); w1.y = cvt_pk_vis(hi[2], hi[3]);
                        store_pair16(dst, w0, w1, fq);
                    } else if (gc < 1536) {
                        bf16_t* dst = vb + krow * 512 + (gc - 1024) + 4 * fq;
                        u32x2 w0, w1; w0.x = cvt_pk_vis(a0[0], a0[1]); w0.y = cvt_pk_vis(a0[2], a0[3]); w1.x = cvt_pk_vis(a1[0], a1[1]); w1.y = cvt_pk_vis(a1[2], a1[3]);
                        store_pair16(dst, w0, w1, fq);
                    } else {
                        bf16_t* dst = zb + (size_t)r * 1024 + (gc - 1536) + 4 * fq;
                        const f32x2 g0 = gelu_pk((f32x2){a0[0], a0[1]}), g1 = gelu_pk((f32x2){a0[2], a0[3]}), g2 = gelu_pk((f32x2){a1[0], a1[1]}), g3 = gelu_pk((f32x2){a1[2], a1[3]});
                        u32x2 w0, w1; w0.x = cvt_pk_vis(g0.x, g0.y); w0.y = cvt_pk_vis(g1.x, g1.y); w1.x = cvt_pk_vis(g2.x, g2.y); w1.y = cvt_pk_vis(g3.x, g3.y);
                        store_pair16(dst, w0, w1, fq);
                    }
                }
            }
    }
};
struct EpiF32 {
    static constexpr bool PERM = false;
    float* O; int ldc; int pad;
    __device__ __forceinline__ void operator()(const f32x4 (&acc)[2][2][4][2], const Unit& u, int wr, int wc, int fr, int fq) const {
#pragma unroll
        for (int ai = 0; ai < 2; ++ai)
#pragma unroll
            for (int m = 0; m < 4; ++m) { float* rowp = O + (size_t)(u.pm * BM + ai * HALF + wr * 64 + m * 16 + fr) * ldc + u.pn * BM + wc * 32 + 4 * fq;
#pragma unroll
                for (int bj = 0; bj < 2; ++bj)
#pragma unroll
                    for (int n = 0; n < 2; ++n) *(f32x4*)(rowp + bj * HALF + 16 * n) = acc[ai][bj][m][n]; }
    }
};
struct EpiGateUp {
    static constexpr bool PERM = true;
    bf16_t* O; unsigned* sdone; int pub_ui; int pub_n;
    __device__ __forceinline__ void operator()(const f32x4 (&acc)[2][2][4][2], const Unit& u, int wr, int wc, int fr, int fq) const {
        store(acc, u, wr, wc, fr, fq);
        if (u.ui == pub_ui) {
            asm volatile("s_waitcnt vmcnt(0)" ::: "memory"); __builtin_amdgcn_s_barrier();
            if (threadIdx.x == 0) { __builtin_amdgcn_fence(__ATOMIC_RELEASE, "agent"); asm volatile("s_waitcnt vmcnt(0)" ::: "memory"); (void)xb_add(sdone, (unsigned)pub_n); }
        }
    }
    __device__ __forceinline__ void store(const f32x4 (&acc)[2][2][4][2], const Unit& u, int wr, int wc, int fr, int fq) const {
#pragma unroll
        for (int ai = 0; ai < 2; ++ai)
#pragma unroll
            for (int m = 0; m < 4; ++m) { bf16_t* dst = O + (size_t)(u.pm * BM + ai * HALF + wr * 64 + m * 16 + fr) * D + u.pn * HALF + wc * 32 + 8 * fq;
                float h[8];
#pragma unroll
                for (int n = 0; n < 2; ++n)
#pragma unroll
                    for (int j = 0; j < 4; ++j) { const float g = acc[ai][0][m][n][j], up = acc[ai][1][m][n][j]; h[4 * n + j] = g * __builtin_amdgcn_rcpf(1.0f + __expf(-g)) * up; }
                u32x4 w; w.x = cvt_pk_bf16(h[0], h[1]); w.y = cvt_pk_bf16(h[2], h[3]); w.z = cvt_pk_bf16(h[4], h[5]); w.w = cvt_pk_bf16(h[6], h[7]);
                *(u32x4*)dst = w; }
    }
};
struct EpiBf16 {
    static constexpr bool PERM = true;
    bf16_t* O; int ldc; int pad;
    __device__ __forceinline__ void operator()(const f32x4 (&acc)[2][2][4][2], const Unit& u, int wr, int wc, int fr, int fq) const {
#pragma unroll
        for (int ai = 0; ai < 2; ++ai)
#pragma unroll
            for (int m = 0; m < 4; ++m) { bf16_t* rowp = O + (size_t)(u.pm * BM + ai * HALF + wr * 64 + m * 16 + fr) * ldc + u.pn * BM + wc * 32 + 8 * fq;
#pragma unroll
                for (int bj = 0; bj < 2; ++bj) { const f32x4 v0 = acc[ai][bj][m][0], v1 = acc[ai][bj][m][1];
                    u32x4 w; w.x = cvt_pk_bf16(v0[0], v0[1]); w.y = cvt_pk_bf16(v0[2], v0[3]); w.z = cvt_pk_bf16(v1[0], v1[1]); w.w = cvt_pk_bf16(v1[2], v1[3]);
                    *(u32x4*)(rowp + bj * HALF) = w; } }
    }
};

template <class Epi, class Sched, bool GATHER>
__device__ __forceinline__ void gemm_phase(PG8_LAS unsigned char* lds, const Gemm g, const Sched& S, const Epi& E) {
    const int tid = opaque_tid(), wid = __builtin_amdgcn_readfirstlane(tid >> 6), lane = tid & 63, wr = wid >> 2, wc = wid & 3, fr = lane & 15, fq = lane >> 4;
    const int K = g.K, nt = K / BK;
    int RA[2]; unsigned colA[2], voffB[2];
#pragma unroll
    for (int i = 0; i < 2; ++i) { int R, C; stage_rc(tid * 16 + i * 8192, R, C); const int Rb = Epi::PERM ? ((R & ~31) + perm32(R & 31)) : R;
        RA[i] = R; colA[i] = (unsigned)C * 2u; voffB[i] = (unsigned)(Rb * K + C) * 2u; }
    const size_t kstep = (size_t)(BK * 2);
    const size_t hstep = (size_t)HALF * K * 2;
    const size_t tstep = 2 * hstep;
    const unsigned ldsw = (unsigned)wid * 1024u;
    const int aoff = lds_byte(wr * 64 + fr, fq * 8), boff = lds_byte(wc * 32 + fr, fq * 8);
#define PG8_AOFF(u, off) do { _Pragma("unroll") for (int _h = 0; _h < 2; ++_h) _Pragma("unroll") for (int _i = 0; _i < 2; ++_i) { \
        int _row = (u).pm * BM + _h * HALF + RA[_i]; if (GATHER) { const int _pos = (u).gp0 + _h * HALF + RA[_i]; _row = _pos < (u).gcnt ? g.rowmap[(u).ge * NTOK + _pos] : 0; } \
        (off)[_h][_i] = (unsigned)_row * (unsigned)(K * 2) + colA[_i]; } } while (0)
#define PG8_SA(b, h) (((b) * 2 + (h)) * HTB)
#define PG8_SB(b, h) ((4 + (b) * 2 + (h)) * HTB)
#define PG8_STAGE(bufoff, gbase, voff) do { _Pragma("unroll") for (int _i = 0; _i < 2; ++_i) \
        __builtin_amdgcn_global_load_lds((const unsigned*)((const char*)(gbase) + (voff)[_i]), (PG8_LAS unsigned*)(lds + (bufoff) + ldsw + _i * 8192), 16, 0, 0); } while (0)
#define PG8_LDA(dst, b, h) do { _Pragma("unroll") for (int m = 0; m < 4; ++m) _Pragma("unroll") for (int k = 0; k < 2; ++k) dst[m][k] = *(const PG8_LAS bf16x8*)(lds + PG8_SA(b, h) + aoff + m * 2048 + k * 1024); } while (0)
#define PG8_LDB(dst, b, h) do { _Pragma("unroll") for (int n = 0; n < 2; ++n) _Pragma("unroll") for (int k = 0; k < 2; ++k) dst[n][k] = *(const PG8_LAS bf16x8*)(lds + PG8_SB(b, h) + boff + n * 2048 + k * 1024); } while (0)
#define PG8_MMA(ai, bj, At, Bt) do { __builtin_amdgcn_s_setprio(1); _Pragma("unroll") for (int m = 0; m < 4; ++m) _Pragma("unroll") for (int n = 0; n < 2; ++n) _Pragma("unroll") for (int k = 0; k < 2; ++k) \
        acc[ai][bj][m][n] = __builtin_amdgcn_mfma_f32_16x16x32_bf16(Bt[n][k], At[m][k], acc[ai][bj][m][n], 0, 0, 0); __builtin_amdgcn_s_setprio(0); } while (0)
#define PG8_WAIT_V(n) asm volatile("s_waitcnt vmcnt(" #n ")" ::: "memory")
#define PG8_WAIT_L(n) asm volatile("s_waitcnt lgkmcnt(" #n ")" ::: "memory")
#define PG8_BAR __builtin_amdgcn_s_barrier()
#define PG8_SCHED __builtin_amdgcn_sched_barrier(0)
    Unit cur, nxt; int ui = 0;
    if (!S.next(0, cur)) return;
    f32x4 acc[2][2][4][2];
#pragma unroll
    for (int a = 0; a < 2; ++a)
#pragma unroll
        for (int b = 0; b < 2; ++b)
#pragma unroll
            for (int m = 0; m < 4; ++m)
#pragma unroll
                for (int n = 0; n < 2; ++n) acc[a][b][m][n] = (f32x4){0.f, 0.f, 0.f, 0.f};
    bf16x8 At[4][2], B0[2][2], B1[2][2];
    const char* Ab = (const char*)g.A;
    unsigned offc[2][2], offn[2][2];
    PG8_AOFF(cur, offc);
    const char* cB = (const char*)g.Bt + (size_t)cur.pb * tstep;
    PG8_STAGE(PG8_SB(0, 0), cB, voffB); PG8_STAGE(PG8_SB(0, 1), cB + hstep, voffB); PG8_STAGE(PG8_SA(0, 0), Ab, offc[0]); PG8_STAGE(PG8_SA(0, 1), Ab, offc[1]);
    if (wr == 1) PG8_BAR;
    PG8_WAIT_V(2); PG8_BAR;
    PG8_STAGE(PG8_SB(1, 0), cB + kstep, voffB); PG8_STAGE(PG8_SA(1, 0), Ab + kstep, offc[0]); PG8_STAGE(PG8_SB(1, 1), cB + hstep + kstep, voffB);
    PG8_WAIT_V(6); PG8_BAR;
    for (;;) {
        const bool has_next = S.next(ui + 1, nxt);
        if (has_next) { PG8_AOFF(nxt, offn); }
        else {
#pragma unroll
            for (int h = 0; h < 2; ++h)
#pragma unroll
                for (int i = 0; i < 2; ++i) offn[h][i] = offc[h][i];
        }
        const char* nB = has_next ? (const char*)g.Bt + (size_t)nxt.pb * tstep : cB;
        for (int t = 0; t < nt; t += 2) {
            const bool last = (t == nt - 2);
            const char* a1 = Ab + (size_t)(t + 1) * kstep;
            const char* a2 = Ab + (last ? (size_t)0 : (size_t)(t + 2) * kstep); const char* b2 = last ? nB : cB + (size_t)(t + 2) * kstep;
            const char* a3 = a2 + kstep; const char* b3 = b2 + kstep;
            unsigned o2[2][2];
#pragma unroll
            for (int h = 0; h < 2; ++h)
#pragma unroll
                for (int i = 0; i < 2; ++i) o2[h][i] = last ? offn[h][i] : offc[h][i];
            PG8_LDB(B0, 0, 0); PG8_LDB(B1, 0, 1); PG8_SCHED; PG8_LDA(At, 0, 0); PG8_STAGE(PG8_SA(1, 1), a1, offc[1]);
            PG8_WAIT_V(8); PG8_WAIT_L(0); PG8_BAR; PG8_MMA(0, 0, At, B0); PG8_MMA(0, 1, At, B1); PG8_BAR; PG8_SCHED;
            PG8_LDA(At, 0, 1); PG8_STAGE(PG8_SB(0, 0), b2, voffB); PG8_STAGE(PG8_SB(0, 1), b2 + hstep, voffB); PG8_STAGE(PG8_SA(0, 0), a2, o2[0]);
            PG8_WAIT_V(8); PG8_WAIT_L(0); PG8_BAR; PG8_MMA(1, 0, At, B0); PG8_MMA(1, 1, At, B1); PG8_BAR; PG8_SCHED;
            PG8_LDB(B0, 1, 0); PG8_LDB(B1, 1, 1); PG8_SCHED; PG8_LDA(At, 1, 0); PG8_STAGE(PG8_SA(0, 1), a2, o2[1]);
            PG8_WAIT_V(8); PG8_WAIT_L(0); PG8_BAR; PG8_MMA(0, 0, At, B0); PG8_MMA(0, 1, At, B1); PG8_BAR; PG8_SCHED;
            PG8_LDA(At, 1, 1); PG8_STAGE(PG8_SB(1, 0), b3, voffB); PG8_STAGE(PG8_SB(1, 1), b3 + hstep, voffB); PG8_STAGE(PG8_SA(1, 0), a3, o2[0]);
            PG8_WAIT_V(8); PG8_WAIT_L(0); PG8_BAR; PG8_MMA(1, 0, At, B0); PG8_MMA(1, 1, At, B1); PG8_BAR; PG8_SCHED;
        }
        if (wr == 0) PG8_BAR;
        E(acc, cur, wr, wc, fr, fq);
        if (!has_next) break;
#pragma unroll
        for (int a = 0; a < 2; ++a)
#pragma unroll
            for (int b = 0; b < 2; ++b)
#pragma unroll
                for (int m = 0; m < 4; ++m)
#pragma unroll
                    for (int n = 0; n < 2; ++n) acc[a][b][m][n] = (f32x4){0.f, 0.f, 0.f, 0.f};
        cur = nxt; cB = nB; ++ui;
#pragma unroll
        for (int h = 0; h < 2; ++h)
#pragma unroll
            for (int i = 0; i < 2; ++i) offc[h][i] = offn[h][i];
        if (wr == 1) PG8_BAR;
    }
    PG8_WAIT_V(0);
    PG8_BAR;
#undef PG8_AOFF
#undef PG8_SA
#undef PG8_SB
#undef PG8_STAGE
#undef PG8_LDA
#undef PG8_LDB
#undef PG8_MMA
#undef PG8_WAIT_V
#undef PG8_WAIT_L
#undef PG8_BAR
#undef PG8_SCHED
}
}


struct Params { const float* in[28]; float* out; unsigned char* ws; };
enum { I_X = 0, I_C, I_CTX, I_CCTX, I_WMOD, I_BMOD, I_WIN, I_LQ1, I_LK1, I_LQ2, I_LK2, I_SUBG, I_SGLNG, I_SGLNB, I_SGW, I_SGB, I_WOUT, I_LN1G, I_LN1B,
       I_RGW, I_RGB, I_REW, I_REB, I_EWG, I_EWU, I_EWD, I_LN2G, I_LN2B };

DEV void phase_prep(const Params& p) {
    const int tidx = opaque_tid();
    float* rope = (float*)(p.ws + OFF_ROPE);
    for (int t = tidx; t < 1024; t += blockDim.x) {
        const int pos = t >> 4, j = t & 15;
        const float inv = powf(10000.0f, -(float)j / 16.0f);
        const float ang = (float)pos * inv;
        rope[2 * t] = cosf(ang); rope[2 * t + 1] = sinf(ang);
    }
    if (tidx < 64) {
        const int l = tidx;
        const float a = wave_sum(p.in[I_LQ1][l] * p.in[I_LK1][l]), b = wave_sum(p.in[I_LQ2][l] * p.in[I_LK2][l]);
        if (l == 0) *(float*)(p.ws + OFF_LAM) = expf(a) - expf(b) + LAM_INIT;
    }
}
DEV void phase_mod(const Params& p, unsigned char* lds) {
    const int tidx = opaque_tid();
    if ((int)blockIdx.x >= 192) return;
    float* sv = (float*)lds; float* red = sv + 17 * 1024;
    const float* c = p.in[I_C]; const float* c_ctx = p.in[I_CCTX]; const float* w_mod = p.in[I_WMOD]; const float* b_mod = p.in[I_BMOD];
    if (blockDim.x == 512) {
        float cv[34];
#pragma unroll
        for (int j = 0; j < 34; ++j) { const int i = tidx + 512 * j; cv[j] = i < 16384 ? c[i] : c_ctx[i - 16384]; }
#pragma unroll
        for (int j = 0; j < 34; ++j) sv[tidx + 512 * j] = silu_f(cv[j]);
    } else
        for (int i = tidx; i < 17 * 1024; i += blockDim.x) { const float v = i < 16384 ? c[i] : c_ctx[i - 16384]; sv[i] = silu_f(v); }
    __syncthreads();
    float* mod = (float*)(p.ws + OFF_MOD);
    const int col = tidx & 31, kg = tidx >> 5, nkg = blockDim.x >> 5, dper = 1024 / nkg;
    for (int u = blockIdx.x; u < 192; u += gridDim.x) {
        const int e = u * 32 + col;
        float acc[17];
#pragma unroll
        for (int r = 0; r < 17; ++r) acc[r] = 0.f;
        for (int d0 = kg * dper; d0 < (kg + 1) * dper; d0 += 16) {
            float w[16];
#pragma unroll
            for (int j = 0; j < 16; ++j) w[j] = w_mod[(size_t)(d0 + j) * 6144 + e];
#pragma unroll
            for (int j = 0; j < 16; ++j)
#pragma unroll
                for (int r = 0; r < 17; ++r) acc[r] += sv[r * 1024 + d0 + j] * w[j];
        }
#pragma unroll
        for (int r = 0; r < 17; ++r) red[(kg * 17 + r) * 32 + col] = acc[r];
        __syncthreads();
        for (int i = tidx; i < 17 * 32; i += blockDim.x) {
            const int r = i >> 5, cc = i & 31; float s = 0.f;
            for (int g = 0; g < nkg; ++g) s += red[(g * 17 + r) * 32 + cc];
            mod[r * 6144 + u * 32 + cc] = s + b_mod[u * 32 + cc];
        }
        __syncthreads();
    }
}
struct ConvTile { const float* W; bf16_t* WT; int N, r0, k0, n0; };
DEV void phase_conv(const Params& p, LAS unsigned char* lds, int r_lo, int r_hi, bool last) {
    const int tidx = opaque_tid();
    const int tid = opaque_tid(), wave = __builtin_amdgcn_readfirstlane(tid >> 6), lane = tid & 63, h = lane >> 5, c = lane & 31;
    unsigned char* ws = p.ws;
    bf16_t* WinT = (bf16_t*)(ws + OFF_WIN); bf16_t* WoutT = (bf16_t*)(ws + OFF_WOUT); bf16_t* SgW = (bf16_t*)(ws + OFF_SGW);
    bf16_t* WguT = (bf16_t*)(ws + OFF_WGU); bf16_t* WdT = (bf16_t*)(ws + OFF_WD);
    constexpr int T_IN = 8 * 20, T_OUT = 8 * 8, T_E = 8 * 8, TOT = T_IN + T_OUT + 3 * NE * T_E;
    auto decode = [&](int t) -> ConvTile {
        if (t < T_IN) return ConvTile{p.in[I_WIN], WinT, 2560, (t % 20) * 128, (t / 20) * 128, (t % 20) * 128};
        t -= T_IN;
        if (t < T_OUT) return ConvTile{p.in[I_WOUT], WoutT, 1024, (t % 8) * 128, (t / 8) * 128, (t % 8) * 128};
        t -= T_OUT;
        const int mi = t / T_E, item = t % T_E, which = mi / NE, e = mi % NE, kb = item / 8, nb = item % 8;
        if (which == 0) return ConvTile{p.in[I_EWG] + (size_t)e * 1048576, WguT + (size_t)e * 2048 * 1024, 1024, nb * 256, kb * 128, nb * 128};
        if (which == 1) return ConvTile{p.in[I_EWU] + (size_t)e * 1048576, WguT + (size_t)e * 2048 * 1024, 1024, 128 + nb * 256, kb * 128, nb * 128};
        return ConvTile{p.in[I_EWD] + (size_t)e * 1048576, WdT + (size_t)e * 1024 * 1024, 1024, nb * 128, kb * 128, nb * 128};
    };
    f32x4nt ld[8];
#define CV_LOAD(d_) do { const float* s_ = (d_).W + (size_t)((d_).k0 + 16 * wave + 8 * h) * (d_).N + (d_).n0 + 4 * c; \
        _Pragma("unroll") for (int i_ = 0; i_ < 8; ++i_) ld[i_] = __builtin_nontemporal_load((const f32x4nt*)(s_ + (size_t)i_ * (d_).N)); } while (0)
    const int t_end = (r_hi >= (1 << 16)) ? TOT : ((int)blockIdx.x + r_hi * (int)gridDim.x < TOT ? (int)blockIdx.x + r_hi * (int)gridDim.x : TOT);
    int t = blockIdx.x + r_lo * gridDim.x, buf = 0;
    ConvTile d = decode(t < t_end ? t : 0);
    if (t < t_end) CV_LOAD(d);
    for (; t < t_end; t += gridDim.x) {
        LAS unsigned char* img = lds + buf * 32768;
#pragma unroll
        for (int m = 0; m < 2; ++m)
#pragma unroll
            for (int q = 0; q < 4; ++q) {
                pg8::u32x2 w; w.x = pack2(ld[4 * m + 0][q], ld[4 * m + 1][q]); w.y = pack2(ld[4 * m + 2][q], ld[4 * m + 3][q]);
                *(LAS pg8::u32x2*)(img + (4 * c + q) * 256 + (((2 * wave + h) ^ (c & 15)) << 4) + 8 * m) = w;
            }
        const ConvTile cur = d;
        const int tn = t + (int)gridDim.x;
        if (tn < t_end) { d = decode(tn); CV_LOAD(d); }
        asm volatile("s_waitcnt lgkmcnt(0)" ::: "memory"); __builtin_amdgcn_s_barrier(); asm volatile("" ::: "memory");
#pragma unroll
        for (int j = 0; j < 4; ++j) {
            const int n = 16 * wave + 4 * j + (lane >> 4), gl = lane & 15;
            const pg8::u32x4 v = *(const LAS pg8::u32x4*)(img + n * 256 + ((gl ^ ((n >> 2) & 15)) << 4));
            st_nt16(cur.WT + (size_t)(cur.r0 + n) * 1024 + cur.k0 + 8 * gl, (u32x4nt){v.x, v.y, v.z, v.w});
        }
        buf ^= 1;
    }
#undef CV_LOAD
    asm volatile("s_waitcnt lgkmcnt(0)" ::: "memory"); __builtin_amdgcn_s_barrier(); asm volatile("" ::: "memory");
    if (!last) return;
    const float* sg_w = p.in[I_SGW];
    for (int i = blockIdx.x * blockDim.x + tidx; i < 65536 / 8; i += gridDim.x * blockDim.x) {
        const int g = i >> 11, pr = (i >> 4) & 127, q0 = (i & 15) * 8;
        const float4 v0 = *(const float4*)(sg_w + (size_t)(g * 128 + pr) * 128 + q0), v1 = *(const float4*)(sg_w + (size_t)(g * 128 + pr) * 128 + q0 + 4);
        uint4 o; o.x = pack2(v0.x, v0.y); o.y = pack2(v0.z, v0.w); o.z = pack2(v1.x, v1.y); o.w = pack2(v1.z, v1.w);
        const int ks = q0 >> 4, h2 = (q0 >> 3) & 1, lane = h2 * 32 + (pr & 31);
        *(uint4*)(SgW + ((size_t)(((g * 4 + (pr >> 5)) * 8 + ks) * 64 + lane)) * 8) = o;
    }
    { const float* wgr = p.in[I_RGW]; const float* wer = p.in[I_REW];
      bf16_t* rhi = (bf16_t*)(ws + OFF_RTW); bf16_t* rlo = rhi + 8 * 3 * 4 * 64 * 8;
      for (int i = blockIdx.x * blockDim.x + tidx; i < 8 * 3 * 4 * 64; i += gridDim.x * blockDim.x) {
          const int ln = i & 63, s = (i >> 6) & 3, nt = (i >> 8) % 3, wv = i / 768, n = 16 * nt + (ln & 15);
          unsigned hh[4], ll[4];
#pragma unroll
          for (int j2 = 0; j2 < 4; ++j2) { bf16_t h2v[2], l2v[2];
#pragma unroll
              for (int e = 0; e < 2; ++e) { const int k = 128 * wv + 32 * s + 8 * (ln >> 4) + 2 * j2 + e;
                  const float w = n < 4 ? wgr[k * 4 + n] : (n < 36 ? wer[k * 32 + (n - 4)] : 0.f);
                  h2v[e] = f2bf(w); l2v[e] = f2bf(w - bf2f(h2v[e])); }
              hh[j2] = (unsigned)h2v[0] | ((unsigned)h2v[1] << 16); ll[j2] = (unsigned)l2v[0] | ((unsigned)l2v[1] << 16); }
          uint4 oh, ol; oh.x = hh[0]; oh.y = hh[1]; oh.z = hh[2]; oh.w = hh[3]; ol.x = ll[0]; ol.y = ll[1]; ol.z = ll[2]; ol.w = ll[3];
          *(uint4*)(rhi + (size_t)i * 8) = oh; *(uint4*)(rlo + (size_t)i * 8) = ol;
      } }
}
DEV void unpack8(const uint4& r, float (&v)[8]) {
    v[0] = bf2f((bf16_t)(r.x & 0xffff)); v[1] = bf2f((bf16_t)(r.x >> 16)); v[2] = bf2f((bf16_t)(r.y & 0xffff)); v[3] = bf2f((bf16_t)(r.y >> 16));
    v[4] = bf2f((bf16_t)(r.z & 0xffff)); v[5] = bf2f((bf16_t)(r.z >> 16)); v[6] = bf2f((bf16_t)(r.w & 0xffff)); v[7] = bf2f((bf16_t)(r.w >> 16));
}
DEV void modulate_rows(const float* src, bf16_t* dst, const float* m, int row_lo, int nrows, int wid, int lane, int nw) {
    float sh[2][8], sc[2][8];
#pragma unroll
    for (int i = 0; i < 2; ++i)
#pragma unroll
        for (int j = 0; j < 8; ++j) { sh[i][j] = m[8 * lane + 512 * i + j]; sc[i][j] = 1.0f + m[1024 + 8 * lane + 512 * i + j]; }
    for (int r = wid; r < nrows; r += 2 * nw) {
        float4 a[2][2][2]; bool ok[2];
#pragma unroll
        for (int u = 0; u < 2; ++u) { const int rr = r + u * nw; ok[u] = rr < nrows; const float* s = src + (size_t)(row_lo + (ok[u] ? rr : r)) * D + 8 * lane;
#pragma unroll
            for (int i = 0; i < 2; ++i) { a[u][i][0] = *(const float4*)(s + 512 * i); a[u][i][1] = *(const float4*)(s + 512 * i + 4); } }
#pragma unroll
        for (int u = 0; u < 2; ++u) if (ok[u]) { bf16_t* d = dst + (size_t)(row_lo + r + u * nw) * D + 8 * lane;
#pragma unroll
            for (int i = 0; i < 2; ++i) { const float4 x0 = a[u][i][0], x1 = a[u][i][1]; uint4 o;
                o.x = pack2(x0.x * sc[i][0] + sh[i][0], x0.y * sc[i][1] + sh[i][1]); o.y = pack2(x0.z * sc[i][2] + sh[i][2], x0.w * sc[i][3] + sh[i][3]);
                o.z = pack2(x1.x * sc[i][4] + sh[i][4], x1.y * sc[i][5] + sh[i][5]); o.w = pack2(x1.z * sc[i][6] + sh[i][6], x1.w * sc[i][7] + sh[i][7]);
                *(uint4*)(d + 512 * i) = o; } }
    }
}
DEV void phase_modulate_ctx(const Params& p) {
    const int tidx = opaque_tid(), wid = tidx >> 6, lane = tidx & 63, nw = blockDim.x >> 6;
    const float* mod = (const float*)(p.ws + OFF_MOD); bf16_t* hc = (bf16_t*)(p.ws + OFF_A + 128 * MiB);
    for (int panel = blockIdx.x; panel < NCTX / 16; panel += gridDim.x) modulate_rows(p.in[I_CTX], hc, mod + 16 * 6144, panel * 16, 16, wid, lane, nw);
}
DEV void phase_modulate_x(const Params& p, LAS unsigned char* lds) {
    const int tidx = opaque_tid(), lane = tidx & 63;
    const float* mod = (const float*)(p.ws + OFF_MOD); const float* src = p.in[I_X];
    bf16_t* h = (bf16_t*)(p.ws + OFF_A);
    LAS unsigned* ticket = (LAS unsigned*)(lds + MISC_OFF + 72);
    const int G = (int)gridDim.x, skip = G > 64 ? 64 : 0, nwork = G - skip, widx = (int)blockIdx.x - skip;
    if (widx < 0) return;
    const int quad_lo = (int)(((long)widx * (NTOK / 4)) / nwork), quad_hi = (int)(((long)(widx + 1) * (NTOK / 4)) / nwork);
    int curb = -1;
    float sh[2][8], sc[2][8];
    for (;;) {
        unsigned tk = 0; if (lane == 0) tk = __hip_atomic_fetch_add(ticket, 1u, __ATOMIC_RELAXED, __HIP_MEMORY_SCOPE_WORKGROUP);
        const int t = __builtin_amdgcn_readfirstlane((int)tk);
        if (t >= quad_hi - quad_lo) break;
        const int row = 4 * (quad_lo + t), b = row / L;
        float4 a[4][2][2];
#pragma unroll
        for (int u = 0; u < 4; ++u) { const float* s = src + (size_t)(row + u) * D;
#pragma unroll
            for (int i = 0; i < 2; ++i) ld_own8<true>(s + 512 * i, lane, a[u][i][0], a[u][i][1]); }
        if (b != curb) { curb = b; const float* m = mod + b * 6144;
#pragma unroll
            for (int i = 0; i < 2; ++i)
#pragma unroll
                for (int j = 0; j < 8; ++j) { sh[i][j] = m[8 * lane + 512 * i + j]; sc[i][j] = 1.0f + m[1024 + 8 * lane + 512 * i + j]; } }
#pragma unroll
        for (int u = 0; u < 4; ++u) { bf16_t* d = h + (size_t)(row + u) * D + 8 * lane;
#pragma unroll
            for (int i = 0; i < 2; ++i) { const float4 x0 = a[u][i][0], x1 = a[u][i][1]; uint4 o;
                o.x = pack2(x0.x * sc[i][0] + sh[i][0], x0.y * sc[i][1] + sh[i][1]); o.y = pack2(x0.z * sc[i][2] + sh[i][2], x0.w * sc[i][3] + sh[i][3]);
                o.z = pack2(x1.x * sc[i][4] + sh[i][4], x1.y * sc[i][5] + sh[i][5]); o.w = pack2(x1.z * sc[i][6] + sh[i][6], x1.w * sc[i][7] + sh[i][7]);
                *(uint4*)(d + 512 * i) = o; } }
    }
}
DEV int moe_early_tiles(int Mt, int G) {
    const int R = (8 * Mt) % G, Rd = (4 * Mt) % G;
    return (R > 0 && Rd > 0 && Rd <= G - R && (Rd & 3) == 0 && Rd <= 4 * 128 && Rd <= 4 * Mt) ? Rd / 4 : 0;
}
DEV void moe_tables(const Params& p, LAS unsigned char* lds) {
    const int tidx = opaque_tid();
    if (tidx < 64) {
        const unsigned* cnt = (const unsigned*)(p.ws + OFF_CTL) + CW_CNT;
        LAS int* tile_e = (LAS int*)(lds + MOE_TE); LAS int* tile_p0 = (LAS int*)(lds + MOE_TP); LAS int* base = (LAS int*)(lds + MOE_BASE);
        const int e = tidx & 31, nt = tidx < 32 ? (int)((cnt[e * CNT_STRIDE] + 255u) >> 8) : 0;
        int incl = nt;
        for (int o = 1; o < 32; o <<= 1) { const int v = __shfl_up(incl, o); if ((tidx & 63) >= o) incl += v; }
        if (tidx < 32) {
            const int t0 = incl - nt;
            base[e] = t0 * 256;
            for (int i = 0; i < nt; ++i) { tile_e[t0 + i] = e; tile_p0[t0 + i] = i * 256; }
            if (tidx == 31) tile_e[MAXT] = incl;
        }
    }
    asm volatile("s_waitcnt lgkmcnt(0)" ::: "memory"); __syncthreads();
}
DEV void phase_final(const Params& p, LAS unsigned char* lds) {
    const int tidx = opaque_tid(), wid = __builtin_amdgcn_readfirstlane(tidx >> 6), lane = tidx & 63, nw = blockDim.x >> 6;
    float* out = p.out; unsigned char* ws = p.ws;
    const float* mod = (const float*)(ws + OFF_MOD); const bf16_t* y2 = (const bf16_t*)(ws + OFF_Y2); const bf16_t* x1b = (const bf16_t*)(ws + OFF_B);
    const int* tok_e = (const int*)(ws + OFF_TOKE); const int* tok_p = (const int*)(ws + OFF_TOKP); const float* tok_w = (const float*)(ws + OFF_TOKW);
    const LAS int* base = (const LAS int*)(lds + MOE_BASE);
    const bf16_t* y2e = (const bf16_t*)(ws + OFF_Y2E); const int early_rows = 256 * moe_early_tiles(((const LAS int*)(lds + MOE_TE))[MAXT], (int)gridDim.x);
    float lg[2][8], lb[2][8];
#pragma unroll
    for (int i = 0; i < 2; ++i)
#pragma unroll
        for (int j = 0; j < 8; ++j) { lg[i][j] = p.in[I_LN2G][8 * lane + 512 * i + j]; lb[i][j] = p.in[I_LN2B][8 * lane + 512 * i + j]; }
    for (int panel = blockIdx.x; panel < NTOK / 128; panel += gridDim.x) {
        const float* m = mod + (panel * 128 / L) * 6144 + 5120;
        float g2[2][8];
#pragma unroll
        for (int i = 0; i < 2; ++i)
#pragma unroll
            for (int j = 0; j < 8; ++j) g2[i][j] = m[8 * lane + 512 * i + j];
        for (int r = wid; r < 128; r += 2 * nw) {
            float v[2][16]; float mu[2], rstd[2];
#pragma unroll
            for (int u = 0; u < 2; ++u) {
                const int row = panel * 128 + r + u * nw;
                const int s0 = base[tok_e[row * 2]] + tok_p[row * 2], s1 = base[tok_e[row * 2 + 1]] + tok_p[row * 2 + 1]; const float w0 = tok_w[row * 2], w1 = tok_w[row * 2 + 1];
                float s = 0.f;
#pragma unroll
                for (int i = 0; i < 2; ++i) {
                    const int c = 8 * lane + 512 * i;
                    float xa[8], ya[8], yb[8];
                    unpack8(ld_nt16(x1b + (size_t)row * D + c), xa); unpack8(ld_nt16((s0 < early_rows ? y2e : y2) + (size_t)s0 * D + c), ya); unpack8(ld_nt16((s1 < early_rows ? y2e : y2) + (size_t)s1 * D + c), yb);
#pragma unroll
                    for (int j = 0; j < 8; ++j) { const float val = ALPHA * xa[j] + g2[i][j] * (w0 * ya[j] + w1 * yb[j]); v[u][8 * i + j] = val; s += val; }
                }
                mu[u] = s;
            }
#pragma unroll
            for (int u = 0; u < 2; ++u) {
                mu[u] = wave_sum(mu[u]) * (1.0f / 1024.0f);
                float q = 0.f;
#pragma unroll
                for (int j = 0; j < 16; ++j) { const float d = v[u][j] - mu[u]; q += d * d; }
                rstd[u] = rsqrtf(wave_sum(q) * (1.0f / 1024.0f) + EPS);
            }
#pragma unroll
            for (int u = 0; u < 2; ++u) {
                float* orow = out + (size_t)(panel * 128 + r + u * nw) * D + 8 * lane;
#pragma unroll
                for (int i = 0; i < 2; ++i) {
                    float4 o0, o1;
                    o0.x = (v[u][8 * i + 0] - mu[u]) * rstd[u] * lg[i][0] + lb[i][0]; o0.y = (v[u][8 * i + 1] - mu[u]) * rstd[u] * lg[i][1] + lb[i][1];
                    o0.z = (v[u][8 * i + 2] - mu[u]) * rstd[u] * lg[i][2] + lb[i][2]; o0.w = (v[u][8 * i + 3] - mu[u]) * rstd[u] * lg[i][3] + lb[i][3];
                    o1.x = (v[u][8 * i + 4] - mu[u]) * rstd[u] * lg[i][4] + lb[i][4]; o1.y = (v[u][8 * i + 5] - mu[u]) * rstd[u] * lg[i][5] + lb[i][5];
                    o1.z = (v[u][8 * i + 6] - mu[u]) * rstd[u] * lg[i][6] + lb[i][6]; o1.w = (v[u][8 * i + 7] - mu[u]) * rstd[u] * lg[i][7] + lb[i][7];
                    { const auto s0_ = __builtin_amdgcn_permlane32_swap(__float_as_uint(o0.x), __float_as_uint(o1.x), false, false);
                      const auto s1_ = __builtin_amdgcn_permlane32_swap(__float_as_uint(o0.y), __float_as_uint(o1.y), false, false);
                      const auto s2_ = __builtin_amdgcn_permlane32_swap(__float_as_uint(o0.z), __float_as_uint(o1.z), false, false);
                      const auto s3_ = __builtin_amdgcn_permlane32_swap(__float_as_uint(o0.w), __float_as_uint(o1.w), false, false);
                      float* ob = out + (size_t)(panel * 128 + r + u * nw) * D + 512 * i + 8 * (lane & 31) + 4 * (lane >> 5);
                      pg8::u32x4 wa, wb; wa.x = s0_[0]; wa.y = s1_[0]; wa.z = s2_[0]; wa.w = s3_[0]; wb.x = s0_[1]; wb.y = s1_[1]; wb.z = s2_[1]; wb.w = s3_[1];
                      *(pg8::u32x4*)ob = wa; *(pg8::u32x4*)(ob + 256) = wb; }
                }
            }
        }
    }
}

namespace att {
typedef short s16x8 __attribute__((ext_vector_type(8)));
typedef short s16x4 __attribute__((ext_vector_type(4)));
typedef float f32x16 __attribute__((ext_vector_type(16)));
typedef float f32x4 __attribute__((ext_vector_type(4)));
typedef unsigned u32x2 __attribute__((ext_vector_type(2)));
constexpr int KBUF = 16384, VOFF = 49152, VBUF = 16384, NUNITS = B * 4 * (L / 128), NT = KEYS / 64;
constexpr float THR = 60.0f;
typedef float f32x2 __attribute__((ext_vector_type(2)));
typedef __bf16 bf16x2 __attribute__((ext_vector_type(2)));
DEV unsigned cvtpk(float lo, float hi) { const f32x2 v = {lo, hi}; return __builtin_bit_cast(unsigned, __builtin_convertvector(v, bf16x2)); }
DEV s16x8 pack8(const f32x16& v, int o) {
    union { unsigned u[4]; s16x8 s; } x;
    x.u[0] = cvtpk(v[o + 0], v[o + 1]); x.u[1] = cvtpk(v[o + 2], v[o + 3]); x.u[2] = cvtpk(v[o + 4], v[o + 5]); x.u[3] = cvtpk(v[o + 6], v[o + 7]);
    return x.s;
}
template <int OFF> DEV void tr_rd(s16x4& r, unsigned addr) { asm volatile("ds_read_b64_tr_b16 %0, %1 offset:%2" : "=&v"(r) : "v"(addr), "i"(OFF)); }
struct Ctx {
    const bf16_t* k1; const bf16_t* k2; const bf16_t* v;
    unsigned ksrc, vsrc0, vsrc1;
    unsigned kaddr[4]; unsigned vaddr[2][4];
    int wid, map;
};
DEV void stageK(const Ctx& c, LAS unsigned char* lds, int t, int kb) {
    const size_t rk = (size_t)t * 64 * 256;
    __builtin_amdgcn_global_load_lds((const unsigned*)(c.k1 + rk + c.ksrc), (LAS unsigned*)(lds + kb * KBUF + c.wid * 1024), 16, 0, 0);
    __builtin_amdgcn_global_load_lds((const unsigned*)(c.k2 + rk + c.ksrc), (LAS unsigned*)(lds + kb * KBUF + 8192 + c.wid * 1024), 16, 0, 0);
}
DEV void stageV(const Ctx& c, LAS unsigned char* lds, int t, int vb) {
    const size_t rv = (size_t)t * 64 * 512;
    __builtin_amdgcn_global_load_lds((const unsigned*)(c.v + rv + c.vsrc0), (LAS unsigned*)(lds + VOFF + vb * VBUF + c.wid * 1024), 16, 0, 0);
    __builtin_amdgcn_global_load_lds((const unsigned*)(c.v + rv + c.vsrc1), (LAS unsigned*)(lds + VOFF + vb * VBUF + 8192 + c.wid * 1024), 16, 0, 0);
}
DEV void qk(const Ctx& c, LAS unsigned char* lds, unsigned kboff, const s16x8 (&qf)[4], f32x16& S0, f32x16& S1) {
    const LAS unsigned char* kb = lds + kboff;
#pragma unroll
    for (int r = 0; r < 16; ++r) { S0[r] = 0.f; S1[r] = 0.f; }
    s16x8 ka[4], kc[4];
#pragma unroll
    for (int s = 0; s < 4; ++s) { ka[s] = *(const LAS s16x8*)(kb + c.kaddr[s]); kc[s] = *(const LAS s16x8*)(kb + 4096 + c.kaddr[s]); }
#pragma unroll
    for (int s = 0; s < 4; ++s) {
        S0 = __builtin_amdgcn_mfma_f32_32x32x16_bf16(ka[s], qf[s], S0, 0, 0, 0);
        S1 = __builtin_amdgcn_mfma_f32_32x32x16_bf16(kc[s], qf[s], S1, 0, 0, 0);
    }
}
DEV int imax3(int a, int b, int c) { return max(max(a, b), c); }
DEV void softmax_pv(const Ctx& c, unsigned vbase, f32x16& S0, f32x16& S1, f32x16 (&O)[4], float& m, float& l, bool first) {
    int i0 = imax3(__float_as_int(S0[0]), __float_as_int(S1[0]), __float_as_int(S0[1])), i1 = imax3(__float_as_int(S0[4]), __float_as_int(S1[4]), __float_as_int(S0[5]));
    int i2 = imax3(__float_as_int(S0[8]), __float_as_int(S1[8]), __float_as_int(S0[9])), i3 = imax3(__float_as_int(S0[12]), __float_as_int(S1[12]), __float_as_int(S0[13]));
    i0 = imax3(i0, __float_as_int(S1[1]), __float_as_int(S0[2])); i1 = imax3(i1, __float_as_int(S1[5]), __float_as_int(S0[6])); i2 = imax3(i2, __float_as_int(S1[9]), __float_as_int(S0[10])); i3 = imax3(i3, __float_as_int(S1[13]), __float_as_int(S0[14]));
    i0 = imax3(i0, __float_as_int(S1[2]), __float_as_int(S0[3])); i1 = imax3(i1, __float_as_int(S1[6]), __float_as_int(S0[7])); i2 = imax3(i2, __float_as_int(S1[10]), __float_as_int(S0[11])); i3 = imax3(i3, __float_as_int(S1[14]), __float_as_int(S0[15]));
    i0 = imax3(i0, __float_as_int(S1[3]), i1); i2 = imax3(i2, __float_as_int(S1[7]), i3);
    const int im = imax3(i0, i2, max(__float_as_int(S1[11]), __float_as_int(S1[15])));
    const bool simple = !first && !__any((im > __float_as_int(THR)) || (m != 0.f));
    if (!simple) {
        const float mref = first ? 0.f : m;
#pragma unroll
        for (int r = 0; r < 16; ++r) { S0[r] -= mref; S1[r] -= mref; }
        float t0 = fmaxf(fmaxf(S0[0], S1[0]), S0[1]), t1 = fmaxf(fmaxf(S0[4], S1[4]), S0[5]), t2 = fmaxf(fmaxf(S0[8], S1[8]), S0[9]), t3 = fmaxf(fmaxf(S0[12], S1[12]), S0[13]);
        t0 = fmaxf(fmaxf(t0, S1[1]), S0[2]); t1 = fmaxf(fmaxf(t1, S1[5]), S0[6]); t2 = fmaxf(fmaxf(t2, S1[9]), S0[10]); t3 = fmaxf(fmaxf(t3, S1[13]), S0[14]);
        t0 = fmaxf(fmaxf(t0, S1[2]), S0[3]); t1 = fmaxf(fmaxf(t1, S1[6]), S0[7]); t2 = fmaxf(fmaxf(t2, S1[10]), S0[11]); t3 = fmaxf(fmaxf(t3, S1[14]), S0[15]);
        t0 = fmaxf(fmaxf(t0, S1[3]), t1); t2 = fmaxf(fmaxf(t2, S1[7]), t3);
        float tm = fmaxf(fmaxf(t0, t2), fmaxf(S1[11], S1[15]));
        { const auto rr = __builtin_amdgcn_permlane32_swap(__float_as_uint(tm), __float_as_uint(tm), false, false);
          tm = fmaxf(__uint_as_float(rr[0]), __uint_as_float(rr[1])); }
        const float d = first ? ((fabsf(tm) > THR) ? tm : 0.f) : ((tm > THR) ? tm : 0.f);
        if (__any(d != 0.f)) {
            const float al = first ? 1.0f : __builtin_amdgcn_exp2f(-d);
            l *= al;
#pragma unroll
            for (int eb = 0; eb < 4; ++eb)
#pragma unroll
                for (int r = 0; r < 16; ++r) O[eb][r] *= al;
#pragma unroll
            for (int r = 0; r < 16; ++r) { S0[r] -= d; S1[r] -= d; }
        }
        m = mref + d;
    }
#pragma unroll
    for (int r = 0; r < 16; ++r) { S0[r] = __builtin_amdgcn_exp2f(S0[r]); S1[r] = __builtin_amdgcn_exp2f(S1[r]); }
    float ls0 = S0[0], ls1 = S0[8], ls2 = S1[0], ls3 = S1[8];
#pragma unroll
    for (int r = 1; r < 8; ++r) { ls0 += S0[r]; ls1 += S0[r + 8]; ls2 += S1[r]; ls3 += S1[r + 8]; }
    l += (ls0 + ls1) + (ls2 + ls3);
    s16x8 pf[4];
    pf[0] = pack8(S0, 0); pf[1] = pack8(S0, 8); pf[2] = pack8(S1, 0); pf[3] = pack8(S1, 8);
    unsigned va[2][4];
#pragma unroll
    for (int t = 0; t < 2; ++t)
#pragma unroll
        for (int eb = 0; eb < 4; ++eb) va[t][eb] = vbase + c.vaddr[t][eb];
    s16x4 g0[2][4][2], g1[2][4][2];
#pragma unroll
    for (int eb = 0; eb < 4; ++eb) { tr_rd<0>(g0[0][eb][0], va[0][eb]); tr_rd<0>(g0[0][eb][1], va[1][eb]); tr_rd<4096>(g0[1][eb][0], va[0][eb]); tr_rd<4096>(g0[1][eb][1], va[1][eb]); }
    asm volatile("s_waitcnt lgkmcnt(0)"
                 : "+v"(g0[0][0][0]), "+v"(g0[0][0][1]), "+v"(g0[0][1][0]), "+v"(g0[0][1][1]), "+v"(g0[0][2][0]), "+v"(g0[0][2][1]), "+v"(g0[0][3][0]), "+v"(g0[0][3][1]),
                   "+v"(g0[1][0][0]), "+v"(g0[1][0][1]), "+v"(g0[1][1][0]), "+v"(g0[1][1][1]), "+v"(g0[1][2][0]), "+v"(g0[1][2][1]), "+v"(g0[1][3][0]), "+v"(g0[1][3][1]));
#pragma unroll
    for (int eb = 0; eb < 4; ++eb) { tr_rd<8192>(g1[0][eb][0], va[0][eb]); tr_rd<8192>(g1[0][eb][1], va[1][eb]); tr_rd<12288>(g1[1][eb][0], va[0][eb]); tr_rd<12288>(g1[1][eb][1], va[1][eb]); }
#pragma unroll
    for (int k2 = 0; k2 < 2; ++k2)
#pragma unroll
        for (int eb = 0; eb < 4; ++eb) {
            const s16x8 vf = __builtin_shufflevector(g0[k2][eb][0], g0[k2][eb][1], 0, 1, 2, 3, 4, 5, 6, 7);
            O[eb] = __builtin_amdgcn_mfma_f32_32x32x16_bf16(vf, pf[k2], O[eb], 0, 0, 0);
        }
    asm volatile("s_waitcnt lgkmcnt(0)"
                 : "+v"(g1[0][0][0]), "+v"(g1[0][0][1]), "+v"(g1[0][1][0]), "+v"(g1[0][1][1]), "+v"(g1[0][2][0]), "+v"(g1[0][2][1]), "+v"(g1[0][3][0]), "+v"(g1[0][3][1]),
                   "+v"(g1[1][0][0]), "+v"(g1[1][0][1]), "+v"(g1[1][1][0]), "+v"(g1[1][1][1]), "+v"(g1[1][2][0]), "+v"(g1[1][2][1]), "+v"(g1[1][3][0]), "+v"(g1[1][3][1]));
#pragma unroll
    for (int k2 = 0; k2 < 2; ++k2)
#pragma unroll
        for (int eb = 0; eb < 4; ++eb) {
            const s16x8 vf = __builtin_shufflevector(g1[k2][eb][0], g1[k2][eb][1], 0, 1, 2, 3, 4, 5, 6, 7);
            O[eb] = __builtin_amdgcn_mfma_f32_32x32x16_bf16(vf, pf[2 + k2], O[eb], 0, 0, 0);
        }
}
#define ATT_BAR() do { asm volatile("s_waitcnt vmcnt(0) lgkmcnt(0)" ::: "memory"); __builtin_amdgcn_s_barrier(); asm volatile("" ::: "memory"); } while (0)
DEV void attn_phase(const Params& p, LAS unsigned char* lds) {
    const int tid = opaque_tid(), wid = __builtin_amdgcn_readfirstlane(tid >> 6), lane = tid & 63;
    const int map = wid >> 2, rg = wid & 3, h2 = lane >> 5, ql = lane & 31;
    unsigned char* ws = p.ws;
    const bf16_t* qbase = (const bf16_t*)(ws + OFF_B) + (size_t)map * NTOK * 256;
    const bf16_t* k1base = (const bf16_t*)(ws + OFF_B + 32 * MiB); const bf16_t* k2base = k1base + (size_t)B * KEYS * 256;
    const bf16_t* vbase = (const bf16_t*)(ws + OFF_B + 68 * MiB);
    bf16_t* mix = (bf16_t*)(ws + OFF_C);
    const float* subg = p.in[I_SUBG];
    const float lam = *(const float*)(ws + OFF_LAM);
    Ctx c; c.wid = wid; c.map = map;
    { const int key = tid >> 3, ch = (tid & 7) ^ ((key >> 1) & 7); c.ksrc = (unsigned)(key * 256 + ch * 8); }
    { const int s0 = tid, k0 = s0 >> 4, c0 = (s0 & 15) ^ (((k0 & 3) << 2) | ((k0 >> 2) & 3)); c.vsrc0 = (unsigned)(k0 * 512 + c0 * 8);
      const int s1 = tid + 512, k1 = s1 >> 4, c1 = (s1 & 15) ^ (((k1 & 3) << 2) | ((k1 >> 2) & 3)); c.vsrc1 = (unsigned)(k1 * 512 + c1 * 8); }
    { const unsigned xk = (unsigned)(ql >> 1) & 7u;
#pragma unroll
      for (int s = 0; s < 4; ++s) c.kaddr[s] = (unsigned)ql * 128u + ((((unsigned)(2 * s + h2)) ^ xk) << 4);
      const unsigned q_ = (unsigned)(lane & 15) >> 2, p_ = (unsigned)lane & 3u, blk = (unsigned)(lane >> 4) & 1u;
#pragma unroll
      for (int t = 0; t < 2; ++t)
#pragma unroll
          for (int eb = 0; eb < 4; ++eb)
              c.vaddr[t][eb] = 256u * (4u * h2 + 8u * t + q_) + 16u * ((((unsigned)eb ^ q_) << 2) | ((2u * blk + (p_ >> 1)) ^ (unsigned)(h2 + 2 * t))) + 8u * (p_ & 1u);
    }
    const int G = gridDim.x, bid = blockIdx.x;
    auto unit_of = [&](int i) -> int {
        if (G == 256) { if (i >= 4) return -1; const int j = i * 32 + (bid >> 3); return ((bid & 7) * 8 + (j >> 4)) * 16 + (j & 15); }
        const int u = i * G + bid; return u < NUNITS ? u : -1; };
#define ATT_STAGE0(unit_) do { const int bh_ = (unit_) >> 4, b_ = bh_ >> 2, h_ = bh_ & 3; \
        c.k1 = k1base + (size_t)b_ * KEYS * 256 + h_ * 64; c.k2 = k2base + (size_t)b_ * KEYS * 256 + h_ * 64; c.v = vbase + (size_t)b_ * KEYS * 512 + h_ * 128; \
        stageK(c, lds, 0, 0); stageV(c, lds, 0, 0); stageK(c, lds, 1, 1); } while (0)
    if (wid >= 4) __builtin_amdgcn_s_setprio(1);
    int unit = unit_of(0);
    if (unit >= 0) ATT_STAGE0(unit);
    for (int i = 0; unit >= 0; ++i) {
        const int bh = unit >> 4, qblk = unit & 15, b = bh >> 2, h = bh & 3;
        const int row = b * L + qblk * 128 + rg * 32 + ql;
        s16x8 qf[4];
        { const bf16_t* qrow = qbase + (size_t)row * 256 + h * 64;
#pragma unroll
          for (int s = 0; s < 4; ++s) qf[s] = *(const s16x8*)(qrow + (2 * s + h2) * 8); }
        f32x16 O[4];
#pragma unroll
        for (int eb = 0; eb < 4; ++eb)
#pragma unroll
            for (int r = 0; r < 16; ++r) O[eb][r] = 0.f;
        float m = 0.f, l = 0.f;
        const unsigned ldsb = (unsigned)(__UINTPTR_TYPE__)lds, kmap = (unsigned)(map * 8192);
        ATT_BAR();
        f32x16 Sa0, Sa1, Sb0, Sb1;
        qk(c, lds, kmap, qf, Sa0, Sa1);
        int k1i = 1, k2i = 2;
        for (int t = 0; t < NT; t += 2) {
            if (t + 2 < NT) stageK(c, lds, t + 2, k2i);
            stageV(c, lds, t + 1, 1);
            qk(c, lds, (unsigned)(k1i * KBUF) + kmap, qf, Sb0, Sb1);
            softmax_pv(c, ldsb + (unsigned)VOFF, Sa0, Sa1, O, m, l, t == 0);
            { const int n = (k2i == 2) ? 0 : k2i + 1; k1i = k2i; k2i = n; }
            ATT_BAR();
            if (t + 3 < NT) stageK(c, lds, t + 3, k2i);
            if (t + 2 < NT) { stageV(c, lds, t + 2, 0); qk(c, lds, (unsigned)(k1i * KBUF) + kmap, qf, Sa0, Sa1); }
            softmax_pv(c, ldsb + (unsigned)(VOFF + VBUF), Sb0, Sb1, O, m, l, false);
            { const int n = (k2i == 2) ? 0 : k2i + 1; k1i = k2i; k2i = n; }
            ATT_BAR();
        }
        unit = unit_of(i + 1);
        if (unit >= 0) ATT_STAGE0(unit);
        float lt; { const auto rr = __builtin_amdgcn_permlane32_swap(__float_as_uint(l), __float_as_uint(l), false, false); lt = __uint_as_float(rr[0]) + __uint_as_float(rr[1]); }
        LAS float* xch = (LAS float*)(lds + (rg == 0 ? 65536 : 65536 + rg * 16384));
        if (map == 1) {
            const float sc = -lam / lt;
#pragma unroll
            for (int eb = 0; eb < 4; ++eb)
#pragma unroll
                for (int g4 = 0; g4 < 4; ++g4)
                    ((LAS f32x4*)xch)[(eb * 4 + g4) * 64 + lane] = (f32x4){O[eb][4 * g4 + 0] * sc, O[eb][4 * g4 + 1] * sc, O[eb][4 * g4 + 2] * sc, O[eb][4 * g4 + 3] * sc};
        }
        asm volatile("s_waitcnt lgkmcnt(0)" ::: "memory"); __builtin_amdgcn_s_barrier(); asm volatile("" ::: "memory");
        if (map == 0) {
            const float sc = 1.0f / lt;
            float ss = 0.f;
#pragma unroll
            for (int eb = 0; eb < 4; ++eb)
#pragma unroll
                for (int g4 = 0; g4 < 4; ++g4) { const f32x4 xv = ((const LAS f32x4*)xch)[(eb * 4 + g4) * 64 + lane];
#pragma unroll
                    for (int j = 0; j < 4; ++j) { const float o = O[eb][4 * g4 + j] * sc + xv[j]; O[eb][4 * g4 + j] = o; ss += o * o; } }
            ss += __shfl_xor(ss, 32);
            const float rn = rsqrtf(ss * (1.0f / 128.0f) + EPS) * (1.0f - LAM_INIT);
            bf16_t* orow = mix + (size_t)row * 1024 + h * 128;
#pragma unroll
            for (int eb = 0; eb < 4; ++eb)
#pragma unroll
                for (int pr = 0; pr < 2; ++pr) {
                    u32x2 w[2];
#pragma unroll
                    for (int s = 0; s < 2; ++s) { const int g4 = 2 * pr + s, e0 = eb * 32 + 8 * g4 + 4 * h2;
                        const f32x4 gg = *(const f32x4*)(subg + e0);
                        w[s].x = cvtpk(O[eb][4 * g4 + 0] * rn * gg[0], O[eb][4 * g4 + 1] * rn * gg[1]); w[s].y = cvtpk(O[eb][4 * g4 + 2] * rn * gg[2], O[eb][4 * g4 + 3] * rn * gg[3]); }
                    const auto rx = __builtin_amdgcn_permlane32_swap(w[0].x, w[1].x, false, false);
                    const auto ry = __builtin_amdgcn_permlane32_swap(w[0].y, w[1].y, false, false);
                    pg8::u32x4 o; o.x = rx[0]; o.y = ry[0]; o.z = rx[1]; o.w = ry[1];
                    *(pg8::u32x4*)(orow + eb * 32 + 16 * pr + 8 * h2) = o;
                }
        }
        asm volatile("s_waitcnt lgkmcnt(0)" ::: "memory"); __builtin_amdgcn_s_barrier(); asm volatile("" ::: "memory");
    }
#undef ATT_STAGE0
    __builtin_amdgcn_s_setprio(0);
    asm volatile("s_waitcnt vmcnt(0) lgkmcnt(0)" ::: "memory"); __builtin_amdgcn_s_barrier(); asm volatile("" ::: "memory");
}
}


namespace sg {
typedef short s16x8 __attribute__((ext_vector_type(8)));
typedef short s16x4 __attribute__((ext_vector_type(4)));
typedef float f32x16 __attribute__((ext_vector_type(16)));
typedef unsigned u32x2 __attribute__((ext_vector_type(2)));
typedef unsigned u32x4 __attribute__((ext_vector_type(4)));
typedef float f32x2 __attribute__((ext_vector_type(2)));
typedef __bf16 bf16x2 __attribute__((ext_vector_type(2)));
DEV unsigned cvtpk(float lo, float hi) { const f32x2 v = {lo, hi}; return __builtin_bit_cast(unsigned, __builtin_convertvector(v, bf16x2)); }
DEV void sg_phase(const Params& p, LAS unsigned char* lds) {
    const int tid = opaque_tid(), wid = __builtin_amdgcn_readfirstlane(tid >> 6), lane = tid & 63, h2 = lane >> 5, ql = lane & 31;
    unsigned char* ws = p.ws;
    const bf16_t* zb = (const bf16_t*)(ws + OFF_A + 64 * MiB); const bf16_t* sgw = (const bf16_t*)(ws + OFF_SGW);
    bf16_t* mix = (bf16_t*)(ws + OFF_C);
    const float* sg_b = p.in[I_SGB];
    float gam[8], bet[8];
#pragma unroll
    for (int j = 0; j < 8; ++j) { gam[j] = p.in[I_SGLNG][lane * 8 + j]; bet[j] = p.in[I_SGLNB][lane * 8 + j]; }
    const unsigned q_ = (unsigned)(lane & 15) >> 2, p_ = (unsigned)lane & 3u, blk = (unsigned)(lane >> 4) & 1u;
    const int cb = wid >> 1, pb0 = (wid & 1) * 2;
    unsigned traddr[2];
#pragma unroll
    for (int t = 0; t < 2; ++t)
        traddr[t] = 256u * (8u * h2 + 4u * t + q_) + 16u * ((((unsigned)cb ^ q_) << 2) | ((2u * blk + (p_ >> 1)) ^ ((2u * h2 + t) & 3u))) + 8u * (p_ & 1u);
    for (int unit = blockIdx.x; unit < NTOK / 128; unit += gridDim.x) {
        const int row0 = unit * 128;
#pragma unroll 2
        for (int rr = 0; rr < 16; ++rr) {
            const int q = wid * 16 + rr;
            const uint4 r = ld_nt16(zb + (size_t)(row0 + q) * 1024 + 512 + lane * 8);
            float v[8] = {bf2f((bf16_t)(r.x & 0xffff)), bf2f((bf16_t)(r.x >> 16)), bf2f((bf16_t)(r.y & 0xffff)), bf2f((bf16_t)(r.y >> 16)),
                          bf2f((bf16_t)(r.z & 0xffff)), bf2f((bf16_t)(r.z >> 16)), bf2f((bf16_t)(r.w & 0xffff)), bf2f((bf16_t)(r.w >> 16))};
            float s = 0.f;
#pragma unroll
            for (int j = 0; j < 8; ++j) s += v[j];
            const float mu = wave_sum(s) * (1.0f / 512.0f);
            float qq = 0.f;
#pragma unroll
            for (int j = 0; j < 8; ++j) { v[j] -= mu; qq += v[j] * v[j]; }
            const float rstd = rsqrtf(wave_sum(qq) * (1.0f / 512.0f) + EPS);
            u32x4 w;
            w.x = cvtpk(v[0] * rstd * gam[0] + bet[0], v[1] * rstd * gam[1] + bet[1]); w.y = cvtpk(v[2] * rstd * gam[2] + bet[2], v[3] * rstd * gam[3] + bet[3]);
            w.z = cvtpk(v[4] * rstd * gam[4] + bet[4], v[5] * rstd * gam[5] + bet[5]); w.w = cvtpk(v[6] * rstd * gam[6] + bet[6], v[7] * rstd * gam[7] + bet[7]);
            const unsigned ch = (unsigned)lane & 15u, swz = (((unsigned)q & 3u) << 2) | (((unsigned)q >> 2) & 3u);
            *(LAS u32x4*)(lds + (lane >> 4) * 32768 + 256 * q + 16 * (ch ^ swz)) = w;
        }
        asm volatile("s_waitcnt lgkmcnt(0)" ::: "memory"); __builtin_amdgcn_s_barrier(); asm volatile("" ::: "memory");
#pragma unroll 1
        for (int g = 0; g < 4; ++g) {
            f32x16 acc[2];
#pragma unroll
            for (int j = 0; j < 2; ++j)
#pragma unroll
                for (int r = 0; r < 16; ++r) acc[j][r] = 0.f;
            const LAS unsigned char* tb = lds + g * 32768;
#pragma unroll
            for (int ks = 0; ks < 8; ++ks) {
                const s16x4 a = __builtin_amdgcn_ds_read_tr16_b64_v4i16((LAS s16x4*)(tb + traddr[0] + 4096 * ks));
                const s16x4 b2 = __builtin_amdgcn_ds_read_tr16_b64_v4i16((LAS s16x4*)(tb + traddr[1] + 4096 * ks));
                const s16x8 vf = __builtin_shufflevector(a, b2, 0, 1, 2, 3, 4, 5, 6, 7);
#pragma unroll
                for (int j = 0; j < 2; ++j) {
                    const s16x8 wf = *(const s16x8*)(sgw + (size_t)((((g * 4 + pb0 + j) * 8 + ks) * 64 + lane)) * 8);
                    acc[j] = __builtin_amdgcn_mfma_f32_32x32x16_bf16(vf, wf, acc[j], 0, 0, 0);
                }
            }
#pragma unroll
            for (int j = 0; j < 2; ++j) {
                const int ptok = (pb0 + j) * 32 + ql, row = row0 + ptok;
                const float bias = sg_b[g * 128 + ptok];
#pragma unroll
                for (int pr = 0; pr < 2; ++pr) {
                    const int c1 = g * 128 + cb * 32 + 16 * pr + 8 * h2;
                    const uint4 ul = *(const uint4*)(zb + (size_t)row * 1024 + c1);
                    const auto ux = __builtin_amdgcn_permlane32_swap(ul.x, ul.z, false, false);
                    const auto uy = __builtin_amdgcn_permlane32_swap(ul.y, ul.w, false, false);
                    const unsigned u[2][2] = {{ux[0], uy[0]}, {ux[1], uy[1]}};
                    u32x2 w[2];
#pragma unroll
                    for (int s = 0; s < 2; ++s) { const int r4 = 2 * pr + s;
                        w[s].x = cvtpk(bf2f((bf16_t)(u[s][0] & 0xffff)) * (acc[j][4 * r4 + 0] + bias), bf2f((bf16_t)(u[s][0] >> 16)) * (acc[j][4 * r4 + 1] + bias));
                        w[s].y = cvtpk(bf2f((bf16_t)(u[s][1] & 0xffff)) * (acc[j][4 * r4 + 2] + bias), bf2f((bf16_t)(u[s][1] >> 16)) * (acc[j][4 * r4 + 3] + bias)); }
                    const auto rx = __builtin_amdgcn_permlane32_swap(w[0].x, w[1].x, false, false);
                    const auto ry = __builtin_amdgcn_permlane32_swap(w[0].y, w[1].y, false, false);
                    u32x4 o; o.x = rx[0]; o.y = ry[0]; o.z = rx[1]; o.w = ry[1];
                    *(u32x4*)(mix + (size_t)row * 1024 + 512 + c1) = o;
                }
            }
        }
        asm volatile("s_waitcnt lgkmcnt(0)" ::: "memory"); __builtin_amdgcn_s_barrier(); asm volatile("" ::: "memory");
    }
}
}


namespace rt {
typedef short s16x8 __attribute__((ext_vector_type(8)));
typedef float f32x4 __attribute__((ext_vector_type(4)));
typedef unsigned u32x2 __attribute__((ext_vector_type(2)));
typedef unsigned u32x4 __attribute__((ext_vector_type(4)));
constexpr int TROW = 2064;
constexpr int O_THI = 0, O_TLO = 16 * TROW, O_PART = 2 * 16 * TROW, O_LOG = O_PART + 8 * 16 * 48 * 4, O_VEC = O_LOG + 16 * 36 * 4, O_SEL = O_VEC + 5 * 4096;
DEV void ln1_router_phase(const Params& p, LAS unsigned char* lds) {
    const int tid = opaque_tid(), wid = __builtin_amdgcn_readfirstlane(tid >> 6), lane = tid & 63, fr = lane & 15, fq = lane >> 4;
    const float* x = p.in[I_X]; const float* ln_g = p.in[I_LN1G]; const float* ln_b = p.in[I_LN1B];
    const float* wgr = p.in[I_RGW]; const float* bgr = p.in[I_RGB]; const float* wer = p.in[I_REW]; const float* ber = p.in[I_REB];
    unsigned char* ws = p.ws; bf16_t* x1b = (bf16_t*)(ws + OFF_B);
    const float* mod = (const float*)(ws + OFF_MOD); const bf16_t* y = (const bf16_t*)(ws + OFF_A);
    bf16_t* tb = (bf16_t*)(ws + OFF_C);
    int* tok_e = (int*)(ws + OFF_TOKE); int* tok_p = (int*)(ws + OFF_TOKP); float* tok_w = (float*)(ws + OFF_TOKW); int* dmap = (int*)(ws + OFF_DMAP);
    unsigned* cnt = (unsigned*)(ws + OFF_CTL) + CW_CNT;
    s16x8 whi[3][4], wlo[3][4];
    { const bf16_t* rhi = (const bf16_t*)(ws + OFF_RTW); const bf16_t* rlo = rhi + 8 * 3 * 4 * 64 * 8;
#pragma unroll
      for (int nt = 0; nt < 3; ++nt)
#pragma unroll
          for (int s = 0; s < 4; ++s) { const size_t o = (size_t)((((wid * 3 + nt) * 4 + s) << 6) + lane) * 8;
              whi[nt][s] = *(const s16x8*)(rhi + o); wlo[nt][s] = *(const s16x8*)(rlo + o); } }
    (void)wgr; (void)wer;
    LAS int* sel_e = (LAS int*)(lds + O_SEL); LAS float* sel_w = (LAS float*)(lds + O_SEL + 1024); LAS int* sel_r = (LAS int*)(lds + O_SEL + 2048);
    LAS int* hist = (LAS int*)(lds + O_SEL + 3072); LAS int* gbase = (LAS int*)(lds + O_SEL + 3200); LAS float* bias = (LAS float*)(lds + O_SEL + 3328);
    if (tid < 36) bias[tid] = tid < 4 ? bgr[tid] : ber[tid - 4];
    for (int panel = blockIdx.x; panel < NTOK / 128; panel += gridDim.x) {
        const int row0 = panel * 128;
        const float* m = mod + (row0 / L) * 6144;
        float4 xr[2][2][2]; uint4 yr[2][2];
#define RT_LOAD(tile_) do { _Pragma("unroll") for (int rr_ = 0; rr_ < 2; ++rr_) _Pragma("unroll") for (int i_ = 0; i_ < 2; ++i_) { \
            const size_t o_ = (size_t)(row0 + (tile_) * 16 + wid * 2 + rr_) * D + 8 * lane + 512 * i_; \
            xr[rr_][i_][0] = *(const float4*)(x + o_); xr[rr_][i_][1] = *(const float4*)(x + o_ + 4); yr[rr_][i_] = *(const uint4*)(y + o_); } } while (0)
        { LAS float* vec = (LAS float*)(lds + O_VEC);
          for (int c = tid; c < 1024; c += 512) { const float g = ln_g[c], bb = ln_b[c], scl = m[4096 + c], sh = m[3072 + c];
              vec[c] = m[2048 + c]; vec[1024 + c] = g; vec[2048 + c] = bb; vec[3072 + c] = g * (1.f + scl); vec[4096 + c] = bb * (1.f + scl) + sh; } }
        if (tid < 32) hist[tid] = 0;
        RT_LOAD(0);
        asm volatile("s_waitcnt lgkmcnt(0)" ::: "memory"); __builtin_amdgcn_s_barrier(); asm volatile("" ::: "memory");
#pragma unroll 1
        for (int tile = 0; tile < 8; ++tile) {
#pragma unroll
            for (int rr = 0; rr < 2; ++rr) {
                const int lrow = wid * 2 + rr, row = row0 + tile * 16 + lrow;
                const LAS f32x4* vec = (const LAS f32x4*)(lds + O_VEC) + 2 * lane;
                float v[16]; float s = 0.f;
#pragma unroll
                for (int i = 0; i < 2; ++i) {
                    const float4 a0 = xr[rr][i][0], a1 = xr[rr][i][1];
                    float yv[8]; unpack8(yr[rr][i], yv);
                    const f32x4 g0 = vec[128 * i], g1 = vec[128 * i + 1];
                    v[8 * i + 0] = ALPHA * a0.x + g0[0] * yv[0]; v[8 * i + 1] = ALPHA * a0.y + g0[1] * yv[1]; v[8 * i + 2] = ALPHA * a0.z + g0[2] * yv[2]; v[8 * i + 3] = ALPHA * a0.w + g0[3] * yv[3];
                    v[8 * i + 4] = ALPHA * a1.x + g1[0] * yv[4]; v[8 * i + 5] = ALPHA * a1.y + g1[1] * yv[5]; v[8 * i + 6] = ALPHA * a1.z + g1[2] * yv[6]; v[8 * i + 7] = ALPHA * a1.w + g1[3] * yv[7];
#pragma unroll
                    for (int j = 0; j < 8; ++j) s += v[8 * i + j];
                }
                const float mu = wave_sum(s) * (1.0f / 1024.0f);
                float q = 0.f;
#pragma unroll
                for (int j = 0; j < 16; ++j) { v[j] -= mu; q += v[j] * v[j]; }
                const float rstd = rsqrtf(wave_sum(q) * (1.0f / 1024.0f) + EPS);
#pragma unroll
                for (int i = 0; i < 2; ++i) {
                    const int c = 8 * lane + 512 * i;
                    float xo[8], tt[8];
#pragma unroll
                    for (int h4 = 0; h4 < 2; ++h4) {
                        const f32x4 g = vec[256 + 128 * i + h4], bb = vec[512 + 128 * i + h4], g2 = vec[768 + 128 * i + h4], b2 = vec[1024 + 128 * i + h4];
#pragma unroll
                        for (int j = 0; j < 4; ++j) { const float n = v[8 * i + 4 * h4 + j] * rstd; xo[4 * h4 + j] = n * g[j] + bb[j]; tt[4 * h4 + j] = n * g2[j] + b2[j]; }
                    }
                    uint4 xb; xb.x = pack2(xo[0], xo[1]); xb.y = pack2(xo[2], xo[3]); xb.z = pack2(xo[4], xo[5]); xb.w = pack2(xo[6], xo[7]);
                    *(uint4*)(x1b + (size_t)row * D + c) = xb;
                    bf16_t hh[8];
#pragma unroll
                    for (int j = 0; j < 8; ++j) hh[j] = f2bf(tt[j]);
                    u32x4 hi4, lo4;
                    hi4.x = (unsigned)hh[0] | ((unsigned)hh[1] << 16); hi4.y = (unsigned)hh[2] | ((unsigned)hh[3] << 16); hi4.z = (unsigned)hh[4] | ((unsigned)hh[5] << 16); hi4.w = (unsigned)hh[6] | ((unsigned)hh[7] << 16);
                    lo4.x = pack2(tt[0] - bf2f(hh[0]), tt[1] - bf2f(hh[1])); lo4.y = pack2(tt[2] - bf2f(hh[2]), tt[3] - bf2f(hh[3]));
                    lo4.z = pack2(tt[4] - bf2f(hh[4]), tt[5] - bf2f(hh[5])); lo4.w = pack2(tt[6] - bf2f(hh[6]), tt[7] - bf2f(hh[7]));
                    { uint4 tw; tw.x = hi4.x; tw.y = hi4.y; tw.z = hi4.z; tw.w = hi4.w; *(uint4*)(tb + (size_t)row * D + c) = tw; }
                    *(LAS u32x4*)(lds + O_THI + lrow * TROW + c * 2) = hi4;
                    *(LAS u32x4*)(lds + O_TLO + lrow * TROW + c * 2) = lo4;
                }
            }
            if (tile < 7) RT_LOAD(tile + 1);
            asm volatile("s_waitcnt lgkmcnt(0)" ::: "memory"); __builtin_amdgcn_s_barrier(); asm volatile("" ::: "memory");
            f32x4 acc[3];
#pragma unroll
            for (int nt = 0; nt < 3; ++nt) acc[nt] = (f32x4){0.f, 0.f, 0.f, 0.f};
#pragma unroll
            for (int s = 0; s < 4; ++s) {
                const int kb = (128 * wid + 32 * s + 8 * fq) * 2;
                const s16x8 ahi = *(const LAS s16x8*)(lds + O_THI + fr * TROW + kb);
                const s16x8 alo = *(const LAS s16x8*)(lds + O_TLO + fr * TROW + kb);
#pragma unroll
                for (int nt = 0; nt < 3; ++nt) {
                    acc[nt] = __builtin_amdgcn_mfma_f32_16x16x32_bf16(ahi, whi[nt][s], acc[nt], 0, 0, 0);
                    acc[nt] = __builtin_amdgcn_mfma_f32_16x16x32_bf16(ahi, wlo[nt][s], acc[nt], 0, 0, 0);
                    acc[nt] = __builtin_amdgcn_mfma_f32_16x16x32_bf16(alo, whi[nt][s], acc[nt], 0, 0, 0);
                }
            }
            { LAS float* part = (LAS float*)(lds + O_PART) + wid * (16 * 48);
#pragma unroll
              for (int nt = 0; nt < 3; ++nt)
#pragma unroll
                  for (int r = 0; r < 4; ++r) part[(fq * 4 + r) * 48 + 16 * nt + fr] = acc[nt][r]; }
            asm volatile("s_waitcnt lgkmcnt(0)" ::: "memory"); __builtin_amdgcn_s_barrier(); asm volatile("" ::: "memory");
            for (int i = tid; i < 16 * 36; i += 512) {
                const int r = i / 36, o = i - r * 36; const LAS float* part = (const LAS float*)(lds + O_PART) + r * 48 + o;
                float sum = 0.f;
#pragma unroll
                for (int w = 0; w < 8; ++w) sum += part[w * (16 * 48)];
                ((LAS float*)(lds + O_LOG))[i] = sum;
            }
            asm volatile("s_waitcnt lgkmcnt(0)" ::: "memory"); __builtin_amdgcn_s_barrier(); asm volatile("" ::: "memory");
            if (tid < 16) {
                const int lr = tile * 16 + tid; const LAS float* lg = (const LAS float*)(lds + O_LOG) + tid * 36;
                float gl[4]; int gs = 0;
#pragma unroll
                for (int g = 0; g < 4; ++g) gl[g] = lg[g] + bias[g];
                float gmax = gl[0];
#pragma unroll
                for (int g = 1; g < 4; ++g) if (gl[g] > gmax) { gmax = gl[g]; gs = g; }
                float gsum = 0.f;
#pragma unroll
                for (int g = 0; g < 4; ++g) gsum += expf(gl[g] - gmax);
                const float gw = 1.0f / gsum;
                float el[8];
#pragma unroll
                for (int j = 0; j < 8; ++j) el[j] = lg[4 + gs * 8 + j] + bias[4 + gs * 8 + j];
                int i0 = 0; float v0 = el[0];
#pragma unroll
                for (int j = 1; j < 8; ++j) if (el[j] > v0) { v0 = el[j]; i0 = j; }
                int i1 = -1; float v1 = -3.0e38f;
#pragma unroll
                for (int j = 0; j < 8; ++j) if (j != i0 && (i1 < 0 || el[j] > v1)) { v1 = el[j]; i1 = j; }
                const float ex = expf(v1 - v0), w0 = gw / (1.0f + ex), w1 = gw * ex / (1.0f + ex);
                const int e0 = gs * 8 + i0, e1 = gs * 8 + i1;
                const int r0 = __hip_atomic_fetch_add(hist + e0, 1, __ATOMIC_RELAXED, __HIP_MEMORY_SCOPE_WORKGROUP), r1 = __hip_atomic_fetch_add(hist + e1, 1, __ATOMIC_RELAXED, __HIP_MEMORY_SCOPE_WORKGROUP);
                sel_e[2 * lr] = e0; sel_e[2 * lr + 1] = e1; sel_w[2 * lr] = w0; sel_w[2 * lr + 1] = w1; sel_r[2 * lr] = r0; sel_r[2 * lr + 1] = r1;
            }
        }
#undef RT_LOAD
        asm volatile("s_waitcnt lgkmcnt(0)" ::: "memory"); __builtin_amdgcn_s_barrier(); asm volatile("" ::: "memory");
        if (tid < 32) { const int h = hist[tid]; gbase[tid] = h > 0 ? (int)atomicAdd(&cnt[tid * CNT_STRIDE], (unsigned)h) : 0; }
        asm volatile("s_waitcnt vmcnt(0) lgkmcnt(0)" ::: "memory"); __builtin_amdgcn_s_barrier(); asm volatile("" ::: "memory");
        if (tid < 256) {
            const int e = sel_e[tid], pz = gbase[e] + sel_r[tid];
            tok_e[row0 * 2 + tid] = e; tok_p[row0 * 2 + tid] = pz; tok_w[row0 * 2 + tid] = sel_w[tid]; dmap[e * NTOK + pz] = row0 + (tid >> 1);
        }
        asm volatile("s_waitcnt lgkmcnt(0)" ::: "memory"); __builtin_amdgcn_s_barrier(); asm volatile("" ::: "memory");
    }
}
}

__global__ void __launch_bounds__(512, 2) mega_fwd(Params p) {
    extern __shared__ __attribute__((aligned(16))) unsigned char lds[];
    unsigned char* ws = p.ws;
    if (threadIdx.x < 4) ((volatile LAS unsigned*)((LAS unsigned char*)lds + MISC_OFF))[threadIdx.x] = 0u;
    if (threadIdx.x == 4) ((volatile LAS unsigned*)((LAS unsigned char*)lds + MISC_OFF))[18] = 0u;
    __syncthreads();
    const XcdBarrier bar = xcd_barrier_post((unsigned*)(ws + OFF_CTL) + CW_BAR, (volatile LAS unsigned*)((LAS unsigned char*)lds + MISC_OFF));
    PG8_LAS unsigned char* ring = (PG8_LAS unsigned char*)lds;
    const int G = gridDim.x, bid = blockIdx.x;

    if (bid == G - 1) phase_prep(p);
    { const int split = (bid < 192) ? 6 * (bid & 3) : 0;
      if (split > 0) phase_conv(p, (LAS unsigned char*)lds, 0, split, false);
      phase_mod(p, lds);
      phase_conv(p, (LAS unsigned char*)lds, split, 1 << 20, true); }
    xcd_barrier(bar);
    phase_modulate_ctx(p);
    { asm volatile("s_waitcnt vmcnt(0)" ::: "memory"); __syncthreads();
      unsigned* hcc = (unsigned*)(ws + OFF_CTL) + CW_HC;
      if (threadIdx.x == 0) {
          __builtin_amdgcn_fence(__ATOMIC_RELEASE, "agent"); asm volatile("s_waitcnt vmcnt(0)" ::: "memory");
          for (int panel = bid; panel < NCTX / 16; panel += G) (void)xb_add(hcc + (panel * 16) / CTX, 1u);
      }
      pg8::PlainOrder S; S.init(NCTX / 256, 4, G, bid); S.pb0 = 2;
      int pm, pn;
      if (S.map(0, pm, pn)) {
          if (threadIdx.x == 0) {
              for (int i = 0; S.map(i, pm, pn); ++i) { unsigned spins = 0; while (xb_ld(hcc + pm) < (unsigned)(CTX / 16) && ++spins < (1u << 22)) __builtin_amdgcn_s_sleep(4); }
              __builtin_amdgcn_fence(__ATOMIC_ACQUIRE, "agent"); asm volatile("s_waitcnt vmcnt(0)" ::: "memory");
          }
          __syncthreads();
          pg8::Gemm g{(const bf16_t*)(ws + OFF_A + 128 * MiB), (const bf16_t*)(ws + OFF_WIN), nullptr, D};
          pg8::EpiInProj E{ws, ring + ROPE_LDS, 1, 0}; pg8::gemm_phase<pg8::EpiInProj, pg8::PlainOrder, false>(ring, g, S, E);
      } }
    phase_modulate_x(p, (LAS unsigned char*)lds);
    xcd_barrier(bar);
    { const int tx = opaque_tid(); const float* rg = (const float*)(ws + OFF_ROPE);
      for (int i = tx; i < 2048; i += 512) ((LAS float*)((LAS unsigned char*)lds + ROPE_LDS))[i] = rg[i];
      asm volatile("s_waitcnt vmcnt(0) lgkmcnt(0)" ::: "memory"); __syncthreads(); }
    { pg8::Gemm g{(const bf16_t*)(ws + OFF_A), (const bf16_t*)(ws + OFF_WIN), nullptr, D}; pg8::PlainOrder S; S.init(NTOK / 256, INC / 256, G, bid, IN_WGM); S.pb0 = 0;
      pg8::EpiInProj E{ws, ring + ROPE_LDS, 0, 0}; pg8::gemm_phase<pg8::EpiInProj, pg8::PlainOrder, false>(ring, g, S, E); }
    xcd_barrier(bar);
    sg::sg_phase(p, (LAS unsigned char*)lds);
    att::attn_phase(p, (LAS unsigned char*)lds);
    xcd_barrier(bar);
    { pg8::Gemm g{(const bf16_t*)(ws + OFF_C), (const bf16_t*)(ws + OFF_WOUT), nullptr, D}; pg8::PlainOrder S; S.init(NTOK / 256, D / 256, G, bid, OUT_WGM); S.pb0 = 0;
      pg8::EpiBf16 E{(bf16_t*)(ws + OFF_A), D, 0}; pg8::gemm_phase<pg8::EpiBf16, pg8::PlainOrder, false>(ring, g, S, E); }
    xcd_barrier(bar);
    rt::ln1_router_phase(p, (LAS unsigned char*)lds);
    xcd_barrier(bar);
    moe_tables(p, (LAS unsigned char*)lds);
    const PG8_LAS int* tile_e = (const PG8_LAS int*)(ring + MOE_TE); const PG8_LAS int* tile_p0 = (const PG8_LAS int*)(ring + MOE_TP);
    const unsigned* ecnt = (const unsigned*)(ws + OFF_CTL) + CW_CNT;
    const int Mt = tile_e[MAXT], ns = moe_early_tiles(Mt, G);
    unsigned* sdone = (unsigned*)(ws + OFF_CTL) + CW_SDONE;
    { pg8::Gemm g{(const bf16_t*)(ws + OFF_C), (const bf16_t*)(ws + OFF_WGU), (const int*)(ws + OFF_DMAP), D};
      pg8::MoeOrder S; S.init(Mt, 8, G, bid, GU_WGM); S.tile_e = tile_e; S.tile_p0 = tile_p0; S.cnt = ecnt; S.tpe = 8; S.pm0 = 0;
      int pub_ui = -1, pub_n = 0;
      if (ns > 0) { pg8::Unit u; for (int i = 0; S.next(i, u); ++i) if (u.pm < ns) { pub_ui = i; ++pub_n; } }
      pg8::EpiGateUp E{(bf16_t*)(ws + OFF_A), sdone, pub_ui, pub_n}; pg8::gemm_phase<pg8::EpiGateUp, pg8::MoeOrder, true>(ring, g, S, E);
      const int j = bid - (8 * Mt) % G;
      if (ns > 0 && j >= 0 && j < 4 * ns) {
          if (threadIdx.x == 0) { unsigned spins = 0; while (xb_ld(sdone) < (unsigned)(8 * ns) && ++spins < (1u << 22)) __builtin_amdgcn_s_sleep(4);
              __builtin_amdgcn_fence(__ATOMIC_ACQUIRE, "agent"); asm volatile("s_waitcnt vmcnt(0)" ::: "memory"); }
          __syncthreads();
          pg8::Gemm g2{(const bf16_t*)(ws + OFF_A), (const bf16_t*)(ws + OFF_WD), nullptr, D};
          pg8::OneOrder S1{j >> 2, j & 3, tile_e[j >> 2] * 4 + (j & 3)};
          pg8::EpiBf16 E2{(bf16_t*)(ws + OFF_Y2E), D, 0}; pg8::gemm_phase<pg8::EpiBf16, pg8::OneOrder, false>(ring, g2, S1, E2);
      } }
    xcd_barrier(bar);
    { pg8::Gemm g{(const bf16_t*)(ws + OFF_A), (const bf16_t*)(ws + OFF_WD), nullptr, D};
      pg8::MoeOrder S; S.init(Mt - ns, 4, G, bid, DN_WGM); S.tile_e = tile_e; S.tile_p0 = tile_p0; S.cnt = ecnt; S.tpe = 4; S.pm0 = ns;
      pg8::EpiBf16 E{(bf16_t*)(ws + OFF_Y2), D, 0}; pg8::gemm_phase<pg8::EpiBf16, pg8::MoeOrder, false>(ring, g, S, E); }
    xcd_barrier(bar);
    phase_final(p, (LAS unsigned char*)lds);
}

extern "C" void kernel_launch(void* const* d_in, const int* in_sizes, int n_in, void* d_out, int out_size, void* d_ws, size_t ws_size, hipStream_t stream) {
    (void)in_sizes; (void)out_size;
    static int grid = 0;
    if (grid == 0) {
        if (n_in != 28 || ws_size < WS_END) { fprintf(stderr, "kernel_launch: expected 28 inputs and >= %zu bytes of workspace (got %d, %zu)\n", (size_t)WS_END, n_in, ws_size); grid = -1; return; }
        int dev = 0, cus = 0, per_cu = 0;
        if (hipGetDevice(&dev) != hipSuccess || hipDeviceGetAttribute(&cus, hipDeviceAttributeMultiprocessorCount, dev) != hipSuccess) { grid = -1; return; }
        if (hipFuncSetAttribute((const void*)mega_fwd, hipFuncAttributeMaxDynamicSharedMemorySize, LDS_BYTES) != hipSuccess) { fprintf(stderr, "kernel_launch: hipFuncSetAttribute failed\n"); grid = -1; return; }
        if (hipOccupancyMaxActiveBlocksPerMultiprocessor(&per_cu, (const void*)mega_fwd, 512, LDS_BYTES) != hipSuccess || per_cu < 1) { fprintf(stderr, "kernel_launch: occupancy query says %d\n", per_cu); per_cu = 1; }
        (void)hipGetLastError();
        grid = cus;
    }
    if (grid < 0) return;
    if (hipMemsetAsync((unsigned char*)d_ws + OFF_CTL, 0, 65536, stream) != hipSuccess) return;
    Params p{};
    for (int i = 0; i < 28; ++i) p.in[i] = (const float*)d_in[i];
    p.out = (float*)d_out; p.ws = (unsigned char*)d_ws;
    hipLaunchKernelGGL(mega_fwd, dim3(grid), dim3(512), LDS_BYTES, stream, p);
}
```
